# Optimizing an MI355X kernel written in HIP

```python
import math
import jax, jax.numpy as jnp
from jax import lax
import numpy as np

D_MODEL = 2048
BATCH = 16
SEQ = 2048
DEPTH = 4

GRID_W = 64
CTX_LEN = 256
EPS = 1e-6

D_MIX = D_MODEL
N_GROUPS = 4
GROUP_W = D_MIX // N_GROUPS
S5_WIDTH = GROUP_W
S5_CH_PER_GROUP = 16
S5_GROUPS = S5_WIDTH // S5_CH_PER_GROUP
S5_STATE = 64
S5_MIN_NEG = -1e-4
ML_HEADS = 4
ML_HEAD_DIM = GROUP_W // ML_HEADS
MLSTM_CHUNK = 64
MLA_HEADS = 4
MLA_NOPE = 128
MLA_ROPE = 64
MLA_QK = MLA_NOPE + MLA_ROPE
MLA_V = GROUP_W // MLA_HEADS
MLA_Q_LORA = 384
MLA_KV_LORA = 128
ATTN_SCALE = MLA_QK ** -0.5
ROPE_BASE = 10000.0
Q_BLOCK = 128
LRU_WIDTH = GROUP_W
LRU_BLOCKS = 4
LRU_BLOCK_W = LRU_WIDTH // LRU_BLOCKS
LRU_CONV = 4
LRU_C = 8.0
D_FF = 4 * D_MODEL
IN_SPLITS = (S5_WIDTH, GROUP_W, GROUP_W, GROUP_W, GROUP_W, 4 * ML_HEADS,
             MLA_Q_LORA, MLA_KV_LORA, MLA_ROPE, LRU_WIDTH, LRU_WIDTH)
IN_COLS = sum(IN_SPLITS)

kernel_name = 'hybrid_parallel_group_flow_trunk'


def rmsnorm(x, w):
    xf = x.astype(jnp.float32)
    y = xf * lax.rsqrt(jnp.mean(xf * xf, axis=-1, keepdims=True) + EPS)
    return (y * w.astype(jnp.float32)).astype(x.dtype)


def modulate(h, shift, scale):
    return h * (1.0 + scale) + shift


def split_cols(z):
    idx = np.cumsum(np.array(IN_SPLITS))[:-1].tolist()
    return jnp.split(z, idx, axis=-1)


def last_state(h, reverse):
    return h[:, 0] if reverse else h[:, -1]


def _real_combine(e1, e2):
    a1, b1 = e1
    a2, b2 = e2
    return a1 * a2, a2 * b1 + b2


def linear_scan(a, b, h0, reverse):
    if reverse:
        a, b = jnp.flip(a, 1), jnp.flip(b, 1)
    if h0 is not None:
        b = b.at[:, 0].add(a[:, 0] * h0)
    _, h = lax.associative_scan(_real_combine, (a, b), axis=1)
    return jnp.flip(h, 1) if reverse else h


def _complex_combine(e1, e2):
    a1r, a1i, b1r, b1i = e1
    a2r, a2i, b2r, b2i = e2
    return (a1r * a2r - a1i * a2i, a1r * a2i + a1i * a2r,
            a2r * b1r - a2i * b1i + b2r, a2r * b1i + a2i * b1r + b2i)


def complex_scan(ar, ai, br, bi, h0, reverse):
    ar = jnp.broadcast_to(ar, br.shape)
    ai = jnp.broadcast_to(ai, br.shape)
    if reverse:
        br, bi = jnp.flip(br, 1), jnp.flip(bi, 1)
    if h0 is not None:
        h0r, h0i = h0
        br = br.at[:, 0].add(ar[:, 0] * h0r - ai[:, 0] * h0i)
        bi = bi.at[:, 0].add(ar[:, 0] * h0i + ai[:, 0] * h0r)
    _, _, hr, hi = lax.associative_scan(_complex_combine, (ar, ai, br, bi), axis=1)
    if reverse:
        hr, hi = jnp.flip(hr, 1), jnp.flip(hi, 1)
    return hr, hi


def s5_mixer(u_l, u_c, lam_re, lam_im, log_dt, b_re, b_im, c_re, c_im, d_skip, glu_w, glu_b, need_ctx):
    def groups(u):
        return u.astype(jnp.float32).reshape(u.shape[0], u.shape[1], S5_GROUPS, S5_CH_PER_GROUP)
    gl, gc = groups(u_l), groups(u_c)
    y_l, y_c = 0.0, 0.0
    for d in range(2):
        rev = d == 1
        lr = jnp.minimum(lam_re[d].astype(jnp.float32), S5_MIN_NEG)
        li = lam_im[d].astype(jnp.float32)
        dt = jnp.exp(log_dt[d].astype(jnp.float32))[:, None]
        mag = jnp.exp(lr * dt)
        ar, ai = mag * jnp.cos(li * dt), mag * jnp.sin(li * dt)
        den = lr * lr + li * li
        fr = ((ar - 1.0) * lr + ai * li) / den
        fi = (ai * lr - (ar - 1.0) * li) / den
        bbr = fr[..., None] * b_re[d] - fi[..., None] * b_im[d]
        bbi = fr[..., None] * b_im[d] + fi[..., None] * b_re[d]

        def drive(u):
            return (jnp.einsum('blgc,gpc->blgp', u, bbr), jnp.einsum('blgc,gpc->blgp', u, bbi))

        def readout(sr, si):
            return jnp.einsum('blgp,gcp->blgc', sr, c_re[d]) - jnp.einsum('blgp,gcp->blgc', si, c_im[d])

        sc_r, sc_i = complex_scan(ar, ai, *drive(gc), None, rev)
        sl_r, sl_i = complex_scan(ar, ai, *drive(gl), (last_state(sc_r, rev), last_state(sc_i, rev)), rev)
        y_l = y_l + readout(sl_r, sl_i)
        if need_ctx:
            y_c = y_c + readout(sc_r, sc_i)

    def finish(y, u):
        y = y.reshape(u.shape[0], u.shape[1], S5_WIDTH) + d_skip * u.astype(jnp.float32)
        y = jax.nn.gelu(y)
        return y * jax.nn.sigmoid(y @ glu_w + glu_b)

    return finish(y_l, u_l), (finish(y_c, u_c) if need_ctx else None)


def mlstm_scan(q, k, v, logi, logf, state0, with_output):
    B_, H_, L_, dh = q.shape
    nc = L_ // MLSTM_CHUNK
    lower = jnp.tril(jnp.ones((MLSTM_CHUNK, MLSTM_CHUNK), dtype=bool))

    def chunks(t):
        return jnp.moveaxis(t.reshape((B_, H_, nc, MLSTM_CHUNK) + t.shape[3:]), 2, 0)

    def step(carry, xs):
        C, n, m = carry
        qc, kc, vc, li, lf = xs
        b = jnp.cumsum(lf, axis=-1)
        b_last = b[..., -1]
        w_log = b_last[..., None] - b + li
        m_new = jnp.maximum(b_last + m, jnp.max(w_log, axis=-1))
        decay = jnp.exp(b_last + m - m_new)
        w = jnp.exp(w_log - m_new[..., None])
        C_new = decay[..., None, None] * C + jnp.einsum('bhs,bhsd,bhse->bhde', w, vc, kc)
        n_new = decay[..., None] * n + jnp.einsum('bhs,bhse->bhe', w, kc)
        if not with_output:
            return (C_new, n_new, m_new), None
        g = b + m[..., None]
        d_log = jnp.where(lower, b[..., :, None] - b[..., None, :] + li[..., None, :], -jnp.inf)
        m_t = jnp.maximum(g, jnp.max(d_log, axis=-1))
        inter = jnp.exp(g - m_t)
        s = jnp.einsum('bhtd,bhsd->bhts', qc, kc) * jnp.exp(d_log - m_t[..., None])
        num = inter[..., None] * jnp.einsum('bhde,bhte->bhtd', C, qc) + jnp.einsum('bhts,bhsd->bhtd', s, vc)
        den = inter * jnp.einsum('bhe,bhte->bht', n, qc) + jnp.sum(s, axis=-1)
        h = num / jnp.maximum(jnp.abs(den), jnp.exp(-m_t))[..., None]
        return (C_new, n_new, m_new), h

    state, h = lax.scan(step, state0, tuple(chunks(t) for t in (q, k, v, logi, logf)))
    if with_output:
        h = jnp.moveaxis(h, 0, 2).reshape(B_, H_, L_, dh)
    return h, state


def mlstm_mixer(q_l, k_l, v_l, o_l, g_l, q_c, k_c, v_c, o_c, g_c, ig_bias, fg_bias, out_norm, need_ctx):
    def heads(t):
        return jnp.transpose(t.astype(jnp.float32).reshape(t.shape[0], t.shape[1], ML_HEADS, ML_HEAD_DIM), (0, 2, 1, 3))

    def gates(g, d):
        g = g.astype(jnp.float32).reshape(g.shape[0], g.shape[1], 2, 2, ML_HEADS)
        logi = g[:, :, d, 0] + ig_bias[d]
        logf = jax.nn.log_sigmoid(g[:, :, d, 1] + fg_bias[d])
        return (jnp.transpose(logi, (0, 2, 1)), jnp.transpose(logf, (0, 2, 1)))

    k_scale = ML_HEAD_DIM ** -0.5
    lat = (heads(q_l), heads(k_l) * k_scale, heads(v_l))
    ctx = (heads(q_c), heads(k_c) * k_scale, heads(v_c))
    B_ = q_l.shape[0]
    zero = (jnp.zeros((B_, ML_HEADS, ML_HEAD_DIM, ML_HEAD_DIM), jnp.float32),
            jnp.zeros((B_, ML_HEADS, ML_HEAD_DIM), jnp.float32),
            jnp.zeros((B_, ML_HEADS), jnp.float32))
    h_l, h_c = 0.0, 0.0
    for d in range(2):
        flip = (lambda t: jnp.flip(t, axis=2)) if d == 1 else (lambda t: t)
        seq_c = [flip(t) for t in ctx + gates(g_c, d)]
        seq_l = [flip(t) for t in lat + gates(g_l, d)]
        out_c, state = mlstm_scan(*seq_c, zero, need_ctx)
        out_l, _ = mlstm_scan(*seq_l, state, True)
        h_l = h_l + flip(out_l)
        if need_ctx:
            h_c = h_c + flip(out_c)

    def finish(h, o):
        hn = rmsnorm(h, out_norm[:, None, :])
        hn = jnp.transpose(hn, (0, 2, 1, 3)).reshape(o.shape[0], o.shape[1], GROUP_W)
        return hn * jax.nn.sigmoid(o.astype(jnp.float32))

    return finish(h_l, o_l), (finish(h_c, o_c) if need_ctx else None)


def axial_angles(n_tokens):
    n_rows = n_tokens // GRID_W
    rows = jnp.repeat(jnp.arange(n_rows, dtype=jnp.float32), GRID_W)
    cols = jnp.tile(jnp.arange(GRID_W, dtype=jnp.float32), n_rows)
    n_freq = MLA_ROPE // 4
    inv_freq = ROPE_BASE ** (-jnp.arange(n_freq, dtype=jnp.float32) / n_freq)
    return rows[:, None] * inv_freq, cols[:, None] * inv_freq


def rotate_pairs(x, ang):
    f = ang.shape[-1]
    cos, sin = jnp.cos(ang)[None, :, None, :], jnp.sin(ang)[None, :, None, :]
    x1, x2 = x[..., :f].astype(jnp.float32), x[..., f:].astype(jnp.float32)
    return jnp.concatenate([x1 * cos - x2 * sin, x2 * cos + x1 * sin], axis=-1)


def rope_2d(x, ang_row, ang_col):
    half = MLA_ROPE // 2
    rope = x[..., MLA_NOPE:]
    rot = jnp.concatenate([rotate_pairs(rope[..., :half], ang_row), rotate_pairs(rope[..., half:], ang_col)], axis=-1)
    return jnp.concatenate([x[..., :MLA_NOPE], rot.astype(x.dtype)], axis=-1)


def mla_queries(cq, q_a_norm, w_q_up, q_norm, angles):
    q = (rmsnorm(cq, q_a_norm) @ w_q_up).reshape(cq.shape[0], cq.shape[1], MLA_HEADS, MLA_QK)
    q = rmsnorm(q, q_norm)
    return q if angles is None else rope_2d(q, *angles)


def mla_keys_values(ckv, kr, kv_a_norm, w_kv_up, k_norm, angles):
    B_, L_ = ckv.shape[:2]
    kv = (rmsnorm(ckv, kv_a_norm) @ w_kv_up).reshape(B_, L_, MLA_HEADS, MLA_NOPE + MLA_V)
    k_rope = jnp.broadcast_to(kr[:, :, None, :], (B_, L_, MLA_HEADS, MLA_ROPE))
    k = rmsnorm(jnp.concatenate([kv[..., :MLA_NOPE], k_rope], axis=-1), k_norm)
    k = k if angles is None else rope_2d(k, *angles)
    return k, kv[..., MLA_NOPE:]


def attend(q, k, v):
    s = jnp.einsum('bqhd,bkhd->bhqk', q, k).astype(jnp.float32) * ATTN_SCALE
    p = jax.nn.softmax(s, axis=-1)
    return jnp.einsum('bhqk,bkhd->bqhd', p.astype(v.dtype), v)


def mla_mixer(cq_l, ckv_l, kr_l, cq_c, ckv_c, kr_c, q_a_norm, w_q_up, kv_a_norm, w_kv_up, q_norm, k_norm, need_ctx):
    B_, L_ = cq_l.shape[:2]
    ang = axial_angles(L_)
    q_l = mla_queries(cq_l, q_a_norm, w_q_up, q_norm, ang)
    k_l, v_l = mla_keys_values(ckv_l, kr_l, kv_a_norm, w_kv_up, k_norm, ang)
    k_c, v_c = mla_keys_values(ckv_c, kr_c, kv_a_norm, w_kv_up, k_norm, None)
    k_all = jnp.concatenate([k_c, k_l], axis=1)
    v_all = jnp.concatenate([v_c, v_l], axis=1)
    n_blocks = L_ // Q_BLOCK
    q_blocks = jnp.moveaxis(q_l.reshape(B_, n_blocks, Q_BLOCK, MLA_HEADS, MLA_QK), 1, 0)
    o_blocks = lax.map(lambda qb: attend(qb, k_all, v_all), q_blocks)
    y_l = jnp.moveaxis(o_blocks, 0, 1).reshape(B_, L_, MLA_HEADS * MLA_V)
    if not need_ctx:
        return y_l, None
    q_c = mla_queries(cq_c, q_a_norm, w_q_up, q_norm, None)
    y_c = attend(q_c, k_c, v_c).reshape(B_, cq_c.shape[1], MLA_HEADS * MLA_V)
    return y_l, y_c


def conv_centred(x, w, b):
    L_ = x.shape[1]
    left = LRU_CONV // 2
    xp = jnp.pad(x, ((0, 0), (left, LRU_CONV - 1 - left), (0, 0)))
    y = b
    for j in range(LRU_CONV):
        y = y + xp[:, j:j + L_] * w[j]
    return y


def rglru_mixer(x_l, gate_l, x_c, gate_c, conv_w, conv_b, wa, ba, wx, bx, lam, need_ctx):
    xs_l = conv_centred(x_l, conv_w, conv_b).astype(jnp.float32)
    xs_c = conv_centred(x_c, conv_w, conv_b).astype(jnp.float32)

    def drive(xs, d):
        B_, L_ = xs.shape[:2]
        xb = xs.reshape(B_, L_, LRU_BLOCKS, LRU_BLOCK_W)
        r = jax.nn.sigmoid(jnp.einsum('blnc,ncd->blnd', xb, wa[d]).reshape(B_, L_, LRU_WIDTH) + ba[d])
        i = jax.nn.sigmoid(jnp.einsum('blnc,ncd->blnd', xb, wx[d]).reshape(B_, L_, LRU_WIDTH) + bx[d])
        log_a = -LRU_C * r * jax.nn.softplus(-lam[d].astype(jnp.float32))
        return jnp.exp(log_a), jnp.sqrt(-jnp.expm1(2.0 * log_a)) * (i * xs)

    y_l, y_c = 0.0, 0.0
    for d in range(2):
        rev = d == 1
        h_c = linear_scan(*drive(xs_c, d), None, rev)
        h_l = linear_scan(*drive(xs_l, d), last_state(h_c, rev), rev)
        y_l = y_l + h_l
        if need_ctx:
            y_c = y_c + h_c
    out_l = y_l * jax.nn.gelu(gate_l.astype(jnp.float32))
    out_c = y_c * jax.nn.gelu(gate_c.astype(jnp.float32)) if need_ctx else None
    return out_l, out_c


def sq_relu_mlp(h, w1, w2):
    a = jax.nn.relu(h @ w1)
    return (a * a) @ w2


def setup_inputs(seed: int = 0) -> dict:
    key = jax.random.key(seed)
    ks = iter(jax.random.split(key, 48))

    def nrm(shape, scale):
        return jax.random.normal(next(ks), shape, jnp.float32) * scale

    def gain(shape):
        return 1.0 + nrm(shape, 0.02)

    L2 = (DEPTH, 2)
    lru_u = jax.random.uniform(next(ks), L2 + (LRU_WIDTH,), jnp.float32, 0.9, 0.999)
    lru_a = lru_u ** (1.0 / LRU_C)
    return {
        'x': nrm((BATCH, SEQ, D_MODEL), 1.0),
        'c': nrm((BATCH, D_MODEL), 1.0),
        'ctx': nrm((BATCH, CTX_LEN, D_MODEL), 1.0),
        'c_ctx': nrm((D_MODEL,), 1.0),
        'ada_w': nrm((DEPTH, D_MODEL, 6 * D_MODEL), 0.5 * D_MODEL ** -0.5),
        'ada_b': nrm((DEPTH, 6 * D_MODEL), 0.02),
        'norm1_w': gain((DEPTH, D_MODEL)),
        'norm2_w': gain((DEPTH, D_MODEL)),
        'w_in': nrm((DEPTH, D_MODEL, IN_COLS), D_MODEL ** -0.5),
        'w_out': nrm((DEPTH, D_MIX, D_MODEL), D_MIX ** -0.5),
        's5_lam_re': -0.5 + nrm(L2 + (S5_GROUPS, S5_STATE), 0.01),
        's5_lam_im': jnp.pi * jnp.arange(S5_STATE, dtype=jnp.float32) + nrm(L2 + (S5_GROUPS, S5_STATE), 0.01),
        's5_log_dt': jax.random.uniform(next(ks), L2 + (S5_GROUPS,), jnp.float32, math.log(1e-3), math.log(1e-1)),
        's5_b_re': nrm(L2 + (S5_GROUPS, S5_STATE, S5_CH_PER_GROUP), (2 * S5_CH_PER_GROUP) ** -0.5),
        's5_b_im': nrm(L2 + (S5_GROUPS, S5_STATE, S5_CH_PER_GROUP), (2 * S5_CH_PER_GROUP) ** -0.5),
        's5_c_re': nrm(L2 + (S5_GROUPS, S5_CH_PER_GROUP, S5_STATE), (2 * S5_STATE) ** -0.5),
        's5_c_im': nrm(L2 + (S5_GROUPS, S5_CH_PER_GROUP, S5_STATE), (2 * S5_STATE) ** -0.5),
        's5_d': nrm((DEPTH, S5_WIDTH), 1.0),
        's5_glu_w': nrm((DEPTH, S5_WIDTH, S5_WIDTH), S5_WIDTH ** -0.5),
        's5_glu_b': nrm((DEPTH, S5_WIDTH), 0.02),
        'ml_ig_bias': nrm(L2 + (ML_HEADS,), 0.1),
        'ml_fg_bias': jnp.linspace(3.0, 6.0, ML_HEADS) + nrm(L2 + (ML_HEADS,), 0.1),
        'ml_out_norm': gain((DEPTH, ML_HEADS, ML_HEAD_DIM)),
        'mla_q_a_norm': gain((DEPTH, MLA_Q_LORA)),
        'mla_w_q_up': nrm((DEPTH, MLA_Q_LORA, MLA_HEADS * MLA_QK), MLA_Q_LORA ** -0.5),
        'mla_kv_a_norm': gain((DEPTH, MLA_KV_LORA)),
        'mla_w_kv_up': nrm((DEPTH, MLA_KV_LORA, MLA_HEADS * (MLA_NOPE + MLA_V)), MLA_KV_LORA ** -0.5),
        'mla_q_norm': gain((DEPTH, MLA_QK)),
        'mla_k_norm': gain((DEPTH, MLA_QK)),
        'lru_conv_w': nrm((DEPTH, LRU_CONV, LRU_WIDTH), 0.5),
        'lru_conv_b': nrm((DEPTH, LRU_WIDTH), 0.02),
        'lru_wa': nrm(L2 + (LRU_BLOCKS, LRU_BLOCK_W, LRU_BLOCK_W), LRU_BLOCK_W ** -0.5),
        'lru_ba': nrm(L2 + (LRU_WIDTH,), 0.02),
        'lru_wx': nrm(L2 + (LRU_BLOCKS, LRU_BLOCK_W, LRU_BLOCK_W), LRU_BLOCK_W ** -0.5),
        'lru_bx': nrm(L2 + (LRU_WIDTH,), 0.02),
        'lru_lam': jnp.log(lru_a) - jnp.log1p(-lru_a),
        'mlp_w1': nrm((DEPTH, D_MODEL, D_FF), D_MODEL ** -0.5),
        'mlp_w2': nrm((DEPTH, D_FF, D_MODEL), D_FF ** -0.5),
    }


def reference(x, c, ctx, c_ctx, ada_w, ada_b, norm1_w, norm2_w, w_in, w_out,
              s5_lam_re, s5_lam_im, s5_log_dt, s5_b_re, s5_b_im, s5_c_re, s5_c_im, s5_d, s5_glu_w, s5_glu_b,
              ml_ig_bias, ml_fg_bias, ml_out_norm,
              mla_q_a_norm, mla_w_q_up, mla_kv_a_norm, mla_w_kv_up, mla_q_norm, mla_k_norm,
              lru_conv_w, lru_conv_b, lru_wa, lru_ba, lru_wx, lru_bx, lru_lam,
              mlp_w1, mlp_w2):
    x_lat, x_ctx = x, ctx
    c_act = jax.nn.silu(c.astype(jnp.float32))
    cctx_act = jax.nn.silu(c_ctx.astype(jnp.float32))
    for l in range(DEPTH):
        need_ctx = l < DEPTH - 1
        mod_l = jnp.split((c_act @ ada_w[l] + ada_b[l])[:, None, :], 6, axis=-1)
        mod_c = jnp.split(cctx_act @ ada_w[l] + ada_b[l], 6, axis=-1)

        h_l = modulate(rmsnorm(x_lat, norm1_w[l]), mod_l[0], mod_l[1])
        h_c = modulate(rmsnorm(x_ctx, norm1_w[l]), mod_c[0], mod_c[1])
        (u_l, mq_l, mk_l, mv_l, mo_l, mg_l, cq_l, ckv_l, kr_l, lx_l, lg_l) = split_cols(h_l @ w_in[l])
        (u_c, mq_c, mk_c, mv_c, mo_c, mg_c, cq_c, ckv_c, kr_c, lx_c, lg_c) = split_cols(h_c @ w_in[l])

        a_l, a_c = s5_mixer(u_l, u_c, s5_lam_re[l], s5_lam_im[l], s5_log_dt[l], s5_b_re[l], s5_b_im[l],
                            s5_c_re[l], s5_c_im[l], s5_d[l], s5_glu_w[l], s5_glu_b[l], need_ctx)
        b_l, b_c = mlstm_mixer(mq_l, mk_l, mv_l, mo_l, mg_l, mq_c, mk_c, mv_c, mo_c, mg_c,
                               ml_ig_bias[l], ml_fg_bias[l], ml_out_norm[l], need_ctx)
        m_l, m_c = mla_mixer(cq_l, ckv_l, kr_l, cq_c, ckv_c, kr_c, mla_q_a_norm[l], mla_w_q_up[l],
                             mla_kv_a_norm[l], mla_w_kv_up[l], mla_q_norm[l], mla_k_norm[l], need_ctx)
        r_l, r_c = rglru_mixer(lx_l, lg_l, lx_c, lg_c, lru_conv_w[l], lru_conv_b[l], lru_wa[l], lru_ba[l],
                               lru_wx[l], lru_bx[l], lru_lam[l], need_ctx)
        x_lat = x_lat + mod_l[2] * (jnp.concatenate([a_l, b_l, m_l, r_l], axis=-1) @ w_out[l])
        if need_ctx:
            x_ctx = x_ctx + mod_c[2] * (jnp.concatenate([a_c, b_c, m_c, r_c], axis=-1) @ w_out[l])

        x_lat = x_lat + mod_l[5] * sq_relu_mlp(modulate(rmsnorm(x_lat, norm2_w[l]), mod_l[3], mod_l[4]), mlp_w1[l], mlp_w2[l])
        if need_ctx:
            x_ctx = x_ctx + mod_c[5] * sq_relu_mlp(modulate(rmsnorm(x_ctx, norm2_w[l]), mod_c[3], mod_c[4]), mlp_w1[l], mlp_w2[l])
    return x_lat
```

```cpp
#include <hip/hip_runtime.h>
#include <cstdio>
#include <cstdint>
#ifndef GEMM_ALIGN
#define GEMM_ALIGN true
#endif
#ifndef GEMM_SP2
#define GEMM_SP2 true
#endif
#ifndef MLP_CHUNK
#define MLP_CHUNK 8192
#endif
#ifndef STAG_GROUPS
#define STAG_GROUPS 1
#define STAG_SLEEP 64
#endif
#ifndef EPI_NT
#define EPI_NT 0
#endif
#ifndef S5_IN_L4
#define S5_IN_L4 0
#endif
#ifndef MLP_ALT
#define MLP_ALT 0
#endif
#ifndef WOUT_STAG_GROUPS
#define WOUT_STAG_GROUPS 1
#define WOUT_STAG_STEPS 4
#endif
#ifndef PROBE_DUP
#define PROBE_DUP 0
#endif

constexpr int DM = 2048, NB = 16, SEQ = 2048, CTXL = 256, DEPTH = 4, DFF = 8192;
constexpr int RL = NB * SEQ;
constexpr int RC = NB * CTXL;
constexpr int RT = RL + RC;
constexpr int TOK = SEQ + CTXL;
constexpr int NZ = 4176, LDZ = 4352;
constexpr int ZU = 0, ZMQ = 512, ZMK = 1024, ZMV = 1536, ZMO = 2048, ZMG = 2560, ZCQ = 2576, ZCKV = 2960, ZKR = 3088, ZLX = 3152, ZLG = 3664;
constexpr int NMOD = 6 * DM;
constexpr float EPS = 1e-6f;
constexpr int NWAVES = 8, NTHR = 512;

enum { I_X = 0, I_C, I_CTX, I_CCTX, I_ADAW, I_ADAB, I_N1W, I_N2W, I_WIN, I_WOUT, I_S5LRE, I_S5LIM, I_S5LDT, I_S5BRE, I_S5BIM, I_S5CRE, I_S5CIM, I_S5D, I_S5GLUW, I_S5GLUB,
       I_MLIG, I_MLFG, I_MLON, I_QAN, I_WQUP, I_KVAN, I_WKVUP, I_QN, I_KN, I_LCW, I_LCB, I_LWA, I_LBA, I_LWX, I_LBX, I_LLAM, I_W1, I_W2, N_IN };

constexpr size_t MiB = 1u << 20;
#ifndef WS_SKEW
#define WS_SKEW 1
#endif
#ifndef BLK_LAYOUT
#define BLK_LAYOUT 1
#endif
__host__ __device__ __forceinline__ size_t blk_off(int row, int col, int nct) { return BLK_LAYOUT ? (((size_t)((row >> 8) * nct + (col >> 8))) << 16) + (size_t)((row & 255) * 256 + (col & 255)) : (size_t)row * (size_t)(256 * nct) + col; }
constexpr size_t WS_CTL = 0, CTL_ZERO_BYTES = 1 * MiB;
constexpr size_t WS_MODS = 1 * MiB;
constexpr size_t WS_S5A = 5 * MiB;
constexpr size_t WS_S5BB = 5 * MiB + 512 * 1024;
constexpr size_t WS_S5CM = 6 * MiB + 512 * 1024;
constexpr size_t WS_LRUC = 7 * MiB + 512 * 1024;
constexpr size_t WS_ROPE = 7 * MiB + 640 * 1024;
constexpr size_t WS_W = 8 * MiB;
constexpr size_t WS_WIN = WS_W;
constexpr size_t WS_WOUT = WS_WIN + 17 * MiB;
constexpr size_t WS_W1 = WS_WOUT + 8 * MiB;
constexpr size_t WS_W2 = WS_W1 + 32 * MiB;
constexpr size_t WS_WGLU = WS_W2 + 32 * MiB;
constexpr size_t WS_WQUP = WS_WGLU + 1 * MiB;
constexpr size_t WS_WKVUP = WS_WQUP + 1 * MiB;
constexpr size_t WS_WLRU = WS_WKVUP + 1 * MiB;
constexpr size_t WS_X = WS_WLRU + 2 * MiB;
constexpr size_t WS_H = WS_X + 288 * MiB + WS_SKEW * 129 * 256;
constexpr size_t WS_Z = WS_H + 144 * MiB + WS_SKEW * 67 * 256;
constexpr size_t WS_Y = WS_Z + 306 * MiB + WS_SKEW * 201 * 256;
constexpr size_t WS_HID = WS_Y + 144 * MiB + WS_SKEW * 37 * 256;
constexpr size_t WS_T = WS_HID + 128 * MiB + WS_SKEW * 93 * 256;
constexpr size_t WS_XS = WS_H;
constexpr size_t WS_AQ = WS_H + 36 * MiB;
constexpr size_t WS_AKV = WS_H + 63 * MiB;
constexpr size_t WS_Q = WS_H;
constexpr size_t WS_K = WS_H + 54 * MiB;
constexpr size_t WS_VT = WS_H + 108 * MiB;
constexpr size_t WS_QRAW = WS_HID;
constexpr size_t WS_KVRAW = WS_HID + 54 * MiB;
constexpr size_t WS_A5 = WS_HID;
constexpr size_t WS_LOGA = WS_T;
constexpr size_t WS_GB = WS_T + 72 * MiB;
constexpr size_t WS_YS = WS_T + 144 * MiB;
constexpr size_t WS_MH = WS_T + 216 * MiB;
constexpr size_t WS_LH = WS_T + 288 * MiB;
constexpr size_t WS_MODP = WS_Z;
constexpr size_t WS_LSUM = WS_T + 360 * MiB;
constexpr size_t WS_SHW = WS_T + 368 * MiB;
constexpr size_t WS_SSP = WS_T + 372 * MiB;
constexpr size_t WS_RSTD = WS_T + 377 * MiB;
constexpr size_t WS_END = WS_T + 378 * MiB;
static_assert(WS_END <= (size_t)1536 * MiB, "d_ws map exceeds 4 x largest input tensor");

constexpr int CW_TMO = 0, CW_CODE = 1;
constexpr int CW_BAR = 4096;
constexpr int CW_QUEUE = 8192;

constexpr int RING_OFF = 0, RING_BYTES = 131072;
constexpr int LDSCTL_OFF = RING_BYTES, MISC_OFF = LDSCTL_OFF + 320;
constexpr int LDS_BYTES = 147456;

#define GAS __attribute__((address_space(1)))
#define LAS __attribute__((address_space(3)))
typedef unsigned short bf16;
typedef unsigned v4u __attribute__((ext_vector_type(4)));
typedef unsigned v2u __attribute__((ext_vector_type(2)));
typedef float f32x4 __attribute__((ext_vector_type(4)));
typedef float f32x16 __attribute__((ext_vector_type(16)));
typedef short bf16x8 __attribute__((ext_vector_type(8)));
typedef short bf16x4 __attribute__((ext_vector_type(4)));
typedef GAS unsigned gu32;
#define RLX_AGENT __ATOMIC_RELAXED, __HIP_MEMORY_SCOPE_AGENT
#define LDS_WAIT() asm volatile("s_waitcnt lgkmcnt(0)" ::: "memory")
#define VM_WAIT() asm volatile("s_waitcnt vmcnt(0)" ::: "memory")
__device__ __forceinline__ unsigned f2bf(float f) { unsigned u = __builtin_bit_cast(unsigned, f); return (u + 0x7fffu + ((u >> 16) & 1u)) >> 16; }
typedef __bf16 bf16x2_t __attribute__((ext_vector_type(2)));
typedef float f32x2_t __attribute__((ext_vector_type(2)));
__device__ __forceinline__ unsigned pk2(float lo, float hi) { const f32x2_t v = {lo, hi}; const bf16x2_t b = __builtin_convertvector(v, bf16x2_t); return __builtin_bit_cast(unsigned, b); }
__device__ __forceinline__ float bf2f(unsigned b) { return __builtin_bit_cast(float, b << 16); }
__device__ __forceinline__ float bflo(unsigned w) { return __builtin_bit_cast(float, w << 16); }
__device__ __forceinline__ float bfhi(unsigned w) { return __builtin_bit_cast(float, w & 0xffff0000u); }
__device__ __forceinline__ void unpack8(const v4u w, float (&f)[8]) { f[0] = bflo(w.x); f[1] = bfhi(w.x); f[2] = bflo(w.y); f[3] = bfhi(w.y); f[4] = bflo(w.z); f[5] = bfhi(w.z); f[6] = bflo(w.w); f[7] = bfhi(w.w); }
__device__ __forceinline__ v4u pack8(const float (&f)[8]) { v4u w; w.x = pk2(f[0], f[1]); w.y = pk2(f[2], f[3]); w.z = pk2(f[4], f[5]); w.w = pk2(f[6], f[7]); return w; }
__device__ __forceinline__ float sigmoidf_(float x) { return __builtin_amdgcn_rcpf(1.f + __expf(-x)); }
__device__ __forceinline__ float gelu_tanh(float x) { const float u = 0.7978845608028654f * (x + 0.044715f * x * x * x); const float t = 1.f - 2.f * __builtin_amdgcn_rcpf(1.f + __expf(2.f * u)); return 0.5f * x * (1.f + t); }
__device__ __forceinline__ float softplusf_(float x) { return fmaxf(x, 0.f) + log1pf(__expf(-fabsf(x))); }
__device__ __forceinline__ float logsigmoidf_(float x) { return fminf(x, 0.f) - log1pf(__expf(-fabsf(x))); }
__device__ __forceinline__ float shx(float v, int mask, int lane) { return __builtin_bit_cast(float, __builtin_amdgcn_ds_bpermute((lane ^ mask) << 2, __builtin_bit_cast(int, v))); }
__device__ __forceinline__ float shup(float v, int delta, int lane) { return __builtin_bit_cast(float, __builtin_amdgcn_ds_bpermute(((lane - delta) & 63) << 2, __builtin_bit_cast(int, v))); }
__device__ __forceinline__ float wave_sum(float v, int lane) {
#pragma unroll
    for (int o = 1; o < 64; o <<= 1) v += shx(v, o, lane);
    return v;
}
__device__ __forceinline__ v4u zero_v4u() { unsigned z = 0u; asm volatile("" : "+v"(z)); return (v4u){z, z, z, z}; }
__device__ __forceinline__ int row_scan(int b, int dir, int p) {
    if (p < CTXL) { const int t = dir ? (CTXL - 1 - p) : p; return RL + b * CTXL + t; }
    const int q = p - CTXL; const int t = dir ? (SEQ - 1 - q) : q; return b * SEQ + t;
}
__device__ __forceinline__ int row_key(int b, int key) { return key < CTXL ? RL + b * CTXL + key : b * SEQ + (key - CTXL); }
__device__ __forceinline__ int mod_row(int r) { return r < RL ? (r >> 11) : NB; }
namespace pg8 {
#define PG8_LAS __attribute__((address_space(3)))
typedef unsigned short bf16_t;
typedef short bf16x8 __attribute__((ext_vector_type(8)));
typedef float f32x4 __attribute__((ext_vector_type(4)));
typedef unsigned u32x4 __attribute__((ext_vector_type(4)));
constexpr int BM = 256, BK = 64, HALF = 128, HTB = HALF * BK * 2  , STAGE_BYTES = 8 * HTB, NXCD = 8, WGM = 8;

__host__ __device__ __forceinline__ int lds_byte(int r, int c) { const int st = (r >> 4) * 2 + (c >> 5), rr = r & 15, cc = c & 31, ob = rr * 64 + cc * 2; return st * 1024 + (ob ^ (((ob >> 9) & 1) << 5)); }
__host__ __device__ __forceinline__ void stage_rc(int b, int& R, int& C) { const int st = b / 1024, sb = b % 1024, swz = sb ^ (((sb >> 9) & 1) << 5); R = (st >> 1) * 16 + swz / 64; C = (st & 1) * 32 + (swz % 64) / 2; }
__host__ __device__ __forceinline__ int perm32(int rho) { const int n = rho >> 4, i = rho & 15; return 8 * (i >> 2) + 4 * n + (i & 3); }

struct Unit { int pm, pn; };
struct Gemm { const bf16_t* A; const bf16_t* Bt; int M, N, K; int ld = 0, nsplit = 0, ablk = 0; };

struct StaticOrder {
    int nM, nN, nwg, G, c;
    __host__ __device__ void init(int M, int N, int G_, int c_) { nM = M / BM; nN = N / BM; nwg = nM * nN; G = G_; c = c_; }
    __host__ __device__ bool next(int i, Unit& u) const {
        const long L = (long)i * G + c; if (L >= nwg) return false;
        int wgid = (int)L; { const int q = nwg / NXCD, r = nwg % NXCD, xcd = wgid % NXCD, off = wgid / NXCD; wgid = (xcd < r ? xcd * (q + 1) : r * (q + 1) + (xcd - r) * q) + off; }
        const int nig = WGM * nN, gid = wgid / nig, fm = gid * WGM, gsz = (nM - fm) < WGM ? (nM - fm) : WGM;
        u.pm = fm + ((wgid % nig) % gsz); u.pn = (wgid % nig) / gsz; return true;
    }
    __device__ __forceinline__ void a_ready(const Unit&) const {}
    __device__ __forceinline__ void done(const Unit&) const {}
};

__device__ __forceinline__ unsigned cvt_pk_bf16(float lo, float hi) { unsigned r; asm volatile("v_cvt_pk_bf16_f32 %0, %1, %2" : "=v"(r) : "v"(lo), "v"(hi)); return r; }
typedef float f32x2 __attribute__((ext_vector_type(2)));
__device__ __forceinline__ float bf_lo(unsigned w) { return __builtin_bit_cast(float, w << 16); }
__device__ __forceinline__ float bf_hi(unsigned w) { return __builtin_bit_cast(float, w & 0xffff0000u); }
template <class T> __device__ __forceinline__ void st_stream(T* p, const T v) { if (EPI_NT) __builtin_nontemporal_store(v, p); else *p = v; }
struct EpiStoreBf16 {
    static constexpr bool PERM = true, AFTER_DRAIN = false;
    bf16_t* O; int ldc;
    __device__ __forceinline__ void operator()(const f32x4 (&acc)[2][2][4][2], const Unit& u, int wr, int wc, int fr, int fq) const {
        const int row0 = u.pm * BM + wr * 64 + fr, col0 = u.pn * BM + wc * 32 + 8 * fq;
#pragma unroll
        for (int ai = 0; ai < 2; ++ai)
#pragma unroll
            for (int m = 0; m < 4; ++m) { bf16_t* rowp = O + (size_t)(row0 + ai * HALF + m * 16) * ldc + col0;
#pragma unroll
                for (int bj = 0; bj < 2; ++bj) { const f32x4 v0 = acc[ai][bj][m][0], v1 = acc[ai][bj][m][1];
                    u32x4 w; w.x = cvt_pk_bf16(v0[0], v0[1]); w.y = cvt_pk_bf16(v0[2], v0[3]); w.z = cvt_pk_bf16(v1[0], v1[1]); w.w = cvt_pk_bf16(v1[2], v1[3]);
                    *(u32x4*)(rowp + bj * HALF) = w; } }
    }
};
struct EpiRelu2 {
    static constexpr bool PERM = true, AFTER_DRAIN = false;
    bf16_t* O; int ldc;
    __device__ __forceinline__ void operator()(const f32x4 (&acc)[2][2][4][2], const Unit& u, int wr, int wc, int fr, int fq) const {
        const int row0 = u.pm * BM + wr * 64 + fr, col0 = u.pn * BM + wc * 32 + 8 * fq;
#pragma unroll
        for (int ai = 0; ai < 2; ++ai)
#pragma unroll
            for (int m = 0; m < 4; ++m) { bf16_t* rowp = O + (size_t)(row0 + ai * HALF + m * 16) * ldc + col0;
#pragma unroll
                for (int bj = 0; bj < 2; ++bj) { f32x4 v0 = acc[ai][bj][m][0], v1 = acc[ai][bj][m][1];
#pragma unroll
                    for (int j = 0; j < 4; ++j) { const float a = fmaxf(v0[j], 0.f), b = fmaxf(v1[j], 0.f); v0[j] = a * a; v1[j] = b * b; }
                    u32x4 w; w.x = cvt_pk_bf16(v0[0], v0[1]); w.y = cvt_pk_bf16(v0[2], v0[3]); w.z = cvt_pk_bf16(v1[0], v1[1]); w.w = cvt_pk_bf16(v1[2], v1[3]);
                    *(u32x4*)(rowp + bj * HALF) = w; } }
    }
};
__device__ __forceinline__ void atomic_add_f32_dev(float* p, float v) { asm volatile("global_atomic_add_f32 %0, %1, off sc1" :: "v"(p), "v"(v) : "memory"); }
template <bool ATOMIC = false> struct EpiResT {
    static constexpr bool PERM = true, AFTER_DRAIN = false;
    const float* xin; float* xout; const float* gate; int row_base;
    __device__ __forceinline__ void operator()(const f32x4 (&acc)[2][2][4][2], const Unit& u, int wr, int wc, int fr, int fq) const {
        const int row0 = row_base + u.pm * BM + wr * 64 + fr, col0 = u.pn * BM + wc * 32 + 8 * fq;
        const int mrow = row0 < 32768 ? (row0 >> 11) : 16;
        const float* gp = gate + (size_t)mrow * 12288 + col0;
        f32x4 gv[2][2];
#pragma unroll
        for (int bj = 0; bj < 2; ++bj)
#pragma unroll
            for (int n = 0; n < 2; ++n) gv[bj][n] = *(const f32x4*)(gp + bj * HALF + n * 4);
#pragma unroll
        for (int ai = 0; ai < 2; ++ai) {
            f32x4 xv[4][2][2];
#pragma unroll
            for (int m = 0; m < 4; ++m) { const size_t off = (size_t)(row0 + ai * HALF + m * 16) * 2048 + col0;
#pragma unroll
                for (int bj = 0; bj < 2; ++bj)
#pragma unroll
                    for (int n = 0; n < 2; ++n) xv[m][bj][n] = *(const f32x4*)(xin + off + bj * HALF + n * 4); }
#pragma unroll
            for (int m = 0; m < 4; ++m) { const size_t off = (size_t)(row0 + ai * HALF + m * 16) * 2048 + col0;
#pragma unroll
                for (int bj = 0; bj < 2; ++bj)
#pragma unroll
                    for (int n = 0; n < 2; ++n) *(f32x4*)(xout + off + bj * HALF + n * 4) = xv[m][bj][n] + gv[bj][n] * acc[ai][bj][m][n]; }
            asm volatile("" ::: "memory");
        }
    }
};
typedef EpiResT<false> EpiRes;
__device__ __forceinline__ float sigm(float x) { return __builtin_amdgcn_rcpf(1.f + __expf(-x)); }
struct EpiGlu {
    static constexpr bool PERM = true, AFTER_DRAIN = false;
    const bf16_t* A5; bf16_t* Y; int ldy; const float* bias;
    __device__ __forceinline__ void operator()(const f32x4 (&acc)[2][2][4][2], const Unit& u, int wr, int wc, int fr, int fq) const {
        const int row0 = u.pm * BM + wr * 64 + fr, col0 = u.pn * BM + wc * 32 + 8 * fq;
        f32x4 bv[2][2];
#pragma unroll
        for (int bj = 0; bj < 2; ++bj)
#pragma unroll
            for (int n = 0; n < 2; ++n) bv[bj][n] = *(const f32x4*)(bias + col0 + bj * HALF + 4 * n);
#pragma unroll
        for (int ai = 0; ai < 2; ++ai)
#pragma unroll
            for (int m = 0; m < 4; ++m) { const int row = row0 + ai * HALF + m * 16;
#pragma unroll
                for (int bj = 0; bj < 2; ++bj) { const u32x4 aw = *(const u32x4*)(A5 + (size_t)row * 512 + col0 + bj * HALF);
                    const f32x4 v0 = acc[ai][bj][m][0] + bv[bj][0], v1 = acc[ai][bj][m][1] + bv[bj][1];
                    const float a0 = bf_lo(aw.x), a1 = bf_hi(aw.x), a2 = bf_lo(aw.y), a3 = bf_hi(aw.y), a4 = bf_lo(aw.z), a5 = bf_hi(aw.z), a6 = bf_lo(aw.w), a7 = bf_hi(aw.w);
                    u32x4 w; w.x = cvt_pk_bf16(a0 * sigm(v0[0]), a1 * sigm(v0[1])); w.y = cvt_pk_bf16(a2 * sigm(v0[2]), a3 * sigm(v0[3]));
                    w.z = cvt_pk_bf16(a4 * sigm(v1[0]), a5 * sigm(v1[1])); w.w = cvt_pk_bf16(a6 * sigm(v1[2]), a7 * sigm(v1[3]));
                    *(u32x4*)(Y + (size_t)row * ldy + col0 + bj * HALF) = w; } }
    }
};
struct EpiLru {
    static constexpr bool PERM = true, AFTER_DRAIN = false;
    const bf16_t* XS; bf16_t* LOGA; bf16_t* GB; const float* cst;
    __device__ __forceinline__ void operator()(const f32x4 (&acc)[2][2][4][2], const Unit& u, int wr, int wc, int fr, int fq) const {
        const int row0 = u.pm * BM + wr * 64 + fr, d = u.pn >> 2, nb = u.pn & 3, ch0 = nb * 128 + wc * 32 + 8 * fq;
        const float* cp = cst + d * 512 + ch0;
#pragma unroll
        for (int ai = 0; ai < 2; ++ai)
#pragma unroll
            for (int m = 0; m < 4; ++m) { const int row = row0 + ai * HALF + m * 16;
                const u32x4 xw = *(const u32x4*)(XS + (size_t)row * 512 + ch0);
                const float xs[8] = {bf_lo(xw.x), bf_hi(xw.x), bf_lo(xw.y), bf_hi(xw.y), bf_lo(xw.z), bf_hi(xw.z), bf_lo(xw.w), bf_hi(xw.w)};
                u32x4 w1, w2;
#pragma unroll
                for (int n = 0; n < 2; ++n) { const f32x4 bav = *(const f32x4*)(cp + 4 * n), bxv = *(const f32x4*)(cp + 1024 + 4 * n), spv = *(const f32x4*)(cp + 2048 + 4 * n);
                    float la[4], gb[4];
#pragma unroll
                    for (int i = 0; i < 4; ++i) { const float r = sigm(acc[ai][0][m][n][i] + bav[i]), ig = sigm(acc[ai][1][m][n][i] + bxv[i]); const float l = -8.f * r * spv[i];
                        la[i] = l; const float x2 = 2.f * l;
                        const float em = -x2 * (1.f + 0.5f * x2 * (1.f + (1.f / 3.f) * x2 * (1.f + 0.25f * x2 * (1.f + 0.2f * x2 * (1.f + (1.f / 6.f) * x2)))));
                        gb[i] = __builtin_amdgcn_sqrtf(fmaxf(x2 > -0.25f ? em : 1.f - __expf(x2), 0.f)) * (ig * xs[4 * n + i]); }
                    w1[2 * n] = cvt_pk_bf16(la[0], la[1]); w1[2 * n + 1] = cvt_pk_bf16(la[2], la[3]); w2[2 * n] = cvt_pk_bf16(gb[0], gb[1]); w2[2 * n + 1] = cvt_pk_bf16(gb[2], gb[3]); }
                *(u32x4*)(LOGA + (size_t)row * 1024 + d * 512 + ch0) = w1; *(u32x4*)(GB + (size_t)row * 1024 + d * 512 + ch0) = w2;
                asm volatile("" ::: "memory"); }
    }
};
struct EpiNull {
    static constexpr bool PERM = false, AFTER_DRAIN = false;
    __device__ __forceinline__ void operator()(const f32x4 (&acc)[2][2][4][2], const Unit& u, int wr, int wc, int fr, int fq) const {
#pragma unroll
        for (int ai = 0; ai < 2; ++ai)
#pragma unroll
            for (int bj = 0; bj < 2; ++bj)
#pragma unroll
                for (int m = 0; m < 4; ++m)
#pragma unroll
                    for (int n = 0; n < 2; ++n) asm volatile("" :: "v"(acc[ai][bj][m][n]));
    }
};

template <bool XIN_F32> struct EpiResNT {
    static constexpr bool PERM = true, AFTER_DRAIN = false;
    const void* xin; const void* xin_ctx; bf16_t* xout; const float* gate; int row_base;
    bf16_t* H; const float* nw; const float* nscale; float* SSP;
    __device__ __forceinline__ void operator()(const f32x4 (&acc)[2][2][4][2], const Unit& u, int wr, int wc, int fr, int fq) const {
        const int row0 = row_base + u.pm * BM + wr * 64 + fr, col0 = u.pn * BM + wc * 32 + 8 * fq, lane = fq * 16 + fr;
        const int mrow = row0 < 32768 ? (row0 >> 11) : 16;
        const float* gp = gate + (size_t)mrow * 12288 + col0; const float* sp = nscale + (size_t)mrow * 12288 + col0; const void* xb = row0 < 32768 ? xin : xin_ctx;
        f32x4 gv[2][2], hs[2][2];
#pragma unroll
        for (int bj = 0; bj < 2; ++bj)
#pragma unroll
            for (int n = 0; n < 2; ++n) { gv[bj][n] = *(const f32x4*)(gp + bj * HALF + n * 4); hs[bj][n] = *(const f32x4*)(nw + col0 + bj * HALF + n * 4) * (*(const f32x4*)(sp + bj * HALF + n * 4) + 1.f); }
        constexpr int NB_ = XIN_F32 ? 4 : 2, MB_ = XIN_F32 ? 2 : 4;
#pragma unroll
        for (int am = 0; am < NB_; ++am) {
            const int ai = XIN_F32 ? (am >> 1) : am, mb = XIN_F32 ? 2 * (am & 1) : 0;
            f32x4 xv[XIN_F32 ? 2 : 1][2][2]; u32x4 xw[XIN_F32 ? 1 : 4][2];
#pragma unroll
            for (int mm = 0; mm < MB_; ++mm) { const int rowl = row0 + ai * HALF + (mb + mm) * 16; const size_t off = (size_t)rowl * 2048 + col0;
#pragma unroll
                for (int bj = 0; bj < 2; ++bj) {
                    if constexpr (XIN_F32) {
#pragma unroll
                        for (int n = 0; n < 2; ++n) xv[mm][bj][n] = *(const f32x4*)((const float*)xb + off + bj * HALF + n * 4); }
                    else xw[mm][bj] = *(const u32x4*)((const bf16_t*)xb + blk_off(rowl, col0, 8) + bj * HALF); } }
#pragma unroll
            for (int mm = 0; mm < MB_; ++mm) { const int m = mb + mm; const int row = row0 + ai * HALF + m * 16; const size_t off = blk_off(row, col0, 8); float ss = 0.f;
#pragma unroll
                for (int bj = 0; bj < 2; ++bj) { u32x4 w, xo;
#pragma unroll
                    for (int n = 0; n < 2; ++n) { f32x4 xi;
                        if constexpr (XIN_F32) xi = xv[mm][bj][n]; else xi = (f32x4){bf_lo(xw[mm][bj][2 * n]), bf_hi(xw[mm][bj][2 * n]), bf_lo(xw[mm][bj][2 * n + 1]), bf_hi(xw[mm][bj][2 * n + 1])};
                        const f32x4 xn = xi + gv[bj][n] * acc[ai][bj][m][n];
                        xo[2 * n] = cvt_pk_bf16(xn[0], xn[1]); xo[2 * n + 1] = cvt_pk_bf16(xn[2], xn[3]);
                        ss += (xn[0] * xn[0] + xn[1] * xn[1]) + (xn[2] * xn[2] + xn[3] * xn[3]);
                        const f32x4 hv = xn * hs[bj][n]; w[2 * n] = cvt_pk_bf16(hv[0], hv[1]); w[2 * n + 1] = cvt_pk_bf16(hv[2], hv[3]); }
                    st_stream((u32x4*)(xout + off + bj * HALF), xo);
                    st_stream((u32x4*)(H + off + bj * HALF), w); }
                ss += __builtin_bit_cast(float, __builtin_amdgcn_ds_bpermute((lane ^ 16) << 2, __builtin_bit_cast(int, ss)));
                ss += __builtin_bit_cast(float, __builtin_amdgcn_ds_bpermute((lane ^ 32) << 2, __builtin_bit_cast(int, ss)));
                if (fq == 0) SSP[(size_t)row * 32 + u.pn * 4 + wc] = ss; }
            asm volatile("" ::: "memory");
        }
    }
};
typedef EpiResNT<true> EpiResNF; typedef EpiResNT<false> EpiResN;
struct EpiResOut {
    static constexpr bool PERM = true, AFTER_DRAIN = false;
    const bf16_t* xin; float* xout; const float* gate; int row_base;
    __device__ __forceinline__ void operator()(const f32x4 (&acc)[2][2][4][2], const Unit& u, int wr, int wc, int fr, int fq) const {
        const int row0 = row_base + u.pm * BM + wr * 64 + fr, col0 = u.pn * BM + wc * 32 + 8 * fq;
        const int mrow = row0 < 32768 ? (row0 >> 11) : 16;
        const float* gp = gate + (size_t)mrow * 12288 + col0;
        f32x4 gv[2][2];
#pragma unroll
        for (int bj = 0; bj < 2; ++bj)
#pragma unroll
            for (int n = 0; n < 2; ++n) gv[bj][n] = *(const f32x4*)(gp + bj * HALF + n * 4);
#pragma unroll
        for (int ai = 0; ai < 2; ++ai) {
            u32x4 xw[4][2];
#pragma unroll
            for (int m = 0; m < 4; ++m) { const size_t off = blk_off(row0 + ai * HALF + m * 16, col0, 8);
#pragma unroll
                for (int bj = 0; bj < 2; ++bj) xw[m][bj] = *(const u32x4*)(xin + off + bj * HALF); }
#pragma unroll
            for (int m = 0; m < 4; ++m) { const size_t off = (size_t)(row0 + ai * HALF + m * 16) * 2048 + col0;
#pragma unroll
                for (int bj = 0; bj < 2; ++bj)
#pragma unroll
                    for (int n = 0; n < 2; ++n) { const f32x4 xi = (f32x4){bf_lo(xw[m][bj][2 * n]), bf_hi(xw[m][bj][2 * n]), bf_lo(xw[m][bj][2 * n + 1]), bf_hi(xw[m][bj][2 * n + 1])};
                        *(f32x4*)(xout + off + bj * HALF + n * 4) = xi + gv[bj][n] * acc[ai][bj][m][n]; } }
            asm volatile("" ::: "memory");
        }
    }
};
struct EpiStoreN {
    static constexpr bool PERM = true, AFTER_DRAIN = false;
    bf16_t* O; int ldc; const float* rstd; const float* shw; int ldshw;
    __device__ __forceinline__ void operator()(const f32x4 (&acc)[2][2][4][2], const Unit& u, int wr, int wc, int fr, int fq) const {
        const int row0 = u.pm * BM + wr * 64 + fr, col0 = u.pn * BM + wc * 32 + 8 * fq;
        const int mrow = row0 < 32768 ? (row0 >> 11) : 16;
        f32x4 sv[2][2];
#pragma unroll
        for (int bj = 0; bj < 2; ++bj)
#pragma unroll
            for (int n = 0; n < 2; ++n) sv[bj][n] = *(const f32x4*)(shw + (size_t)mrow * ldshw + col0 + bj * HALF + 4 * n);
#pragma unroll
        for (int ai = 0; ai < 2; ++ai)
#pragma unroll
            for (int m = 0; m < 4; ++m) { const int row = row0 + ai * HALF + m * 16; const float rs = rstd[row]; bf16_t* rowp = O + (size_t)row * ldc + col0;
#pragma unroll
                for (int bj = 0; bj < 2; ++bj) { const f32x4 v0 = acc[ai][bj][m][0] * rs + sv[bj][0], v1 = acc[ai][bj][m][1] * rs + sv[bj][1];
                    u32x4 w; w.x = cvt_pk_bf16(v0[0], v0[1]); w.y = cvt_pk_bf16(v0[2], v0[3]); w.z = cvt_pk_bf16(v1[0], v1[1]); w.w = cvt_pk_bf16(v1[2], v1[3]);
                    st_stream((u32x4*)(rowp + bj * HALF), w); } }
    }
};
struct EpiRelu2N {
    static constexpr bool PERM = true, AFTER_DRAIN = false;
    bf16_t* O; int ldc; const float* rstd; const float* shw; int ldshw; int row_base;
    __device__ __forceinline__ void operator()(const f32x4 (&acc)[2][2][4][2], const Unit& u, int wr, int wc, int fr, int fq) const {
        const int row0 = u.pm * BM + wr * 64 + fr, col0 = u.pn * BM + wc * 32 + 8 * fq, grow0 = row_base + row0;
        const int mrow = grow0 < 32768 ? (grow0 >> 11) : 16;
        f32x4 sv[2][2];
#pragma unroll
        for (int bj = 0; bj < 2; ++bj)
#pragma unroll
            for (int n = 0; n < 2; ++n) sv[bj][n] = *(const f32x4*)(shw + (size_t)mrow * ldshw + col0 + bj * HALF + 4 * n);
#pragma unroll
        for (int ai = 0; ai < 2; ++ai)
#pragma unroll
            for (int m = 0; m < 4; ++m) { const int row = row0 + ai * HALF + m * 16; const float rs = rstd[row_base + row]; bf16_t* rowp = O + blk_off(row, col0, ldc >> 8);
#pragma unroll
                for (int bj = 0; bj < 2; ++bj) { f32x4 v0 = acc[ai][bj][m][0] * rs + sv[bj][0], v1 = acc[ai][bj][m][1] * rs + sv[bj][1];
#pragma unroll
                    for (int j = 0; j < 4; ++j) { const float a = fmaxf(v0[j], 0.f), b = fmaxf(v1[j], 0.f); v0[j] = a * a; v1[j] = b * b; }
                    u32x4 w; w.x = cvt_pk_bf16(v0[0], v0[1]); w.y = cvt_pk_bf16(v0[2], v0[3]); w.z = cvt_pk_bf16(v1[0], v1[1]); w.w = cvt_pk_bf16(v1[2], v1[3]);
                    *(u32x4*)(rowp + bj * HALF) = w; } }
    }
};

struct EpiPart {
    static constexpr bool PERM = false, AFTER_DRAIN = false, VIRT = true;
    float* P; int ntile; int rows;
    __device__ __forceinline__ void operator()(const f32x4 (&acc)[2][2][4][2], const Unit& u, int wr, int wc, int fr, int fq) const {
        const int slice = u.pn / ntile, pn = u.pn % ntile, ld = 256 * ntile;
        const int row0 = u.pm * BM + wr * 64 + fr, col0 = pn * BM + wc * 32 + 4 * fq; float* base = P + (size_t)slice * rows * ld;
#pragma unroll
        for (int ai = 0; ai < 2; ++ai)
#pragma unroll
            for (int m = 0; m < 4; ++m) { float* rowp = base + (size_t)(row0 + ai * HALF + m * 16) * ld + col0;
#pragma unroll
                for (int bj = 0; bj < 2; ++bj)
#pragma unroll
                    for (int n = 0; n < 2; ++n) *(f32x4*)(rowp + bj * HALF + n * 16) = acc[ai][bj][m][n]; }
    }
};
template <class T, class = void> struct epi_virt { static constexpr bool value = false; };
template <class T> struct epi_virt<T, decltype((void)T::VIRT)> { static constexpr bool value = true; };
template <class Epi, class Sched, bool ALIGN_EPI = false, bool SP2 = false, int NSP = 0>
__device__ __forceinline__ void gemm_phase(PG8_LAS unsigned char* lds, const Gemm g, const Sched& S, const Epi& E, const int tid_in) {
    const int tid = tid_in,
    wid = __builtin_amdgcn_readfirstlane(tid >> 6), lane = tid & 63, wr = wid >> 2, wc = wid & 3, fr = lane & 15, fq = lane >> 4;
    const int K = g.K, nt = K / BK, LD = g.ld ? g.ld : g.K;
    const bool ablk = BLK_LAYOUT && g.ablk; const int LDA = ablk ? 256 : LD;
    unsigned voffA[2], voffB[2];
#pragma unroll
    for (int i = 0; i < 2; ++i) { int R, C; stage_rc(tid * 16 + i * 8192, R, C); const int Rb = Epi::PERM ? ((R & ~31) + perm32(R & 31)) : R;
        voffA[i] = (unsigned)(R * LDA + C) * 2u; voffB[i] = (unsigned)(Rb * LD + C) * 2u; }
    const size_t kstep = (size_t)(BK * 2);
    const size_t hstep = (size_t)HALF * LD * 2;
    const size_t hstepA = (size_t)HALF * LDA * 2;
#define PG8_KOFF(t) (ablk ? (((size_t)((t) >> 2) << 17) + (size_t)(((t) & 3) << 7)) : (size_t)(t) * kstep)
    const size_t tstep = 2 * hstep;
    const unsigned ldsw = (unsigned)wid * 1024u;
    const int aoff = lds_byte(wr * 64 + fr, fq * 8), boff = lds_byte(wc * 32 + fr, fq * 8);
#define PG8_SA(b, h) (((b) * 2 + (h)) * HTB)
#define PG8_SB(b, h) ((4 + (b) * 2 + (h)) * HTB)
#define PG8_STAGE(bufoff, gbase, voff) do { _Pragma("unroll") for (int _i = 0; _i < 2; ++_i) \
        __builtin_amdgcn_global_load_lds((const unsigned*)((const char*)(gbase) + (voff)[_i]), (PG8_LAS unsigned*)(lds + (bufoff) + ldsw + _i * 8192), 16, 0, 0); } while (0)
#define PG8_LDA(dst, b, h) do { _Pragma("unroll") for (int m = 0; m < 4; ++m) _Pragma("unroll") for (int k = 0; k < 2; ++k) dst[m][k] = *(const PG8_LAS bf16x8*)(lds + PG8_SA(b, h) + aoff + m * 2048 + k * 1024); } while (0)
#define PG8_LDB(dst, b, h) do { _Pragma("unroll") for (int n = 0; n < 2; ++n) _Pragma("unroll") for (int k = 0; k < 2; ++k) dst[n][k] = *(const PG8_LAS bf16x8*)(lds + PG8_SB(b, h) + boff + n * 2048 + k * 1024); } while (0)
#define PG8_MMA(ai, bj, At, Bt) do { __builtin_amdgcn_s_setprio(1); _Pragma("unroll") for (int m = 0; m < 4; ++m) _Pragma("unroll") for (int n = 0; n < 2; ++n) _Pragma("unroll") for (int k = 0; k < 2; ++k) \
        acc[ai][bj][m][n] = __builtin_amdgcn_mfma_f32_16x16x32_bf16(Bt[n][k], At[m][k], acc[ai][bj][m][n], 0, 0, 0); __builtin_amdgcn_s_setprio(0); } while (0)
#define PG8_WAIT_V(n) asm volatile("s_waitcnt vmcnt(" #n ")" ::: "memory")
#define PG8_WAIT_L(n) asm volatile("s_waitcnt lgkmcnt(" #n ")" ::: "memory")
#define PG8_BAR __builtin_amdgcn_s_barrier()
#define PG8_SCHED __builtin_amdgcn_sched_barrier(0)
    Unit cur, nxt; int ui = 0;
    if (!S.next(0, cur)) return;
    f32x4 acc[2][2][4][2];
    float zf = 0.f; asm volatile("" : "+v"(zf));
    const f32x4 zero4 = (f32x4){zf, zf, zf, zf};
#pragma unroll
    for (int a = 0; a < 2; ++a)
#pragma unroll
        for (int b = 0; b < 2; ++b)
#pragma unroll
            for (int m = 0; m < 4; ++m)
#pragma unroll
                for (int n = 0; n < 2; ++n) acc[a][b][m][n] = zero4;
    bf16x8 At[4][2], B0[2][2], B1[2][2];
#define PG8_SLICE(u) (NSP > 0 ? (u).pn / NSP : (NSP < 0 ? ((u).pn & (-NSP - 1)) : 0))
#define PG8_PNR(u) (NSP > 0 ? (u).pn % NSP : (u).pn)
#define PG8_ABASE(u) ((const char*)g.A + (size_t)(u).pm * tstep + (size_t)PG8_SLICE(u) * K * (ablk ? 512 : 2))
#define PG8_BBASE(u) ((const char*)g.Bt + (size_t)PG8_PNR(u) * tstep + (size_t)PG8_SLICE(u) * K * 2)
    const char* cA = PG8_ABASE(cur); const char* cB = PG8_BBASE(cur);
    S.a_ready(cur);
    if constexpr (SP2) {
        PG8_STAGE(PG8_SB(0, 0), cB, voffB); PG8_STAGE(PG8_SB(0, 1), cB + hstep, voffB); PG8_STAGE(PG8_SA(0, 0), cA, voffA); PG8_STAGE(PG8_SA(0, 1), cA + hstepA, voffA);
        if (wr == 1) PG8_BAR;
        PG8_WAIT_V(2); PG8_BAR;
        PG8_STAGE(PG8_SB(1, 0), cB + kstep, voffB); PG8_STAGE(PG8_SA(1, 0), cA + kstep, voffA); PG8_STAGE(PG8_SB(1, 1), cB + hstep + kstep, voffB);
        PG8_WAIT_V(6); PG8_BAR;
    } else {
        PG8_STAGE(PG8_SB(0, 0), cB, voffB); PG8_STAGE(PG8_SA(0, 0), cA, voffA); PG8_STAGE(PG8_SB(0, 1), cB + hstep, voffB); PG8_STAGE(PG8_SA(0, 1), cA + hstepA, voffA);
        if (wr == 1) PG8_BAR;
        PG8_WAIT_V(4); PG8_BAR;
        PG8_STAGE(PG8_SB(1, 0), cB + kstep, voffB); PG8_STAGE(PG8_SA(1, 0), cA + kstep, voffA); PG8_STAGE(PG8_SB(1, 1), cB + hstep + kstep, voffB);
        PG8_WAIT_V(6); PG8_BAR;
    }
    for (;;) {
        const bool has_next = S.next(ui + 1, nxt);
        const char* nA = has_next ? PG8_ABASE(nxt) : cA; const char* nB = has_next ? PG8_BBASE(nxt) : cB;
        for (int t = 0; t < nt; t += 2) {
            const bool last = (t == nt - 2);
            const char* a1 = cA + PG8_KOFF(t) + kstep;
            const char* a2 = last ? nA : cA + PG8_KOFF(t + 2); const char* b2 = last ? nB : cB + (size_t)(t + 2) * kstep;
            const char* a3 = a2 + kstep; const char* b3 = b2 + kstep;
            if (last && has_next) S.a_ready(nxt);
            if constexpr (SP2) {
            PG8_LDB(B0, 0, 0); PG8_LDB(B1, 0, 1); PG8_SCHED; PG8_LDA(At, 0, 0); PG8_STAGE(PG8_SA(1, 1), a1 + hstepA, voffA);
            PG8_WAIT_V(8); PG8_WAIT_L(0); PG8_BAR; PG8_MMA(0, 0, At, B0); PG8_MMA(0, 1, At, B1); PG8_BAR; PG8_SCHED;
            PG8_LDA(At, 0, 1); PG8_STAGE(PG8_SB(0, 0), b2, voffB); PG8_STAGE(PG8_SB(0, 1), b2 + hstep, voffB); PG8_STAGE(PG8_SA(0, 0), a2, voffA);
            PG8_WAIT_V(8); PG8_WAIT_L(0); PG8_BAR; PG8_MMA(1, 0, At, B0); PG8_MMA(1, 1, At, B1); PG8_BAR; PG8_SCHED;
            PG8_LDB(B0, 1, 0); PG8_LDB(B1, 1, 1); PG8_SCHED; PG8_LDA(At, 1, 0); PG8_STAGE(PG8_SA(0, 1), a2 + hstepA, voffA);
            PG8_WAIT_V(8); PG8_WAIT_L(0); PG8_BAR; PG8_MMA(0, 0, At, B0); PG8_MMA(0, 1, At, B1); PG8_BAR; PG8_SCHED;
            PG8_LDA(At, 1, 1); PG8_STAGE(PG8_SB(1, 0), b3, voffB); PG8_STAGE(PG8_SB(1, 1), b3 + hstep, voffB); PG8_STAGE(PG8_SA(1, 0), a3, voffA);
            PG8_WAIT_V(8); PG8_WAIT_L(0); PG8_BAR; PG8_MMA(1, 0, At, B0); PG8_MMA(1, 1, At, B1); PG8_BAR; PG8_SCHED;
            } else {
            PG8_LDB(B0, 0, 0); PG8_SCHED; PG8_LDA(At, 0, 0); PG8_STAGE(PG8_SA(1, 1), a1 + hstepA, voffA);
            PG8_WAIT_L(8); PG8_BAR; PG8_WAIT_L(0); PG8_MMA(0, 0, At, B0); PG8_BAR; PG8_SCHED;
            PG8_LDB(B1, 0, 1); PG8_STAGE(PG8_SB(0, 0), b2, voffB);
            PG8_BAR; PG8_WAIT_L(0); PG8_MMA(0, 1, At, B1); PG8_BAR;
            PG8_LDA(At, 0, 1); PG8_STAGE(PG8_SA(0, 0), a2, voffA);
            PG8_BAR; PG8_WAIT_L(0); PG8_MMA(1, 0, At, B0); PG8_BAR; PG8_SCHED;
            PG8_STAGE(PG8_SB(0, 1), b2 + hstep, voffB);
            PG8_WAIT_V(6); PG8_BAR; PG8_MMA(1, 1, At, B1); PG8_BAR;
            PG8_LDB(B0, 1, 0); PG8_SCHED; PG8_LDA(At, 1, 0); PG8_STAGE(PG8_SA(0, 1), a2 + hstepA, voffA);
            PG8_WAIT_L(8); PG8_BAR; PG8_WAIT_L(0); PG8_MMA(0, 0, At, B0); PG8_BAR; PG8_SCHED;
            PG8_LDB(B1, 1, 1); PG8_STAGE(PG8_SB(1, 0), b3, voffB);
            PG8_BAR; PG8_WAIT_L(0); PG8_MMA(0, 1, At, B1); PG8_BAR;
            PG8_LDA(At, 1, 1); PG8_STAGE(PG8_SA(1, 0), a3, voffA);
            PG8_BAR; PG8_WAIT_L(0); PG8_MMA(1, 0, At, B0); PG8_BAR; PG8_SCHED;
            PG8_STAGE(PG8_SB(1, 1), b3 + hstep, voffB);
            PG8_WAIT_V(6); PG8_BAR; PG8_MMA(1, 1, At, B1); PG8_BAR;
            }
        }
        if constexpr (ALIGN_EPI) { if (wr == 0) PG8_BAR; }
        if constexpr (!Epi::AFTER_DRAIN) { if constexpr (epi_virt<Epi>::value) E(acc, cur, wr, wc, fr, fq); else { const Unit eu{cur.pm, PG8_PNR(cur)}; E(acc, eu, wr, wc, fr, fq); } S.done(cur); }
        if (!has_next) break;
#pragma unroll
        for (int a = 0; a < 2; ++a)
#pragma unroll
            for (int b = 0; b < 2; ++b)
#pragma unroll
                for (int m = 0; m < 4; ++m)
#pragma unroll
                    for (int n = 0; n < 2; ++n) acc[a][b][m][n] = zero4;
        cur = nxt; cA = nA; cB = nB; ++ui;
        if constexpr (ALIGN_EPI) { if (wr == 1) PG8_BAR; }
    }
    PG8_WAIT_V(0);
    if constexpr (!ALIGN_EPI) { if (wr == 0) PG8_BAR; }
    PG8_BAR;
    if constexpr (Epi::AFTER_DRAIN) { E.fused(acc, cur, wr, wc, fr, fq, lds, wid, lane); S.done(cur); }
#undef PG8_SLICE
#undef PG8_PNR
#undef PG8_KOFF
#undef PG8_ABASE
#undef PG8_BBASE
#undef PG8_SA
#undef PG8_SB
#undef PG8_STAGE
#undef PG8_LDA
#undef PG8_LDB
#undef PG8_MMA
#undef PG8_WAIT_V
#undef PG8_WAIT_L
#undef PG8_BAR
#undef PG8_SCHED
}
}
namespace pg8 {
struct GrpDesc { const bf16_t* A; const bf16_t* Bt; int M, N, K, ld, bdiag; };
struct GUnit { int pm, pn, grp; };
__device__ __forceinline__ bool static_map(long L, int nM, int nN, Unit& u) {
    const int nwg = nM * nN; if (L >= nwg) return false;
    int wgid = (int)L; { const int q = nwg / NXCD, r = nwg % NXCD, xcd = wgid % NXCD, off = wgid / NXCD; wgid = (xcd < r ? xcd * (q + 1) : r * (q + 1) + (xcd - r) * q) + off; }
    const int nig = WGM * nN, gid = wgid / nig, fm = gid * WGM, gsz = (nM - fm) < WGM ? (nM - fm) : WGM;
    u.pm = fm + ((wgid % nig) % gsz); u.pn = (wgid % nig) / gsz; return true;
}
template <class E0, class E1, class E2>
__device__ __forceinline__ void gemm_group3(PG8_LAS unsigned char* lds, const GrpDesc g0, const GrpDesc g1, const GrpDesc g2, const E0& e0, const E1& e1, const E2& e2, const int Gn, const int c, const int tid_in) {
    static_assert(E0::PERM && E1::PERM && E2::PERM, "gemm_group3: the three epilogues must share the permuted weight staging");
    const int tid = tid_in, wid = __builtin_amdgcn_readfirstlane(tid >> 6), lane = tid & 63, wr = wid >> 2, wc = wid & 3, fr = lane & 15, fq = lane >> 4;
    const int n0 = (g0.M / BM) * (g0.N / BM), n1 = (g1.M / BM) * (g1.N / BM), n2 = (g2.M / BM) * (g2.N / BM);
    int sR[2], sRb[2], sC[2];
#pragma unroll
    for (int i = 0; i < 2; ++i) { int R, C; stage_rc(tid * 16 + i * 8192, R, C); sR[i] = R; sRb[i] = (R & ~31) + perm32(R & 31); sC[i] = C; }
    const size_t kstep = (size_t)(BK * 2);
    const unsigned ldsw = (unsigned)wid * 1024u;
    const int aoff = lds_byte(wr * 64 + fr, fq * 8), boff = lds_byte(wc * 32 + fr, fq * 8);
#define PG8_SA(b, h) (((b) * 2 + (h)) * HTB)
#define PG8_SB(b, h) ((4 + (b) * 2 + (h)) * HTB)
#define PG8_STAGE(bufoff, gbase, voff) do { _Pragma("unroll") for (int _i = 0; _i < 2; ++_i) \
        __builtin_amdgcn_global_load_lds((const unsigned*)((const char*)(gbase) + (voff)[_i]), (PG8_LAS unsigned*)(lds + (bufoff) + ldsw + _i * 8192), 16, 0, 0); } while (0)
#define PG8_LDA(dst, b, h) do { _Pragma("unroll") for (int m = 0; m < 4; ++m) _Pragma("unroll") for (int k = 0; k < 2; ++k) dst[m][k] = *(const PG8_LAS bf16x8*)(lds + PG8_SA(b, h) + aoff + m * 2048 + k * 1024); } while (0)
#define PG8_LDB(dst, b, h) do { _Pragma("unroll") for (int n = 0; n < 2; ++n) _Pragma("unroll") for (int k = 0; k < 2; ++k) dst[n][k] = *(const PG8_LAS bf16x8*)(lds + PG8_SB(b, h) + boff + n * 2048 + k * 1024); } while (0)
#define PG8_MMA(ai, bj, At, Bt) do { __builtin_amdgcn_s_setprio(1); _Pragma("unroll") for (int m = 0; m < 4; ++m) _Pragma("unroll") for (int n = 0; n < 2; ++n) _Pragma("unroll") for (int k = 0; k < 2; ++k) \
        acc[ai][bj][m][n] = __builtin_amdgcn_mfma_f32_16x16x32_bf16(Bt[n][k], At[m][k], acc[ai][bj][m][n], 0, 0, 0); __builtin_amdgcn_s_setprio(0); } while (0)
#define PG8_WAIT_V(n) asm volatile("s_waitcnt vmcnt(" #n ")" ::: "memory")
#define PG8_WAIT_L(n) asm volatile("s_waitcnt lgkmcnt(" #n ")" ::: "memory")
#define PG8_BAR __builtin_amdgcn_s_barrier()
#define PG8_SCHED __builtin_amdgcn_sched_barrier(0)
#define PG8_GETUNIT(L, u, ok) do { Unit t_; const long L_ = (L); ok = true; \
        if (L_ < n0) { static_map(L_, g0.M / BM, g0.N / BM, t_); u.grp = 0; } else if (L_ < n0 + n1) { static_map(L_ - n0, g1.M / BM, g1.N / BM, t_); u.grp = 1; } \
        else if (L_ < n0 + n1 + n2) { static_map(L_ - n0 - n1, g2.M / BM, g2.N / BM, t_); u.grp = 2; } else { ok = false; t_.pm = 0; t_.pn = 0; u.grp = 0; } u.pm = t_.pm; u.pn = t_.pn; } while (0)
#define PG8_GSEL(u, f) ((u).grp == 0 ? g0.f : ((u).grp == 1 ? g1.f : g2.f))
#define PG8_SETUNIT(u, pA, pB, ntv, ldv) do { const int ld_ = PG8_GSEL(u, ld), K_ = PG8_GSEL(u, K), bd_ = PG8_GSEL(u, bdiag); const int sl_ = bd_ ? ((u).pn & (bd_ - 1)) : 0; \
        pA = (const char*)PG8_GSEL(u, A) + (size_t)(u).pm * (size_t)(2 * HALF) * ld_ * 2 + (size_t)sl_ * K_ * 2; pB = (const char*)PG8_GSEL(u, Bt) + (size_t)(u).pn * (size_t)(2 * HALF) * ld_ * 2 + (size_t)sl_ * K_ * 2; ntv = K_ / BK; ldv = ld_; } while (0)
#define PG8_SETVOFF(vA, vB, ldv) do { _Pragma("unroll") for (int i = 0; i < 2; ++i) { vA[i] = (unsigned)(sR[i] * (ldv) + sC[i]) * 2u; vB[i] = (unsigned)(sRb[i] * (ldv) + sC[i]) * 2u; } } while (0)
    GUnit cur, nxt; int ui = 0; bool ok;
    PG8_GETUNIT((long)c, cur, ok);
    if (!ok) return;
    f32x4 acc[2][2][4][2];
    float zf = 0.f; asm volatile("" : "+v"(zf));
    const f32x4 zero4 = (f32x4){zf, zf, zf, zf};
#pragma unroll
    for (int a = 0; a < 2; ++a)
#pragma unroll
        for (int b = 0; b < 2; ++b)
#pragma unroll
            for (int m = 0; m < 4; ++m)
#pragma unroll
                for (int n = 0; n < 2; ++n) acc[a][b][m][n] = zero4;
    bf16x8 At[4][2], B0[2][2], B1[2][2];
    const char* cA; const char* cB; int nt, ldc_; PG8_SETUNIT(cur, cA, cB, nt, ldc_);
    unsigned voffA[2], voffB[2]; PG8_SETVOFF(voffA, voffB, ldc_);
    size_t hstep = (size_t)HALF * ldc_ * 2;
    PG8_STAGE(PG8_SB(0, 0), cB, voffB); PG8_STAGE(PG8_SB(0, 1), cB + hstep, voffB); PG8_STAGE(PG8_SA(0, 0), cA, voffA); PG8_STAGE(PG8_SA(0, 1), cA + hstep, voffA);
    if (wr == 1) PG8_BAR;
    PG8_WAIT_V(2); PG8_BAR;
    PG8_STAGE(PG8_SB(1, 0), cB + kstep, voffB); PG8_STAGE(PG8_SA(1, 0), cA + kstep, voffA); PG8_STAGE(PG8_SB(1, 1), cB + hstep + kstep, voffB);
    PG8_WAIT_V(6); PG8_BAR;
    for (;;) {
        bool has_next; PG8_GETUNIT((long)(ui + 1) * Gn + c, nxt, has_next);
        const char* nA = cA; const char* nB = cB; int ntn = nt, ldn = ldc_;
        if (has_next) PG8_SETUNIT(nxt, nA, nB, ntn, ldn);
        unsigned voffAn[2], voffBn[2]; PG8_SETVOFF(voffAn, voffBn, ldn);
        const size_t hstepn = (size_t)HALF * ldn * 2;
        for (int t = 0; t < nt; t += 2) {
            const bool last = (t == nt - 2);
            const char* a1 = cA + (size_t)(t + 1) * kstep;
            const char* a2 = last ? nA : cA + (size_t)(t + 2) * kstep; const char* b2 = last ? nB : cB + (size_t)(t + 2) * kstep;
            const char* a3 = a2 + kstep; const char* b3 = b2 + kstep;
            unsigned vA2[2], vB2[2];
#pragma unroll
            for (int i = 0; i < 2; ++i) { vA2[i] = last ? voffAn[i] : voffA[i]; vB2[i] = last ? voffBn[i] : voffB[i]; }
            const size_t h2 = last ? hstepn : hstep;
            PG8_LDB(B0, 0, 0); PG8_LDB(B1, 0, 1); PG8_SCHED; PG8_LDA(At, 0, 0); PG8_STAGE(PG8_SA(1, 1), a1 + hstep, voffA);
            PG8_WAIT_V(8); PG8_WAIT_L(0); PG8_BAR; PG8_MMA(0, 0, At, B0); PG8_MMA(0, 1, At, B1); PG8_BAR; PG8_SCHED;
            PG8_LDA(At, 0, 1); PG8_STAGE(PG8_SB(0, 0), b2, vB2); PG8_STAGE(PG8_SB(0, 1), b2 + h2, vB2); PG8_STAGE(PG8_SA(0, 0), a2, vA2);
            PG8_WAIT_V(8); PG8_WAIT_L(0); PG8_BAR; PG8_MMA(1, 0, At, B0); PG8_MMA(1, 1, At, B1); PG8_BAR; PG8_SCHED;
            PG8_LDB(B0, 1, 0); PG8_LDB(B1, 1, 1); PG8_SCHED; PG8_LDA(At, 1, 0); PG8_STAGE(PG8_SA(0, 1), a2 + h2, vA2);
            PG8_WAIT_V(8); PG8_WAIT_L(0); PG8_BAR; PG8_MMA(0, 0, At, B0); PG8_MMA(0, 1, At, B1); PG8_BAR; PG8_SCHED;
            PG8_LDA(At, 1, 1); PG8_STAGE(PG8_SB(1, 0), b3, vB2); PG8_STAGE(PG8_SB(1, 1), b3 + h2, vB2); PG8_STAGE(PG8_SA(1, 0), a3, vA2);
            PG8_WAIT_V(8); PG8_WAIT_L(0); PG8_BAR; PG8_MMA(1, 0, At, B0); PG8_MMA(1, 1, At, B1); PG8_BAR; PG8_SCHED;
        }
        if (wr == 0) PG8_BAR;
        { const Unit eu{cur.pm, cur.pn};
          if (cur.grp == 0) e0(acc, eu, wr, wc, fr, fq); else if (cur.grp == 1) e1(acc, eu, wr, wc, fr, fq); else e2(acc, eu, wr, wc, fr, fq); }
        if (!has_next) break;
#pragma unroll
        for (int a = 0; a < 2; ++a)
#pragma unroll
            for (int b = 0; b < 2; ++b)
#pragma unroll
                for (int m = 0; m < 4; ++m)
#pragma unroll
                    for (int n = 0; n < 2; ++n) acc[a][b][m][n] = zero4;
        cur = nxt; cA = nA; cB = nB; nt = ntn; ldc_ = ldn; hstep = hstepn;
#pragma unroll
        for (int i = 0; i < 2; ++i) { voffA[i] = voffAn[i]; voffB[i] = voffBn[i]; }
        ++ui;
        if (wr == 1) PG8_BAR;
    }
    PG8_WAIT_V(0);
    PG8_BAR;
#undef PG8_GETUNIT
#undef PG8_GSEL
#undef PG8_SETUNIT
#undef PG8_SETVOFF
#undef PG8_SA
#undef PG8_SB
#undef PG8_STAGE
#undef PG8_LDA
#undef PG8_LDB
#undef PG8_MMA
#undef PG8_WAIT_V
#undef PG8_WAIT_L
#undef PG8_BAR
#undef PG8_SCHED
}
}
#define XB_TMO      128
#define XB_XCNT(j)  (256  + 64 * (j))
#define XB_XSUB(j)  (1280 + 64 * (j))
#define XB_XGEN(j)  (2304 + 64 * (j))
#define XB_TOP      3328
#define XB_TOPGEN   3392
#define XCD_BAR_WORDS 3456
#define XB_SPIN_CAP (1u << 18)

__device__ __forceinline__ unsigned xb_ld(unsigned* p)              { return __hip_atomic_load(p, __ATOMIC_RELAXED, __HIP_MEMORY_SCOPE_AGENT); }
__device__ __forceinline__ unsigned xb_add(unsigned* p, unsigned v) { return __hip_atomic_fetch_add(p, v, __ATOMIC_RELAXED, __HIP_MEMORY_SCOPE_AGENT); }
__device__ __forceinline__ unsigned xb_xcc_id() { return (unsigned)__builtin_amdgcn_s_getreg((3 << 11) | 20) & 0xFu; }
#define XB_SPIN(cond, bar) do { unsigned _sp = 0; while (cond) { __builtin_amdgcn_s_sleep(1); \
    if ((++_sp & 255u) == 0u) { if (xb_ld(&(bar)[XB_TMO])) break; if (_sp > XB_SPIN_CAP) { atomicAdd(&(bar)[XB_TMO], 1u); break; } } } } while (0)

struct XcdBarrier {
    unsigned* bar; unsigned x;
    volatile LAS unsigned* st;
};

__device__ __forceinline__ XcdBarrier xcd_barrier_post(unsigned* bar, volatile LAS unsigned* st) {
    XcdBarrier b; b.bar = bar; b.x = xb_xcc_id(); b.st = st;
    if (threadIdx.x == 0) (void)xb_add(&bar[XB_XCNT(b.x)], 1u);
    return b;
}
__device__ __forceinline__ void xcd_barrier_complete(unsigned* bar, unsigned x, unsigned& nloc, unsigned& nx) {
    const unsigned G = gridDim.x * gridDim.y * gridDim.z;
    unsigned sum, cnt, mine, sp = 0u;
    for (;;) {
        sum = 0u; cnt = 0u; mine = 0u;
#pragma unroll
        for (unsigned j = 0; j < 16; ++j) { const unsigned c = xb_ld(&bar[XB_XCNT(j)]); sum += c; cnt += (c > 0u) ? 1u : 0u; mine = (j == x) ? c : mine; }
        if (sum == G) break;
        __builtin_amdgcn_s_sleep(1);
        if ((++sp & 255u) == 0u) { if (xb_ld(&bar[XB_TMO])) break; if (sp > XB_SPIN_CAP) { atomicAdd(&bar[XB_TMO], 1u); break; } }
    }
    nloc = mine > 0u ? mine : 1u; nx = cnt > 0u ? cnt : 1u;
}

__device__ __forceinline__ void xcd_barrier(const XcdBarrier& b) {
    asm volatile("s_waitcnt vmcnt(0)" ::: "memory");
    __syncthreads();
    if (threadIdx.x == 0) {
        unsigned* bar = b.bar;
        __builtin_amdgcn_s_waitcnt(0);
        unsigned nloc = b.st[0], nx = b.st[1];
        if (nloc == 0u) { xcd_barrier_complete(bar, b.x, nloc, nx); b.st[0] = nloc; b.st[1] = nx; }
        const unsigned old = xb_add(&bar[XB_XSUB(b.x)], 1u);
        const unsigned gen = old / nloc;
        if (old + 1u == (gen + 1u) * nloc) {
            __builtin_amdgcn_fence(__ATOMIC_RELEASE, "agent");
            asm volatile("s_waitcnt vmcnt(0)" ::: "memory");
            const unsigned og = xb_add(&bar[XB_TOP], 1u);
            const unsigned tg = og / nx;
            if (og + 1u == (tg + 1u) * nx) xb_add(&bar[XB_TOPGEN], 1u);
            else XB_SPIN(xb_ld(&bar[XB_TOPGEN]) == tg, bar);
            __builtin_amdgcn_fence(__ATOMIC_ACQUIRE, "agent");
            xb_add(&bar[XB_XGEN(b.x)], 1u);
            asm volatile("s_waitcnt vmcnt(0)" ::: "memory");
        } else {
            XB_SPIN(xb_ld(&bar[XB_XGEN(b.x)]) == gen, bar);
            __builtin_amdgcn_fence(__ATOMIC_ACQUIRE, "agent");
            asm volatile("s_waitcnt vmcnt(0)" ::: "memory");
        }
    }
    __syncthreads();
}
struct Args { const float* in[N_IN]; float* out; unsigned char* ws; int lo, hi; };
static_assert(sizeof(Args) == (N_IN + 2) * 8 + 8, "Args has no holes");
struct Frame {
    LAS unsigned char* lds;
    volatile LAS unsigned* MISC;
    gu32* ctl;
    int tid, lane, wave, G, bid;
    unsigned char* ws;
    const __attribute__((address_space(4))) char* kp;
    float* out;
};
#define WSP(T, off) ((T*)(F.ws + (off)))
typedef const GAS float* gcfptr_t;
#define KIN(i) ((const float*)(*(const __attribute__((address_space(4))) gcfptr_t*)(F.kp + 8 * (i))))

template <class LhsFn> __device__ __forceinline__ void skinny17_task(Frame& F, LhsFn lhs, const float* W, int N, int n0, float* out, int ldo, const float* bias) {
    LAS float* sh = (LAS float*)(F.lds + RING_OFF);
    const int lane = F.lane, bi = lane & 31, hk = lane >> 5, col = n0 + 32 * F.wave + bi, cc = min(col, N - 1);
    f32x16 acc;
#pragma unroll
    for (int e = 0; e < 16; ++e) acc[e] = 0.f;
    for (int kh = 0; kh < 2; ++kh) {
        __syncthreads();
        for (int idx = F.tid; idx < 17 * 1024; idx += NTHR) { const int b = idx >> 10, kk = idx & 1023; sh[b * 1025 + kk] = lhs(b, kh * 1024 + kk); }
        __syncthreads();
        const float* wp = W + (size_t)(kh * 1024 + hk) * N + cc; const LAS float* ap = sh + (bi < 17 ? bi : 0) * 1025 + hk;
#pragma unroll 8
        for (int ks = 0; ks < 512; ++ks) { const float bv = wp[(size_t)(2 * ks) * N]; float av = ap[2 * ks]; av = bi < 17 ? av : 0.f;
            acc = __builtin_amdgcn_mfma_f32_32x32x2f32(av, bv, acc, 0, 0, 0); }
    }
    if (col < N) { const float bz = bias ? bias[col] : 0.f;
#pragma unroll
        for (int r = 0; r < 16; ++r) { const int b = (r & 3) + 8 * (r >> 2) + 4 * hk; if (b < 17) out[(size_t)b * ldo + col] = acc[r] + bz; } }
}
__device__ __forceinline__ void p0a_prologue(Frame& F, const float* c, const float* cctx, const float* adaw, const float* adab,
                                             const float* lre, const float* lim, const float* ldt, const float* bre, const float* bim, const float* cre, const float* cim) {
    for (int t = F.bid; t < DEPTH * 48; t += F.G) { const int l = t / 48, n0 = (t % 48) * 256;
        skinny17_task(F, [&](int b, int k) { const float v = b < NB ? c[b * DM + k] : cctx[k]; return v / (1.f + __expf(-v)); },
                      adaw + (size_t)l * DM * NMOD, NMOD, n0, WSP(float, WS_MODS) + (size_t)l * 17 * NMOD, NMOD, adab + (size_t)l * NMOD); }
    __syncthreads();
    { float* RT_ = WSP(float, WS_ROPE);
      for (int i = F.bid * NTHR + F.tid; i < 1024; i += F.G * NTHR) { const int pos = i >> 4, fi = i & 15; const float inv = exp2f(-(float)fi * (13.287712379549449f / 16.f));
          float sn, cs; sincosf((float)pos * inv, &sn, &cs); RT_[2 * i] = cs; RT_[2 * i + 1] = sn; } }
    {
        float* S5A = WSP(float, WS_S5A); bf16* BB = WSP(bf16, WS_S5BB); bf16* CM = WSP(bf16, WS_S5CM);
        for (int i = F.bid * NTHR + F.tid; i < DEPTH * 2 * 32 * 64; i += F.G * NTHR) {
            const int p = i & 63, ldg = i >> 6;
            const float lr = fminf(lre[i], -1e-4f), li = lim[i], dt = __expf(ldt[ldg]);
            const float mag = expf(lr * dt), ar = mag * cosf(li * dt), ai = mag * sinf(li * dt);
            const float den = lr * lr + li * li, fr = ((ar - 1.f) * lr + ai * li) / den, fi = (ai * lr - (ar - 1.f) * li) / den;
            S5A[(size_t)i * 2] = ar; S5A[(size_t)i * 2 + 1] = ai;
            const int kre = (p & 31) + 64 * (p >> 5), kim = kre + 32;
            const int hre = 2 * (p & 31) + 64 * (p >> 5), him = hre + 1;
#pragma unroll
            for (int cc = 0; cc < 16; ++cc) { const float br = bre[(size_t)i * 16 + cc], bi = bim[(size_t)i * 16 + cc];
                BB[((size_t)ldg * 128 + kre) * 16 + cc] = (bf16)f2bf(fr * br - fi * bi); BB[((size_t)ldg * 128 + kim) * 16 + cc] = (bf16)f2bf(fr * bi + fi * br);
                CM[((size_t)ldg * 16 + cc) * 128 + hre] = (bf16)f2bf(cre[((size_t)ldg * 16 + cc) * 64 + p]); CM[((size_t)ldg * 16 + cc) * 128 + him] = (bf16)f2bf(-cim[((size_t)ldg * 16 + cc) * 64 + p]); }
        }
    }
}
__device__ __forceinline__ void p0c_shw(Frame& F, const float* win_all, const float* w1_all) {
    const float* MODS = WSP(float, WS_MODS); float* SHW = WSP(float, WS_SHW);
    for (int t = F.bid; t < DEPTH * 49; t += F.G) { const int l = t / 49, g = t % 49; const bool is1 = g >= 17; const int ish = is1 ? 3 : 0;
        const float* mp = MODS + (size_t)l * 17 * NMOD + ish * DM;
        skinny17_task(F, [&](int b, int k) { return mp[(size_t)b * NMOD + k]; },
                      is1 ? w1_all + (size_t)l * DM * DFF : win_all + (size_t)l * DM * NZ, is1 ? DFF : NZ, (is1 ? g - 17 : g) * 256,
                      SHW + (size_t)l * 17 * (LDZ + DFF) + (is1 ? LDZ : 0), LDZ + DFF, nullptr); }
    __syncthreads();
}
__device__ __forceinline__ void norm0_phase(Frame& F, const float* x, const float* ctx, const float* w, const float* mods  ) {
    bf16* H = WSP(bf16, WS_H); float* RSTD = WSP(float, WS_RSTD);
    const int gw = F.bid * NWAVES + F.wave, NGW = F.G * NWAVES, lane = F.lane;
    for (int r = gw; r < RT; r += NGW) {
        const float* xrow = r < RL ? x + (size_t)r * DM : ctx + (size_t)(r - RL) * DM; const float* sc = mods + (size_t)mod_row(r) * NMOD + 1 * DM;
        const f32x4* xr = (const f32x4*)xrow + lane; f32x4 v[8]; float s = 0.f;
#pragma unroll
        for (int j = 0; j < 8; ++j) { v[j] = xr[64 * j]; s += (v[j].x * v[j].x + v[j].y * v[j].y) + (v[j].z * v[j].z + v[j].w * v[j].w); }
        s = wave_sum(s, lane);
        if (lane == 0) RSTD[r] = rsqrtf(s * (1.f / DM) + EPS);
        v2u* o8 = (v2u*)(H + blk_off(r, 0, 8)) + lane; constexpr int JS = BLK_LAYOUT ? 16384 : 64;
#pragma unroll
        for (int j = 0; j < 8; ++j) { const int cix = 64 * j + lane; const f32x4 y = v[j] * ((const f32x4*)w)[cix] * (((const f32x4*)sc)[cix] + 1.f); v2u o; o.x = pk2(y.x, y.y); o.y = pk2(y.z, y.w); o8[JS * j] = o; }
    }
}
__device__ __forceinline__ void ctxfix_phase(Frame& F, const float* gate  , const float* w, const float* sc  ) {
    bf16* X = WSP(bf16, WS_X); const float* P = WSP(float, WS_LOGA); bf16* H = WSP(bf16, WS_H); float* RSTD = WSP(float, WS_RSTD);
    const int gw = F.bid * NWAVES + F.wave, NGW = F.G * NWAVES, lane = F.lane;
    for (int rc = gw; rc < RC; rc += NGW) { const int r = RL + rc;
        v2u* xr = (v2u*)(X + blk_off(r, 0, 8)) + lane; constexpr int JS = BLK_LAYOUT ? 16384 : 64; const f32x4* p0 = (const f32x4*)(P + (size_t)rc * DM) + lane; const f32x4* p1 = (const f32x4*)(P + (size_t)(RC + rc) * DM) + lane;
        f32x4 v[8]; float s = 0.f;
#pragma unroll
        for (int j = 0; j < 8; ++j) { const int cix = 64 * j + lane; const v2u xw = xr[JS * j]; const f32x4 xi = (f32x4){bflo(xw.x), bfhi(xw.x), bflo(xw.y), bfhi(xw.y)};
            v[j] = xi + ((const f32x4*)gate)[cix] * (p0[64 * j] + p1[64 * j]); s += (v[j].x * v[j].x + v[j].y * v[j].y) + (v[j].z * v[j].z + v[j].w * v[j].w); }
        s = wave_sum(s, lane);
        if (lane == 0) RSTD[r] = rsqrtf(s * (1.f / DM) + EPS);
        v2u* o8 = (v2u*)(H + blk_off(r, 0, 8)) + lane;
#pragma unroll
        for (int j = 0; j < 8; ++j) { const int cix = 64 * j + lane; v2u xo; xo.x = pk2(v[j].x, v[j].y); xo.y = pk2(v[j].z, v[j].w); xr[JS * j] = xo;
            const f32x4 y = v[j] * ((const f32x4*)w)[cix] * (((const f32x4*)sc)[cix] + 1.f); v2u o; o.x = pk2(y.x, y.y); o.y = pk2(y.z, y.w); o8[JS * j] = o; }
    }
}
__device__ __forceinline__ void rstd_phase(Frame& F, int nrows) {
    const float* SSP = WSP(float, WS_SSP); float* RSTD = WSP(float, WS_RSTD);
    for (int r = F.bid * NTHR + F.tid; r < nrows; r += F.G * NTHR) { const f32x4* sp = (const f32x4*)(SSP + (size_t)r * 32); float s = 0.f;
#pragma unroll
        for (int j = 0; j < 8; ++j) { const f32x4 v = sp[j]; s += (v.x + v.y) + (v.z + v.w); }
        RSTD[r] = rsqrtf(s * (1.f / DM) + EPS); }
}
__device__ __forceinline__ void transpose_item(const float* W, int K, int N, bf16* WT, int ldt, LAS float* scr, int item, int lane) {
    const int nblk = (N + 31) / 32, kb = item / nblk, nb = item % nblk, k0 = 64 * kb, n0 = 32 * nb;
    const int nr = min(n0 + (lane & 31), N - 1);
#pragma unroll 8
    for (int i = 0; i < 32; ++i) { const int kk = 2 * i + (lane >> 5); scr[kk * 33 + (lane & 31)] = W[(size_t)(k0 + kk) * N + nr]; }
    LDS_WAIT(); asm volatile("" ::: "memory");
    const int cch = lane & 7;
#pragma unroll
    for (int j = 0; j < 4; ++j) { const int n = (lane >> 3) + 8 * j; const LAS float* s = scr + (8 * cch) * 33 + n;
        v4u o; o.x = pk2(s[0 * 33], s[1 * 33]); o.y = pk2(s[2 * 33], s[3 * 33]); o.z = pk2(s[4 * 33], s[5 * 33]); o.w = pk2(s[6 * 33], s[7 * 33]);
        if (n0 + n < N) *(v4u*)(WT + (size_t)(n0 + n) * ldt + k0 + 8 * cch) = o; }
    LDS_WAIT(); asm volatile("" ::: "memory");
}
__device__ __forceinline__ void norm_row(const float* xrow, bf16* orow, const float* w, const float* shift, const float* scale, int lane) {
    const f32x4* xr = (const f32x4*)xrow + lane;
    f32x4 v[8]; float s = 0.f;
#pragma unroll
    for (int j = 0; j < 8; ++j) { v[j] = xr[64 * j]; s += (v[j].x * v[j].x + v[j].y * v[j].y) + (v[j].z * v[j].z + v[j].w * v[j].w); }
    const float rstd = rsqrtf(wave_sum(s, lane) * (1.f / DM) + EPS);
    v2u* o8 = (v2u*)orow + lane;
#pragma unroll
    for (int j = 0; j < 8; ++j) { const int cix = 64 * j + lane; const f32x4 wv = ((const f32x4*)w)[cix], sh = ((const f32x4*)shift)[cix], sc = ((const f32x4*)scale)[cix];
        const f32x4 y = v[j] * rstd * wv * (sc + 1.f) + sh; v2u o; o.x = pk2(y.x, y.y); o.y = pk2(y.z, y.w); o8[64 * j] = o; }
}
__device__ __forceinline__ void norm_phase(Frame& F, const float* X, bf16* H, const float* w, const float* mods  , int ishift, int iscale, int nrows) {
    const int gw = F.bid * NWAVES + F.wave, NGW = F.G * NWAVES;
    for (int r = gw; r < nrows; r += NGW) { const float* mp = mods + (size_t)mod_row(r) * NMOD;
        norm_row(X + (size_t)r * DM, H + (size_t)r * DM, w, mp + ishift * DM, mp + iscale * DM, F.lane); }
}
constexpr int CV_1 = 32 * 256, CV_2 = 128 * 64, CV_OUT = 32 * 64, CV_G = 8 * 16, CV_OWN = CV_1 + CV_2 + CV_OUT + CV_G, CV_IN = 32 * 131, CV_Q = 6 * 24, CV_KV = 2 * 32, CV_NEXT = CV_IN + CV_Q + CV_KV;
__device__ __forceinline__ void convert_item(Frame& F, const Args& A, int lo, int ln, int it, LAS float* scr) {
    int r = it;
    if (r < CV_OWN) { if (lo < 0) return;
        if (r < CV_1) { transpose_item(KIN(I_W1) + (size_t)lo * DM * DFF, DM, DFF, WSP(bf16, WS_W1), DM, scr, r, F.lane); return; } r -= CV_1;
        if (r < CV_2) { transpose_item(KIN(I_W2) + (size_t)lo * DFF * DM, DFF, DM, WSP(bf16, WS_W2), DFF, scr, r, F.lane); return; } r -= CV_2;
        if (r < CV_OUT) { transpose_item(KIN(I_WOUT) + (size_t)lo * DM * DM, DM, DM, WSP(bf16, WS_WOUT), DM, scr, r, F.lane); return; } r -= CV_OUT;
        transpose_item(KIN(I_S5GLUW) + (size_t)lo * 512 * 512, 512, 512, WSP(bf16, WS_WGLU), 512, scr, r, F.lane); return; }
    r -= CV_OWN; if (ln >= DEPTH) return;
    if (r < CV_IN) { transpose_item(KIN(I_WIN) + (size_t)ln * DM * NZ, DM, NZ, WSP(bf16, WS_WIN), DM, scr, r, F.lane); return; } r -= CV_IN;
    if (r < CV_Q) { transpose_item(KIN(I_WQUP) + (size_t)ln * 384 * 768, 384, 768, WSP(bf16, WS_WQUP), 384, scr, r, F.lane); return; } r -= CV_Q;
    transpose_item(KIN(I_WKVUP) + (size_t)ln * 128 * 1024, 128, 1024, WSP(bf16, WS_WKVUP), 256, scr, r, F.lane);
}
__device__ __forceinline__ void convert_misc(Frame& F, const Args& A, int ln, int t0, int nt) {
    if (ln >= DEPTH) return;
    { v4u* p = WSP(v4u, WS_WKVUP); const v4u z4 = zero_v4u(); for (int i = t0; i < 1024 * 16; i += nt) { const int n = i >> 4, c8 = i & 15; p[(size_t)n * 32 + 16 + c8] = z4; } }
    { float* cst = WSP(float, WS_LRUC); const float* ba = KIN(I_LBA) + (size_t)ln * 1024; const float* bx = KIN(I_LBX) + (size_t)ln * 1024; const float* lam = KIN(I_LLAM) + (size_t)ln * 1024;
      for (int i = t0; i < 1024; i += nt) { cst[i] = ba[i]; cst[1024 + i] = bx[i]; cst[2048 + i] = softplusf_(-lam[i]); } }
    { const float* wa = KIN(I_LWA) + (size_t)ln * 2 * 4 * 128 * 128; const float* wx = KIN(I_LWX) + (size_t)ln * 2 * 4 * 128 * 128; v4u* p = WSP(v4u, WS_WLRU);
      for (int i = t0; i < 2048 * 64; i += nt) { const int cidx = i >> 6, k8 = (i & 63) * 8; const int pn = cidx >> 8, type = (cidx >> 7) & 1, j = cidx & 127, d = pn >> 2, nb = pn & 3;
          v4u o = zero_v4u();
          if ((k8 >> 7) == nb) { const float* src = (type ? wx : wa) + ((size_t)(d * 4 + nb) * 128 + (k8 & 127)) * 128 + j;
              o.x = pk2(src[0 * 128], src[1 * 128]); o.y = pk2(src[2 * 128], src[3 * 128]); o.z = pk2(src[4 * 128], src[5 * 128]); o.w = pk2(src[6 * 128], src[7 * 128]); }
          p[i] = o; } }
}
__device__ __forceinline__ void convert_weights(Frame& F, const Args& A, int lo, int ln) {
    LAS float* scr = (LAS float*)(F.lds + RING_OFF + F.wave * 16384);
    for (int it = F.bid * NWAVES + F.wave; it < CV_OWN + CV_NEXT; it += F.G * NWAVES) convert_item(F, A, lo, ln, it, scr);
    convert_misc(F, A, ln, F.bid * NTHR + F.tid, F.G * NTHR);
}
constexpr int CV_UNITS = (CV_OWN + CV_NEXT + 63) / 64 + 1;
__device__ __forceinline__ void convert_unit(Frame& F, const Args& A, int lo, int ln, int cu) {
    if (cu == CV_UNITS - 1) { convert_misc(F, A, ln, F.tid, NTHR); return; }
    LAS float* scr = (LAS float*)(F.lds + RING_OFF + F.wave * 16384);
    for (int j = 0; j < 8; ++j) { const int it = cu * 64 + j * 8 + F.wave; if (it < CV_OWN + CV_NEXT) convert_item(F, A, lo, ln, it, scr); }
}
__device__ __forceinline__ void prep_phase(Frame& F, const Args& A, int l) {
    const bf16* Z = WSP(bf16, WS_Z); bf16* XS = WSP(bf16, WS_XS); bf16* AQ = WSP(bf16, WS_AQ); bf16* AKV = WSP(bf16, WS_AKV);
    const float* cw = KIN(I_LCW) + (size_t)l * 4 * 512; const float* cb = KIN(I_LCB) + (size_t)l * 512;
    const float* qan = KIN(I_QAN) + (size_t)l * 384; const float* kvan = KIN(I_KVAN) + (size_t)l * 128;
    for (size_t i = (size_t)F.bid * NTHR + F.tid; i < (size_t)RT * 64; i += (size_t)F.G * NTHR) {
        const int r = (int)(i >> 6), c8 = (int)(i & 63) * 8;
        int t, len; if (r < RL) { t = r & (SEQ - 1); len = SEQ; } else { t = (r - RL) & (CTXL - 1); len = CTXL; }
        float acc[8];
#pragma unroll
        for (int j = 0; j < 8; ++j) acc[j] = cb[c8 + j];
#pragma unroll
        for (int tap = 0; tap < 4; ++tap) { const int tt = t + tap - 2;
            if (tt >= 0 && tt < len) { const v4u w = *(const v4u*)(Z + (size_t)(r + tap - 2) * LDZ + ZLX + c8); float f[8]; unpack8(w, f);
#pragma unroll
                for (int j = 0; j < 8; ++j) acc[j] += f[j] * cw[tap * 512 + c8 + j]; } }
        *(v4u*)(XS + (size_t)r * 512 + c8) = pack8(acc);
    }
    const int gw = F.bid * NWAVES + F.wave, NGW = F.G * NWAVES;
    for (int r = gw; r < RT; r += NGW) {
        const bool isq = F.lane < 48; const int e0 = isq ? F.lane * 8 : (F.lane - 48) * 8;
        const v4u w = *(const v4u*)(Z + (size_t)r * LDZ + (isq ? ZCQ : ZCKV) + e0); float f[8]; unpack8(w, f);
        float ss = 0.f;
#pragma unroll
        for (int j = 0; j < 8; ++j) ss += f[j] * f[j];
        const float sq = wave_sum(isq ? ss : 0.f, F.lane), skv = wave_sum(isq ? 0.f : ss, F.lane);
        const float rstd = isq ? rsqrtf(sq * (1.f / 384.f) + EPS) : rsqrtf(skv * (1.f / 128.f) + EPS);
        const float* nw = isq ? qan + e0 : kvan + e0;
#pragma unroll
        for (int j = 0; j < 8; ++j) f[j] = f[j] * rstd * nw[j];
        if (isq) *(v4u*)(AQ + (size_t)r * 384 + e0) = pack8(f);
        else { *(v4u*)(AKV + (size_t)r * 256 + e0) = pack8(f); *(v4u*)(AKV + (size_t)r * 256 + 128 + e0) = zero_v4u(); }
    }
}
constexpr float ATTN_SCALE_LOG2E = 0.07216878364870322f * 1.4426950408889634f;
__device__ __forceinline__ void rope8(float (&f)[8], int li, int t, int lane, const float* rope) {
    const bool second = (li & 2) != 0;
    const int pos = (li < 20) ? (t >> 6) : (t & 63);
    const f32x4* tp = (const f32x4*)(rope + (size_t)(pos * 16 + 8 * (li & 1)) * 2);
    const f32x4 t0 = tp[0], t1 = tp[1], t2 = tp[2], t3 = tp[3];
    const float cs[8] = {t0.x, t0.z, t1.x, t1.z, t2.x, t2.z, t3.x, t3.z}, sn[8] = {t0.y, t0.w, t1.y, t1.w, t2.y, t2.w, t3.y, t3.w};
    float o[8];
#pragma unroll
    for (int j = 0; j < 8; ++j) { const float other = shx(f[j], 2, lane); o[j] = second ? (f[j] * cs[j] + other * sn[j]) : (f[j] * cs[j] - other * sn[j]); }
#pragma unroll
    for (int j = 0; j < 8; ++j) f[j] = o[j];
}
__device__ __forceinline__ void mla_finish(Frame& F, const Args& A, int l, bool need_ctx, int wg0, int nwg) {
    const bf16* Z = WSP(bf16, WS_Z); const bf16* KVRAW = WSP(bf16, WS_KVRAW); bf16* K = WSP(bf16, WS_K);
    const float* kn = KIN(I_KN) + (size_t)l * 192; const float* rope = WSP(float, WS_ROPE);
    const int gw = (F.bid - wg0) * NWAVES + F.wave, NGW = nwg * NWAVES;
    const int li = F.lane & 31, hh = F.lane >> 5; const bool act = li < 24;
    float knw[8];
#pragma unroll
    for (int j = 0; j < 8; ++j) knw[j] = act ? kn[8 * li + j] : 0.f;
    for (int r = gw; r < RT; r += NGW) {
        const bool lat = r < RL; const int t = r & (SEQ - 1);
        v4u wk[2];
#pragma unroll
        for (int it = 0; it < 2; ++it) { const int h = it * 2 + hh;
            wk[it] = li < 16 ? *(const v4u*)(KVRAW + (size_t)r * 1024 + h * 256 + 8 * li) : (li < 24 ? *(const v4u*)(Z + (size_t)r * LDZ + ZKR + 8 * (li - 16)) : zero_v4u()); }
        int b, key; if (lat) { b = r >> 11; key = CTXL + t; } else { b = (r - RL) >> 8; key = (r - RL) & (CTXL - 1); }
#pragma unroll
        for (int it = 0; it < 2; ++it) { const int h = it * 2 + hh;
            float g[8]; unpack8(wk[it], g);
            float sk = 0.f;
#pragma unroll
            for (int j = 0; j < 8; ++j) sk += g[j] * g[j];
#pragma unroll
            for (int o = 1; o < 32; o <<= 1) sk += shx(sk, o, F.lane);
            const float rk = rsqrtf(sk * (1.f / 192.f) + EPS);
#pragma unroll
            for (int j = 0; j < 8; ++j) g[j] = g[j] * rk * knw[j];
            if (lat) { if (li >= 16 && li < 24) rope8(g, li, t, F.lane, rope); }
            if (act) *(v4u*)(K + ((size_t)b * TOK + key) * 768 + h * 192 + 8 * li) = pack8(g);
        }
    }
}
template <bool FINAL> __device__ __forceinline__ void lru_chunk(Frame& F, int wunit) {
    const bf16* LOGA = WSP(bf16, WS_LOGA); const bf16* GB = WSP(bf16, WS_GB); bf16* LH = WSP(bf16, WS_LH); float* SUM = WSP(float, WS_LSUM);
    const int b = wunit / 72, d = (wunit / 36) & 1, c = wunit % 36, c8 = 8 * F.lane, step = d ? -1 : 1;
    const int r0 = row_scan(b, d, 64 * c);
    float* sp = SUM + ((size_t)((b * 2 + d) * 36) * 2) * 512 + c8;
    float h[8], P[8];
#pragma unroll
    for (int j = 0; j < 8; ++j) { h[j] = 0.f; P[j] = 0.f; }
    if (FINAL) {
        for (int cc = 0; cc < c; ++cc) { const f32x4 p0 = *(const f32x4*)(sp + (size_t)cc * 1024), p1 = *(const f32x4*)(sp + (size_t)cc * 1024 + 4), e0 = *(const f32x4*)(sp + (size_t)cc * 1024 + 512), e1 = *(const f32x4*)(sp + (size_t)cc * 1024 + 516);
#pragma unroll
            for (int j = 0; j < 4; ++j) { h[j] = __expf(p0[j]) * h[j] + e0[j]; h[4 + j] = __expf(p1[j]) * h[4 + j] + e1[j]; } }
    }
    const bf16* lap = LOGA + d * 512 + c8; const bf16* gbp = GB + d * 512 + c8; bf16* lhp = LH + (size_t)d * RT * 512 + c8;
    for (int t0 = 0; t0 < 64; t0 += 8) {
        v4u la[8], gb[8];
#pragma unroll
        for (int j = 0; j < 8; ++j) { const size_t row = (size_t)(r0 + step * (t0 + j)); la[j] = *(const v4u*)(lap + row * 1024); gb[j] = *(const v4u*)(gbp + row * 1024); }
#pragma unroll
        for (int j = 0; j < 8; ++j) { float a[8], g[8]; unpack8(la[j], a); unpack8(gb[j], g);
#pragma unroll
            for (int e = 0; e < 8; ++e) { h[e] = __expf(a[e]) * h[e] + g[e]; if (!FINAL) P[e] += a[e]; }
            if (FINAL) *(v4u*)(lhp + (size_t)(r0 + step * (t0 + j)) * 512) = pack8(h); }
    }
    if (!FINAL) { float* o = sp + (size_t)c * 1024;
        *(f32x4*)(o) = (f32x4){P[0], P[1], P[2], P[3]}; *(f32x4*)(o + 4) = (f32x4){P[4], P[5], P[6], P[7]};
        *(f32x4*)(o + 512) = (f32x4){h[0], h[1], h[2], h[3]}; *(f32x4*)(o + 516) = (f32x4){h[4], h[5], h[6], h[7]}; }
}
template <bool DO_S5, bool DO_REST> __device__ __forceinline__ void finish_phase(Frame& F, const Args& A, int l, int nrows) {
    const bf16* Z = WSP(bf16, WS_Z); bf16* Y = WSP(bf16, WS_Y); bf16* A5 = WSP(bf16, WS_A5);
    const bf16* YS = WSP(bf16, WS_YS); const bf16* MH = WSP(bf16, WS_MH); const bf16* LH = WSP(bf16, WS_LH);
    const float* s5d = KIN(I_S5D) + (size_t)l * 512; const float* on = KIN(I_MLON) + (size_t)l * 512;
    const int gw = F.bid * NWAVES + F.wave, NGW = F.G * NWAVES; const int c8 = F.lane * 8;
    for (int r = gw; r < nrows; r += NGW) {
        float a[8], b[8], o[8];
        if (DO_S5) { unpack8(*(const v4u*)(YS + (size_t)r * 512 + c8), a); unpack8(*(const v4u*)(YS + ((size_t)RT + r) * 512 + c8), b); unpack8(*(const v4u*)(Z + (size_t)r * LDZ + ZU + c8), o);
#pragma unroll
          for (int j = 0; j < 8; ++j) a[j] = gelu_tanh(a[j] + b[j] + s5d[c8 + j] * o[j]);
          *(v4u*)(A5 + (size_t)r * 512 + c8) = pack8(a); }
        if (DO_REST) { unpack8(*(const v4u*)(LH + (size_t)r * 512 + c8), a); unpack8(*(const v4u*)(LH + ((size_t)RT + r) * 512 + c8), b); unpack8(*(const v4u*)(Z + (size_t)r * LDZ + ZLG + c8), o);
#pragma unroll
          for (int j = 0; j < 8; ++j) a[j] = (a[j] + b[j]) * gelu_tanh(o[j]);
          *(v4u*)(Y + (size_t)r * DM + 1536 + c8) = pack8(a); }
        if (DO_REST) { unpack8(*(const v4u*)(MH + (size_t)r * 512 + c8), a); unpack8(*(const v4u*)(MH + ((size_t)RT + r) * 512 + c8), b); unpack8(*(const v4u*)(Z + (size_t)r * LDZ + ZMO + c8), o);
          float ss = 0.f;
#pragma unroll
          for (int j = 0; j < 8; ++j) { a[j] += b[j]; ss += a[j] * a[j]; }
#pragma unroll
          for (int s = 1; s < 16; s <<= 1) ss += shx(ss, s, F.lane);
          const float rstd = rsqrtf(ss * (1.f / 128.f) + EPS);
#pragma unroll
          for (int j = 0; j < 8; ++j) a[j] = a[j] * rstd * on[c8 + j] * sigmoidf_(o[j]);
          *(v4u*)(Y + (size_t)r * DM + 512 + c8) = pack8(a); }
    }
}
#define MFMA16(a, b, c) __builtin_amdgcn_mfma_f32_16x16x32_bf16((a), (b), (c), 0, 0, 0)
#define MFMA32(a, b, c) __builtin_amdgcn_mfma_f32_32x32x16_bf16((a), (b), (c), 0, 0, 0)
__device__ __forceinline__ bf16x8 ldsfrag(const LAS bf16* p) { return *(const LAS bf16x8*)p; }

__device__ __forceinline__ void s5_scan(Frame& F, int l, int unit_lo, int unit_hi) {
    const bf16* Z = WSP(bf16, WS_Z); bf16* YS = WSP(bf16, WS_YS);
    const float* S5A = WSP(float, WS_S5A); const bf16* BB = WSP(bf16, WS_S5BB); const bf16* CM = WSP(bf16, WS_S5CM);
    LAS bf16* Hs = (LAS bf16*)(F.lds + RING_OFF + F.wave * 8704);
    const int lane = F.lane, j = lane & 31, hl = lane >> 5, i16 = lane & 15, q4 = lane >> 4;
    const int hb = (j >> 2) & 1, tt = (j & 3) + 4 * (j >> 3);
    for (int unit = unit_lo; unit < unit_hi; ++unit) {
        const int bp = unit & 7, g = (unit >> 3) & 31, d = unit >> 8, b0 = 2 * bp, ldg = (l * 2 + d) * 32 + g;
        bf16x8 Bf[4], Cf[4];
#pragma unroll
        for (int t = 0; t < 4; ++t) { Bf[t] = *(const bf16x8*)(BB + ((size_t)ldg * 128 + t * 32 + j) * 16 + 8 * hl); Cf[t] = *(const bf16x8*)(CM + ((size_t)ldg * 16 + i16) * 128 + 32 * t + 8 * q4); }
        const float ar0 = S5A[((size_t)ldg * 64 + j) * 2], ai0 = S5A[((size_t)ldg * 64 + j) * 2 + 1], ar1 = S5A[((size_t)ldg * 64 + j + 32) * 2], ai1 = S5A[((size_t)ldg * 64 + j + 32) * 2 + 1];
        float hr0 = 0.f, hi0 = 0.f, hr1 = 0.f, hi1 = 0.f;
        const bf16* zu = Z + ZU + g * 16 + 8 * hl;
        bf16x8 a0 = *(const bf16x8*)(zu + (size_t)row_scan(b0 + hb, d, tt) * LDZ);
        bf16x8 a1 = *(const bf16x8*)(zu + (size_t)row_scan(b0 + hb, d, 16 + tt) * LDZ);
        for (int blk = 0; blk < TOK / 16; ++blk) {
            const int p0 = blk * 16, pn = min(blk + 2, TOK / 16 - 1) * 16;
            const bf16x8 a2 = *(const bf16x8*)(zu + (size_t)row_scan(b0 + hb, d, pn + tt) * LDZ);
            f32x16 acc[4];
#pragma unroll
            for (int t = 0; t < 4; ++t) { f32x16 z;
#pragma unroll
                for (int e = 0; e < 16; ++e) z[e] = 0.f;
                acc[t] = MFMA32(a0, Bf[t], z); }
            LAS unsigned* hrow = (LAS unsigned*)(Hs + hl * (16 * 136)) + j;
#pragma unroll
            for (int r = 0; r < 16; ++r) {
                const float nr0 = ar0 * hr0 - ai0 * hi0 + acc[0][r], ni0 = ar0 * hi0 + ai0 * hr0 + acc[1][r];
                const float nr1 = ar1 * hr1 - ai1 * hi1 + acc[2][r], ni1 = ar1 * hi1 + ai1 * hr1 + acc[3][r];
                hr0 = nr0; hi0 = ni0; hr1 = nr1; hi1 = ni1;
                hrow[r * 68] = pk2(nr0, ni0); hrow[r * 68 + 32] = pk2(nr1, ni1);
            }
            asm volatile("s_waitcnt lgkmcnt(0)" ::: "memory");
#pragma unroll
            for (int h2 = 0; h2 < 2; ++h2) {
                f32x4 y = (f32x4){0.f, 0.f, 0.f, 0.f};
#pragma unroll
                for (int ks = 0; ks < 4; ++ks) y = MFMA16(Cf[ks], ldsfrag(Hs + h2 * (16 * 136) + i16 * 136 + 32 * ks + 8 * q4), y);
                { const int rr = row_scan(b0 + h2, d, p0 + i16); v2u o; o.x = pk2(y[0], y[1]); o.y = pk2(y[2], y[3]);
                  *(v2u*)(YS + ((size_t)d * RT + rr) * 512 + g * 16 + 4 * q4) = o; }
            }
            asm volatile("s_waitcnt lgkmcnt(0)" ::: "memory");
            a0 = a1; a1 = a2;
        }
    }
}

constexpr int ML_QS = 0, ML_KS = 17408, ML_VS = 34816, ML_KW = 53248, ML_CT = 71680, ML_SP = 108544, ML_FL = 118784;
constexpr int ML_P = 144, ML_SPP = 80;
typedef short v4i16_t __attribute__((ext_vector_type(4)));
__device__ __forceinline__ v2u tr16(const LAS bf16* p) { return __builtin_bit_cast(v2u, __builtin_amdgcn_ds_read_tr16_b64_v4i16((LAS v4i16_t*)p)); }
__device__ __forceinline__ bf16x8 trfrag(const LAS bf16* base, int pitch, int k0, int n0) {
    const v2u lo = tr16(base + k0 * pitch + n0), hi = tr16(base + (k0 + 4) * pitch + n0);
    const v4u w = (v4u){lo.x, lo.y, hi.x, hi.y}; return __builtin_bit_cast(bf16x8, w);
}
__device__ __forceinline__ void mlstm_chain(Frame& F, const Args& A, int l, int unit) {
    const bf16* Z = WSP(bf16, WS_Z); bf16* MH = WSP(bf16, WS_MH);
    const int b = unit >> 3, head = (unit >> 1) & 3, dir = unit & 1;
    LAS bf16* Qs = (LAS bf16*)(F.lds + ML_QS); LAS bf16* Ks = (LAS bf16*)(F.lds + ML_KS); LAS bf16* Vs = (LAS bf16*)(F.lds + ML_VS);
    LAS bf16* Kw = (LAS bf16*)(F.lds + ML_KW); LAS bf16* Ct = (LAS bf16*)(F.lds + ML_CT); LAS bf16* Sp = (LAS bf16*)(F.lds + ML_SP);
    LAS float* bcum = (LAS float*)(F.lds + ML_FL); LAS float* lis = bcum + 64; LAS float* den = bcum + 128; LAS float* nq = bcum + 192; LAS float* nvec = bcum + 256; LAS float* nadd = bcum + 384;
    int lane_l = F.lane; asm volatile("" : "+v"(lane_l));
    const int lane = lane_l, w = F.wave, tid = w * 64 + lane, i16 = lane & 15, q4 = lane >> 4;
    const float igb = KIN(I_MLIG)[(l * 2 + dir) * 4 + head], fgb = KIN(I_MLFG)[(l * 2 + dir) * 4 + head];
    const float kscale = 0.08838834764831845f;
    f32x4 C[8];
#pragma unroll
    for (int e = 0; e < 8; ++e) C[e] = (f32x4){0.f, 0.f, 0.f, 0.f};
    __syncthreads();
    if (tid < 128) { nvec[tid] = 0.f; nadd[tid] = 0.f; }
    float gb[5], gl[5];
#pragma unroll
    for (int j = 0; j < 5; ++j) { const int cc = 8 * j + w; gb[j] = 0.f; gl[j] = 0.f;
        if (cc < TOK / 64) { const bf16* zr = Z + (size_t)row_scan(b, dir, 64 * cc + lane) * LDZ + ZMG + dir * 8 + head; gl[j] = bf2f(zr[0]) + igb; gb[j] = logsigmoidf_(bf2f(zr[4]) + fgb); } }
#pragma unroll
    for (int o = 1; o < 64; o <<= 1) {
#pragma unroll
        for (int j = 0; j < 5; ++j) { const float t = shup(gb[j], o, lane); if (lane >= o) gb[j] += t; } }
    const int trq = (8 * q4 + (i16 >> 2)), trc = 4 * (i16 & 3);
    const LAS bf16* vs_tr = Vs + trq * ML_P + trc; const LAS bf16* kw_tr = Kw + trq * ML_P + trc; const LAS bf16* ct_tr = Ct + trq * ML_P + trc; const LAS bf16* sp_tr = Sp + trq * ML_SPP + trc;
    v4u qreg[2], kreg[2], vreg[2];
    auto load_chunk = [&](int c) {
#pragma unroll
        for (int i = 0; i < 2; ++i) { const int idx = tid + 512 * i, s = idx >> 4, c8 = (idx & 15) * 8; const bf16* zr = Z + (size_t)row_scan(b, dir, 64 * c + s) * LDZ + head * 128 + c8;
            qreg[i] = *(const v4u*)(zr + ZMQ); kreg[i] = *(const v4u*)(zr + ZMK); vreg[i] = *(const v4u*)(zr + ZMV); }
    };
    load_chunk(0);
    float eBprev = 1.f;
    for (int c = 0; c < TOK / 64; ++c) {
        __syncthreads();
        if (w == (c & 7)) { float bv = gb[0], lv = gl[0];
#pragma unroll
            for (int j = 1; j < 5; ++j) if ((c >> 3) == j) { bv = gb[j]; lv = gl[j]; }
            bcum[lane] = bv; lis[lane] = lv; }
        if (tid < 128) { nvec[tid] = eBprev * nvec[tid] + nadd[tid]; nadd[tid] = 0.f; }
#pragma unroll
        for (int i = 0; i < 2; ++i) { const int idx = tid + 512 * i, s = idx >> 4, c8 = (idx & 15) * 8;
            *(LAS v4u*)(Qs + s * 136 + c8) = qreg[i];
            *(LAS v4u*)(Vs + s * ML_P + c8) = vreg[i]; }
#pragma unroll
        for (int et = 0; et < 8; ++et) { v2u cw; cw.x = pk2(C[et][0], C[et][1]); cw.y = pk2(C[et][2], C[et][3]); *(LAS v2u*)(Ct + (16 * et + i16) * ML_P + 16 * w + 4 * q4) = cw; }
        float kf[2][8];
#pragma unroll
        for (int i = 0; i < 2; ++i) { const int idx = tid + 512 * i, s = idx >> 4, c8 = (idx & 15) * 8;
            unpack8(kreg[i], kf[i]);
#pragma unroll
            for (int jj = 0; jj < 8; ++jj) kf[i][jj] *= kscale;
            *(LAS v4u*)(Ks + s * 136 + c8) = pack8(kf[i]); }
        if (c + 1 < TOK / 64) load_chunk(c + 1);
        __syncthreads();
        const float Btot = bcum[63];
#pragma unroll
        for (int i = 0; i < 2; ++i) { const int idx = tid + 512 * i, s = idx >> 4, c8 = (idx & 15) * 8; const float ws = __expf(Btot - bcum[s] + lis[s]);
#pragma unroll
            for (int jj = 0; jj < 8; ++jj) kf[i][jj] *= ws;
            *(LAS v4u*)(Kw + s * ML_P + c8) = pack8(kf[i]); }
#pragma unroll
        for (int ti = 0; ti < 2; ++ti) { const int idx = 2 * w + ti, tt = idx >> 2, st = idx & 3; const int srow = 16 * st + i16;
            f32x4 acc = (f32x4){0.f, 0.f, 0.f, 0.f};
            if (st <= tt) {
#pragma unroll
                for (int ks = 0; ks < 4; ++ks) acc = MFMA16(ldsfrag(Qs + (16 * tt + i16) * 136 + 32 * ks + 8 * q4), ldsfrag(Ks + srow * 136 + 32 * ks + 8 * q4), acc); }
            const float bs = bcum[srow], ls = lis[srow]; const f32x4 bt = *(const LAS f32x4*)(bcum + 16 * tt + 4 * q4); float v[4];
#pragma unroll
            for (int r = 0; r < 4; ++r) { const int t = 16 * tt + 4 * q4 + r; v[r] = (srow <= t && st <= tt) ? acc[r] * __expf(bt[r] - bs + ls) : 0.f; }
            v2u sw; sw.x = pk2(v[0], v[1]); sw.y = pk2(v[2], v[3]); *(LAS v2u*)(Sp + srow * ML_SPP + 16 * tt + 4 * q4) = sw; }
        __syncthreads();
        bf16x8 vfr[2], cfr[4], nfr[4];
        const bf16x8 onesf = __builtin_bit_cast(bf16x8, (v4u){0x3f803f80u, 0x3f803f80u, 0x3f803f80u, 0x3f803f80u});
#pragma unroll
        for (int ks = 0; ks < 2; ++ks) vfr[ks] = trfrag(vs_tr, ML_P, 32 * ks, 16 * w);
#pragma unroll
        for (int ks = 0; ks < 4; ++ks) { cfr[ks] = trfrag(ct_tr, ML_P, 32 * ks, 16 * w);
            const f32x4 n0 = *(const LAS f32x4*)(nvec + 32 * ks + 8 * q4), n1 = *(const LAS f32x4*)(nvec + 32 * ks + 8 * q4 + 4);
            const float nf[8] = {n0.x, n0.y, n0.z, n0.w, n1.x, n1.y, n1.z, n1.w}; nfr[ks] = __builtin_bit_cast(bf16x8, pack8(nf)); }
#pragma unroll 1
        for (int tt = 0; tt < 4; ++tt) {
            f32x4 a1 = (f32x4){0.f, 0.f, 0.f, 0.f}, a2 = (f32x4){0.f, 0.f, 0.f, 0.f}, ad = (f32x4){0.f, 0.f, 0.f, 0.f}, an = (f32x4){0.f, 0.f, 0.f, 0.f};
#pragma unroll
            for (int ks = 0; ks < 2; ++ks) { const bf16x8 sf = trfrag(sp_tr, ML_SPP, 32 * ks, 16 * tt); a1 = MFMA16(vfr[ks], sf, a1); ad = MFMA16(onesf, sf, ad); }
#pragma unroll
            for (int ks = 0; ks < 4; ++ks) { const bf16x8 qf = ldsfrag(Qs + (16 * tt + i16) * 136 + 32 * ks + 8 * q4); a2 = MFMA16(cfr[ks], qf, a2); an = MFMA16(nfr[ks], qf, an); }
            const int rr = row_scan(b, dir, 64 * c + 16 * tt + i16);
            { const float eb = __expf(bcum[16 * tt + i16]), dn = ad[0] + eb * an[0], inv = __builtin_amdgcn_rcpf(fmaxf(fabsf(dn), 1.f));
              v2u o; o.x = pk2((a1[0] + eb * a2[0]) * inv, (a1[1] + eb * a2[1]) * inv); o.y = pk2((a1[2] + eb * a2[2]) * inv, (a1[3] + eb * a2[3]) * inv);
              *(v2u*)(MH + ((size_t)dir * RT + rr) * 512 + head * 128 + 16 * w + 4 * q4) = o; }
        }
        const float eB = __expf(Btot);
#pragma unroll
        for (int et = 0; et < 8; ++et) { f32x4 acc = C[et] * eB;
#pragma unroll
            for (int ks = 0; ks < 2; ++ks) acc = MFMA16(vfr[ks], trfrag(kw_tr, ML_P, 32 * ks, 16 * et), acc);
            C[et] = acc; __builtin_amdgcn_sched_barrier(0); }
        { const int e = tid & 127, part = tid >> 7; float s = 0.f;
#pragma unroll
          for (int ss = 0; ss < 16; ++ss) s += bf2f(Kw[(16 * part + ss) * ML_P + e]);
          __hip_atomic_fetch_add(nadd + e, s, __ATOMIC_RELAXED, __HIP_MEMORY_SCOPE_WORKGROUP); }
        eBprev = eB;
    }
    __syncthreads();
}

constexpr int AT_K = 0, AT_V = 25600, AT_VP = 144, AT_BUF = 44032;
__device__ __forceinline__ void attn_unit(Frame& F, int b, int h, int qrow0, int nkt, const float* qn  ) {
    const bf16* Q = WSP(bf16, WS_QRAW); const bf16* K = WSP(bf16, WS_K); const bf16* KVRAW = WSP(bf16, WS_KVRAW); bf16* Y = WSP(bf16, WS_Y);
    LAS bf16* Kl = (LAS bf16*)(F.lds + AT_K); LAS bf16* Vl = (LAS bf16*)(F.lds + AT_V);
    int lane_l = F.lane; asm volatile("" : "+v"(lane_l));
    const int lane = lane_l, w = F.wave, tid = w * 64 + lane, i16 = lane & 15, q4 = lane >> 4;
    bf16x8 qf[2][6];
    const bf16* Qb = Q + (size_t)qrow0 * 768 + h * 192;
    const unsigned qoff = (unsigned)((32 * w + i16) * 768 + 8 * q4);
#pragma unroll
    for (int qt = 0; qt < 2; ++qt)
#pragma unroll
        for (int ks = 0; ks < 6; ++ks) qf[qt][ks] = *(const bf16x8*)(Qb + (qoff + (unsigned)(16 * qt * 768 + 32 * ks)));
    { const float* rope = WSP(float, WS_ROPE); const bool lat = qrow0 < RL;
#pragma unroll
      for (int qt = 0; qt < 2; ++qt) {
          float f[6][8]; float ss = 0.f;
#pragma unroll
          for (int ks = 0; ks < 6; ++ks) { unpack8(__builtin_bit_cast(v4u, qf[qt][ks]), f[ks]);
#pragma unroll
              for (int j = 0; j < 8; ++j) ss += f[ks][j] * f[ks][j]; }
          ss += shx(ss, 16, lane); ss += shx(ss, 32, lane);
          const float rs = rsqrtf(ss * (1.f / 192.f) + EPS);
#pragma unroll
          for (int ks = 0; ks < 6; ++ks) { const f32x4 n0 = *(const f32x4*)(qn + 32 * ks + 8 * q4), n1 = *(const f32x4*)(qn + 32 * ks + 8 * q4 + 4);
#pragma unroll
              for (int j = 0; j < 4; ++j) { f[ks][j] *= rs * n0[j]; f[ks][4 + j] *= rs * n1[j]; } }
          if (lat) { const int t = (qrow0 + 32 * w + 16 * qt + i16) & (SEQ - 1); const bool second = (q4 & 2) != 0;
#pragma unroll
              for (int part = 0; part < 2; ++part) {
                  const int pos = part ? (t & 63) : (t >> 6); const f32x4* tp = (const f32x4*)(rope + (size_t)(pos * 16 + 8 * (q4 & 1)) * 2);
                  const f32x4 t0 = tp[0], t1 = tp[1], t2 = tp[2], t3 = tp[3];
                  const float cs[8] = {t0.x, t0.z, t1.x, t1.z, t2.x, t2.z, t3.x, t3.z}, sn[8] = {t0.y, t0.w, t1.y, t1.w, t2.y, t2.w, t3.y, t3.w};
#pragma unroll
                  for (int j = 0; j < 8; ++j) { const float me = f[4 + part][j], other = shx(me, 32, lane); f[4 + part][j] = second ? (me * cs[j] + other * sn[j]) : (me * cs[j] - other * sn[j]); } } }
#pragma unroll
          for (int ks = 0; ks < 6; ++ks) {
#pragma unroll
              for (int j = 0; j < 8; ++j) f[ks][j] *= ATTN_SCALE_LOG2E;
              qf[qt][ks] = __builtin_bit_cast(bf16x8, pack8(f[ks])); }
      } }
    f32x4 O[2][8];
#pragma unroll
    for (int qt = 0; qt < 2; ++qt)
#pragma unroll
        for (int dt = 0; dt < 8; ++dt) O[qt][dt] = (f32x4){0.f, 0.f, 0.f, 0.f};
    float mrun[2] = {-1e30f, -1e30f}, lsum[2] = {0.f, 0.f};
    const bf16* kbase = K + (size_t)b * TOK * 768 + h * 192;
    v4u kr[3], vr[2];
    unsigned koff[3], voff[2];
#pragma unroll
    for (int i = 0; i < 3; ++i) { const int idx = tid + 512 * i, r = idx / 24, cc = idx % 24; koff[i] = (unsigned)(r * 768 + 8 * cc); }
#pragma unroll
    for (int i = 0; i < 2; ++i) { const int idx = tid + 512 * i, r = idx >> 4, cc = idx & 15; voff[i] = (unsigned)(r * 1024 + 8 * cc); }
    auto load_tile = [&](int kt) {
        const bf16* kb = kbase + (size_t)kt * (64 * 768); const bf16* vb = KVRAW + (size_t)row_key(b, 64 * kt) * 1024 + h * 256 + 128;
#pragma unroll
        for (int i = 0; i < 3; ++i) kr[i] = *(const v4u*)(kb + koff[i]);
#pragma unroll
        for (int i = 0; i < 2; ++i) vr[i] = *(const v4u*)(vb + voff[i]);
    };
    const LAS bf16* vtr0 = Vl + (4 * q4 + (i16 >> 2)) * AT_VP + 4 * (i16 & 3);
    int kwo[3], vwo[2];
#pragma unroll
    for (int i = 0; i < 3; ++i) { const int idx = tid + 512 * i, r = idx / 24, cc = idx % 24; kwo[i] = r * 200 + 8 * cc; }
#pragma unroll
    for (int i = 0; i < 2; ++i) { const int idx = tid + 512 * i, r = idx >> 4, cc = idx & 15; vwo[i] = r * AT_VP + 8 * cc; }
    load_tile(0);
    __syncthreads();
#pragma unroll
    for (int i = 0; i < 3; ++i) *(LAS v4u*)(Kl + kwo[i]) = kr[i];
#pragma unroll
    for (int i = 0; i < 2; ++i) *(LAS v4u*)(Vl + vwo[i]) = vr[i];
    __syncthreads();
    for (int kt = 0; kt < nkt; ++kt) {
        const int bo = (kt & 1) * (AT_BUF / 2);
        const LAS bf16* Kc = Kl + bo; const LAS bf16* vtrc = vtr0 + bo;
        if (kt + 1 < nkt) load_tile(kt + 1);
        f32x4 s[2][4];
#pragma unroll
        for (int k4 = 0; k4 < 4; ++k4) {
            f32x4 s0 = (f32x4){0.f, 0.f, 0.f, 0.f}, s1 = (f32x4){0.f, 0.f, 0.f, 0.f};
#pragma unroll
            for (int ks = 0; ks < 6; ++ks) { const bf16x8 kf = ldsfrag(Kc + (16 * k4 + i16) * 200 + 32 * ks + 8 * q4); s0 = MFMA16(kf, qf[0][ks], s0); s1 = MFMA16(kf, qf[1][ks], s1); }
            s[0][k4] = s0; s[1][k4] = s1;
        }
        bf16x8 pf[2][2];
#pragma unroll
        for (int qt = 0; qt < 2; ++qt) {
            float tm = -1e30f;
#pragma unroll
            for (int k4 = 0; k4 < 4; ++k4)
#pragma unroll
                for (int r = 0; r < 4; ++r) tm = fmaxf(tm, s[qt][k4][r]);
            tm = fmaxf(tm, shx(tm, 16, lane)); tm = fmaxf(tm, shx(tm, 32, lane));
            const float mn = fmaxf(mrun[qt], tm), alpha = __builtin_amdgcn_exp2f(mrun[qt] - mn);
            mrun[qt] = mn;
            float ps = 0.f; float p[4][4];
#pragma unroll
            for (int k4 = 0; k4 < 4; ++k4)
#pragma unroll
                for (int r = 0; r < 4; ++r) { p[k4][r] = __builtin_amdgcn_exp2f(s[qt][k4][r] - mn); ps += p[k4][r]; }
            lsum[qt] = lsum[qt] * alpha + ps;
#pragma unroll
            for (int dt = 0; dt < 8; ++dt) O[qt][dt] = O[qt][dt] * alpha;
#pragma unroll
            for (int kk = 0; kk < 2; ++kk) { v4u pw; pw.x = pk2(p[2 * kk][0], p[2 * kk][1]); pw.y = pk2(p[2 * kk][2], p[2 * kk][3]); pw.z = pk2(p[2 * kk + 1][0], p[2 * kk + 1][1]); pw.w = pk2(p[2 * kk + 1][2], p[2 * kk + 1][3]);
                pf[qt][kk] = __builtin_bit_cast(bf16x8, pw); }
        }
#pragma unroll
        for (int dt = 0; dt < 8; ++dt)
#pragma unroll
            for (int kk = 0; kk < 2; ++kk) {
                const v2u lo = tr16(vtrc + (32 * kk) * AT_VP + 16 * dt), hi = tr16(vtrc + (32 * kk + 16) * AT_VP + 16 * dt);
                const v4u vw = (v4u){lo.x, lo.y, hi.x, hi.y}; const bf16x8 vf = __builtin_bit_cast(bf16x8, vw);
                O[0][dt] = MFMA16(vf, pf[0][kk], O[0][dt]); O[1][dt] = MFMA16(vf, pf[1][kk], O[1][dt]);
            }
        if (kt + 1 < nkt) { const int bn = ((kt + 1) & 1) * (AT_BUF / 2);
#pragma unroll
            for (int i = 0; i < 3; ++i) *(LAS v4u*)(Kl + bn + kwo[i]) = kr[i];
#pragma unroll
            for (int i = 0; i < 2; ++i) *(LAS v4u*)(Vl + bn + vwo[i]) = vr[i]; }
        __syncthreads();
    }
#pragma unroll
    for (int qt = 0; qt < 2; ++qt) {
        float lt = lsum[qt]; lt += shx(lt, 16, lane); lt += shx(lt, 32, lane);
        const float inv = 1.f / lt;
        bf16* Yb = Y + (size_t)qrow0 * DM + 1024 + h * 128; const unsigned yoff = (unsigned)((32 * w + 16 * qt + i16) * DM + 4 * q4);
#pragma unroll
        for (int dt = 0; dt < 8; ++dt) { const f32x4 o = O[qt][dt] * inv; v2u ow; ow.x = pk2(o[0], o[1]); ow.y = pk2(o[2], o[3]); *(v2u*)(Yb + (yoff + (unsigned)(16 * dt))) = ow; }
    }
    __syncthreads();
}
template <class E_> __device__ __forceinline__ void probe_redirect(E_&, float*) {}
__device__ __forceinline__ void probe_redirect(pg8::EpiRes& e, float* dummy) { e.xout = dummy; }

__global__ void __launch_bounds__(NTHR, 2) trunk_fwd(Args A) {
    extern __shared__ __attribute__((aligned(16))) unsigned char lds[];
    Frame F;
    F.lds = (LAS unsigned char*)lds;
    F.MISC = (volatile LAS unsigned*)(F.lds + MISC_OFF);
    F.tid = threadIdx.x; F.lane = F.tid & 63; F.wave = __builtin_amdgcn_readfirstlane(F.tid >> 6);
    F.G = gridDim.x; F.bid = blockIdx.x;
    F.ws = A.ws; F.out = A.out; F.kp = (const __attribute__((address_space(4))) char*)__builtin_amdgcn_kernarg_segment_ptr();
    unsigned char* const ws0 = A.ws; const __attribute__((address_space(4))) char* const kp0 = F.kp;
    F.ctl = (gu32*)(A.ws + WS_CTL);
    for (int u = F.tid; u < (LDS_BYTES - LDSCTL_OFF) / 4; u += NTHR) ((LAS unsigned*)(F.lds + LDSCTL_OFF))[u] = 0u;
    __syncthreads();
    XcdBarrier bar = xcd_barrier_post((unsigned*)(F.ctl + CW_BAR), F.MISC + 8);
    const int lo = A.lo, hi = A.hi, wave0 = F.wave;
    int st = 0;
#define RELAUNDER() do { int w_s = wave0; asm volatile("" : "+s"(w_s)); F.wave = w_s; { unsigned m_ = ~0u; asm volatile("" : "+v"(m_)); F.lane = (int)__builtin_amdgcn_mbcnt_hi(m_, __builtin_amdgcn_mbcnt_lo(m_, 0u)); } F.tid = w_s * 64 + F.lane; int b_ = blockIdx.x, g_ = gridDim.x; asm volatile("" : "+s"(b_), "+s"(g_)); F.bid = b_; F.G = g_; GAS unsigned char* w_ = (GAS unsigned char*)ws0; asm volatile("" : "+s"(w_)); F.ws = (unsigned char*)w_; const __attribute__((address_space(4))) char* k_ = kp0; asm volatile("" : "+s"(k_)); F.kp = k_; } while (0)
#define STEP_BEGIN if (st >= lo && st < hi) { asm volatile("; STEP_MARK_BEGIN %0" :: "n"(__LINE__)); RELAUNDER();
#define STEP_END   asm volatile("; STEP_MARK_END %0" :: "n"(__LINE__)); if (st + 1 < hi) { xcd_barrier(bar); if (PROBE_DUP == 11) xcd_barrier(bar); } } ++st;
#define PROBE_REDIRECT(e) probe_redirect(e, WSP(float, WS_Z))
#define GEMM_STAGGER() do { if (STAG_GROUPS > 1) { const int sg_ = (F.bid >> 3) % STAG_GROUPS; for (int i_ = 0; i_ < sg_; ++i_) __builtin_amdgcn_s_sleep(STAG_SLEEP); } } while (0)
#define GEMM_RUN(EPI) { if (PROBE_DUP == 8) { auto E2_ = E; PROBE_REDIRECT(E2_); pg8::gemm_phase<decltype(E2_), pg8::StaticOrder, GEMM_ALIGN, GEMM_SP2>(ring, g, S, E2_, F.tid); RELAUNDER(); } \
    if (PROBE_DUP == 1) { pg8::EpiNull EN_; pg8::gemm_phase<pg8::EpiNull, pg8::StaticOrder, GEMM_ALIGN, GEMM_SP2>(ring, g, S, EN_, F.tid); RELAUNDER(); } \
    pg8::gemm_phase<pg8::EPI, pg8::StaticOrder, GEMM_ALIGN, GEMM_SP2>(ring, g, S, E, F.tid); }
#define GEMM_RUN_NSP(EPI, NSPV) { pg8::gemm_phase<pg8::EPI, pg8::StaticOrder, GEMM_ALIGN, GEMM_SP2, NSPV>(ring, g, S, E, F.tid); }
#define MODS_L (WSP(float, WS_MODS) + (size_t)l * 17 * NMOD)
    LAS unsigned char* ring = F.lds + RING_OFF;

    STEP_BEGIN
        for (int rep = 0; rep < (PROBE_DUP == 7 ? 2 : 1); ++rep)
        p0a_prologue(F, KIN(I_C), KIN(I_CCTX), KIN(I_ADAW), KIN(I_ADAB), KIN(I_S5LRE), KIN(I_S5LIM), KIN(I_S5LDT), KIN(I_S5BRE), KIN(I_S5BIM), KIN(I_S5CRE), KIN(I_S5CIM));
    STEP_END
    STEP_BEGIN
        for (int rep = 0; rep < (PROBE_DUP == 24 ? 2 : 1); ++rep) { p0c_shw(F, KIN(I_WIN), KIN(I_W1)); RELAUNDER(); }
    STEP_END

    for (int l = 0; l < DEPTH; ++l) {
        const bool need_ctx = l < DEPTH - 1;
        const int nrows = need_ctx ? RT : RL;
        STEP_BEGIN
            for (int rep = 0; rep < ((PROBE_DUP == 4 || PROBE_DUP == 20) ? 2 : 1); ++rep) {
            convert_weights(F, A, l, l);
            RELAUNDER();
            if (l == 0) norm0_phase(F, KIN(I_X), KIN(I_CTX), KIN(I_N1W), WSP(float, WS_MODS));
            else { rstd_phase(F, RL); RELAUNDER(); if (rep == 0) ctxfix_phase(F, MODS_L - 17 * NMOD + 16 * NMOD + 5 * DM, KIN(I_N1W) + (size_t)l * DM, MODS_L + 16 * NMOD + 1 * DM); }
            RELAUNDER(); }
        STEP_END
        STEP_BEGIN
            pg8::Gemm g{WSP(bf16, WS_H), WSP(bf16, WS_WIN), RT, LDZ, DM}; g.ablk = 1; pg8::StaticOrder S; S.init(RT, LDZ, F.G, F.bid);
            for (int rep = 0; rep < (PROBE_DUP == 14 ? 2 : 1); ++rep) {
            pg8::EpiStoreN E{WSP(bf16, WS_Z), LDZ, WSP(float, WS_RSTD), WSP(float, WS_SHW) + (size_t)l * 17 * (LDZ + DFF), LDZ + DFF};
            GEMM_STAGGER(); GEMM_RUN(EpiStoreN)
            RELAUNDER(); }
        STEP_END
        STEP_BEGIN
            for (int rep = 0; rep < ((PROBE_DUP == 4 || PROBE_DUP == 21) ? 2 : 1); ++rep) { prep_phase(F, A, l); RELAUNDER(); }
        STEP_END
        STEP_BEGIN
            for (int rep = 0; rep < (PROBE_DUP == 12 ? 2 : 1); ++rep) {
            { const pg8::GrpDesc gl{WSP(bf16, WS_XS), WSP(bf16, WS_WLRU), RT, 2048, 128, 512, 4}, gk{WSP(bf16, WS_AKV), WSP(bf16, WS_WKVUP), RT, 1024, 256, 256, 0},
                                 gq{WSP(bf16, WS_AQ), WSP(bf16, WS_WQUP), need_ctx ? RT : RL, 768, 384, 384, 0};
              const pg8::EpiLru el{WSP(bf16, WS_XS), WSP(bf16, WS_LOGA), WSP(bf16, WS_GB), WSP(float, WS_LRUC)};
              const pg8::EpiStoreBf16 ek{WSP(bf16, WS_KVRAW), 1024}, eq{WSP(bf16, WS_QRAW), 768};
              pg8::gemm_group3(ring, gl, gk, gq, el, ek, eq, F.G, F.bid, F.tid); }
            RELAUNDER(); }
        STEP_END
        STEP_BEGIN
            for (int rep = 0; rep < (PROBE_DUP == 3 ? 2 : 1); ++rep) {
            const int s5wg = (S5_IN_L4 && F.G >= 256) ? 64 : 0;
            if (F.bid < s5wg) { const int wu = F.bid * 8 + F.wave; s5_scan(F, l, wu, wu + 1); }
            else {
            for (int wu = (F.bid - s5wg) * NWAVES + F.wave; wu < NB * 2 * 36; wu += (F.G - s5wg) * NWAVES) lru_chunk<false>(F, wu);
            RELAUNDER();
            mla_finish(F, A, l, need_ctx, s5wg, F.G - s5wg); }
            RELAUNDER(); }
        STEP_END
        STEP_BEGIN
            const int nattn = 704 + (need_ctx ? 64 : 0), nunits = nattn + 144;
            volatile LAS unsigned* slot = F.MISC + 16;
            for (int rep = 0; rep < ((PROBE_DUP == 2 || PROBE_DUP == 5 || PROBE_DUP == 6 || PROBE_DUP == 9) ? 2 : 1); ++rep) {
            gu32* qh = F.ctl + CW_QUEUE + 64 * (l + 4 * rep);
            const int ubase = (rep == 1 && PROBE_DUP == 6) ? 192 : (rep == 1 && PROBE_DUP == 9) ? 128 : 0;
            const int ulim = (rep == 1 && PROBE_DUP == 5) ? 128 : (rep == 1 && PROBE_DUP == 9) ? 192 : nunits;
            for (;;) {
                __syncthreads();
                if (F.tid == 0) slot[0] = __hip_atomic_fetch_add(qh, 1u, __ATOMIC_RELAXED, __HIP_MEMORY_SCOPE_AGENT);
                __syncthreads();
                const int u = ubase + __builtin_amdgcn_readfirstlane((int)slot[0]);
                if (u >= ulim) break;
                if (u < 128) mlstm_chain(F, A, l, u);
                else if (u < 192) { if (!(S5_IN_L4 && F.G >= 256)) { const int wu = (u - 128) * 8 + F.wave; s5_scan(F, l, wu, wu + 1); } }
                else if (u >= nattn) lru_chunk<true>(F, (u - nattn) * 8 + F.wave);
                else { int ab, ah, aq, an; const int ua = u - 192;
                    if (ua < 512) { ab = ua >> 5; ah = (ua >> 3) & 3; aq = (ua >> 5) * SEQ + 256 * (ua & 7); an = TOK / 64; }
                    else { const int uc = ua - 512; ab = uc >> 2; ah = uc & 3; aq = RL + (uc >> 2) * CTXL; an = CTXL / 64; }
                    attn_unit(F, ab, ah, aq, an, KIN(I_QN) + (size_t)l * 192); }
                RELAUNDER();
            }
            }
        STEP_END
        STEP_BEGIN
            for (int rep = 0; rep < ((PROBE_DUP == 4 || PROBE_DUP == 22) ? 2 : 1); ++rep) { finish_phase<true, false>(F, A, l, nrows); RELAUNDER(); }
        STEP_END
        STEP_BEGIN
            pg8::Gemm g{WSP(bf16, WS_A5), WSP(bf16, WS_WGLU), nrows, 512, 512}; pg8::StaticOrder S; S.init(nrows, 512, F.G, F.bid);
            for (int rep = 0; rep < (PROBE_DUP == 13 ? 2 : 1); ++rep) {
            pg8::EpiGlu E{WSP(bf16, WS_A5), WSP(bf16, WS_Y), DM, KIN(I_S5GLUB) + (size_t)l * 512};
            GEMM_RUN(EpiGlu)
            RELAUNDER();
            finish_phase<false, true>(F, A, l, nrows);
            RELAUNDER(); }
        STEP_END
        STEP_BEGIN
            pg8::Gemm g{WSP(bf16, WS_Y), WSP(bf16, WS_WOUT), nrows, DM, DM}; pg8::StaticOrder S; S.init(nrows, DM, F.G, F.bid);
            if (l == 0) {
                pg8::EpiResNF E{KIN(I_X), KIN(I_CTX) - (size_t)RL * DM, WSP(bf16, WS_X), MODS_L + 2 * DM, 0, WSP(bf16, WS_H), KIN(I_N2W) + (size_t)l * DM, MODS_L + 4 * DM, WSP(float, WS_SSP)};
                GEMM_RUN(EpiResNF)
            } else {
                pg8::EpiResN E{WSP(bf16, WS_X), WSP(bf16, WS_X), WSP(bf16, WS_X), MODS_L + 2 * DM, 0, WSP(bf16, WS_H), KIN(I_N2W) + (size_t)l * DM, MODS_L + 4 * DM, WSP(float, WS_SSP)};
                GEMM_RUN(EpiResN)
            }
        STEP_END
        STEP_BEGIN
            for (int rep = 0; rep < (PROBE_DUP == 23 ? 2 : 1); ++rep) { rstd_phase(F, nrows); RELAUNDER(); }
        STEP_END
        { const int nch = (nrows + MLP_CHUNK - 1) / MLP_CHUNK;
          for (int c = 0; c <= nch; ++c) {
            STEP_BEGIN
                const int g1first = (MLP_ALT && c >= 1 && c < nch) ? ((F.bid >> 3) & 1) : 0;
                for (int ord = 0; ord < 2; ++ord) { const int which = ord ^ g1first;
                if (which == 0) {
                if (c >= 1) { const int r0 = (c - 1) * MLP_CHUNK, m = min(MLP_CHUNK, nrows - r0); const bf16* hid = WSP(bf16, WS_Z) + (size_t)((c - 1) & 1) * MLP_CHUNK * DFF;
                    if (m >= 8192) {
                        if (need_ctx) {
                            pg8::Gemm g{hid, WSP(bf16, WS_W2), m, DM, DFF}; g.ablk = 1; pg8::StaticOrder S; S.init(m, DM, F.G, F.bid);
                            pg8::EpiResN E{WSP(bf16, WS_X), WSP(bf16, WS_X), WSP(bf16, WS_X), MODS_L + 5 * DM, r0,
                                           WSP(bf16, WS_H), KIN(I_N1W) + (size_t)(l + 1) * DM, MODS_L + 17 * NMOD + 1 * DM, WSP(float, WS_SSP)};
                            GEMM_RUN(EpiResN)
                        } else {
                            pg8::Gemm g{hid, WSP(bf16, WS_W2), m, DM, DFF}; g.ablk = 1; pg8::StaticOrder S; S.init(m, DM, F.G, F.bid);
                            pg8::EpiResOut E{WSP(bf16, WS_X), F.out, MODS_L + 5 * DM, r0};
                            GEMM_RUN(EpiResOut)
                        }
                    } else {
                        pg8::Gemm g{hid, WSP(bf16, WS_W2), m, 2 * DM, DFF / 2, DFF, DM / 256}; g.ablk = 1; pg8::StaticOrder S; S.init(m, 2 * DM, F.G, F.bid);
                        pg8::EpiPart E{WSP(float, WS_LOGA), DM / 256, RC};
                        GEMM_RUN_NSP(EpiPart, 8)
                    }
                    RELAUNDER(); }
                } else {
                if (c < nch) { const int r0 = c * MLP_CHUNK, m = min(MLP_CHUNK, nrows - r0);
                    pg8::Gemm g{WSP(bf16, WS_H) + (size_t)r0 * DM, WSP(bf16, WS_W1), m, DFF, DM}; g.ablk = 1; pg8::StaticOrder S; S.init(m, DFF, F.G, F.bid);
                    pg8::EpiRelu2N E{WSP(bf16, WS_Z) + (size_t)(c & 1) * MLP_CHUNK * DFF, DFF, WSP(float, WS_RSTD), WSP(float, WS_SHW) + (size_t)l * 17 * (LDZ + DFF) + LDZ, LDZ + DFF, r0};
                    if (PROBE_DUP == 25) { GEMM_RUN(EpiRelu2N) RELAUNDER(); }
                    GEMM_RUN(EpiRelu2N) }
                }
                RELAUNDER(); }
            STEP_END
          } }
    }
#undef STEP_BEGIN
#undef STEP_END
}

extern "C" void kernel_launch(void* const* d_in, const int* in_sizes, int n_in, void* d_out, int out_size, void* d_ws, size_t ws_size, hipStream_t stream) {
    static int grid = 0;
    if (grid == 0) {
        if (n_in != N_IN || in_sizes[0] != RL * DM || out_size != RL * DM || ws_size < WS_END) {
            fprintf(stderr, "kernel_launch: shape/workspace mismatch: n_in %d in0 %d out %d ws %zu (need %zu); nothing launched\n", n_in, n_in > 0 ? in_sizes[0] : -1, out_size, ws_size, (size_t)WS_END); grid = -1; return; }
        int dev = 0, cus = 0, per_cu = 0;
        if (hipGetDevice(&dev) != hipSuccess || hipDeviceGetAttribute(&cus, hipDeviceAttributeMultiprocessorCount, dev) != hipSuccess) { grid = -1; return; }
        if (hipFuncSetAttribute((const void*)trunk_fwd, hipFuncAttributeMaxDynamicSharedMemorySize, LDS_BYTES) != hipSuccess) { fprintf(stderr, "kernel_launch: hipFuncSetAttribute failed\n"); grid = -1; return; }
        if (hipOccupancyMaxActiveBlocksPerMultiprocessor(&per_cu, (const void*)trunk_fwd, NTHR, LDS_BYTES) != hipSuccess || per_cu < 1)
            fprintf(stderr, "kernel_launch: note: occupancy query reports %d workgroups per CU\n", per_cu);
        (void)hipGetLastError();
        grid = cus;
    }
    if (grid < 0) return;
    if (hipMemsetAsync((char*)d_ws + WS_CTL, 0, CTL_ZERO_BYTES, stream) != hipSuccess) return;
    Args a{};
    for (int i = 0; i < N_IN; ++i) a.in[i] = (const float*)d_in[i];
    a.out = (float*)d_out; a.ws = (unsigned char*)d_ws;
#ifndef MK_SPLIT
    a.lo = 0; a.hi = 1 << 20;
    hipLaunchKernelGGL(trunk_fwd, dim3(grid), dim3(NTHR), LDS_BYTES, stream, a);
#else
    for (int s = 0; s < MK_SPLIT; ++s) { a.lo = s; a.hi = s + 1; hipLaunchKernelGGL(trunk_fwd, dim3(grid), dim3(NTHR), LDS_BYTES, stream, a); }
#endif
}
```

```cpp
#include <hip/hip_runtime.h>
#include <cstdio>
#include <cstdint>
#ifndef GEMM_ALIGN
#define GEMM_ALIGN true
#endif
#ifndef GEMM_SP2
#define GEMM_SP2 true
#endif
#ifndef MLP_CHUNK
#define MLP_CHUNK 8192
#endif
#ifndef STAG_GROUPS
#define STAG_GROUPS 1
#define STAG_SLEEP 64
#endif
#ifndef EPI_NT
#define EPI_NT 0
#endif
#ifndef S5_IN_L4
#define S5_IN_L4 0
#endif
#ifndef MLP_ALT
#define MLP_ALT 0
#endif
#ifndef WOUT_STAG_GROUPS
#define WOUT_STAG_GROUPS 1
#define WOUT_STAG_STEPS 4
#endif
#ifndef PROBE_DUP
#define PROBE_DUP 0
#endif

constexpr int DM = 2048, NB = 16, SEQ = 2048, CTXL = 256, DEPTH = 4, DFF = 8192;
constexpr int RL = NB * SEQ;
constexpr int RC = NB * CTXL;
constexpr int RT = RL + RC;
constexpr int TOK = SEQ + CTXL;
constexpr int NZ = 4176, LDZ = 4352;
constexpr int ZU = 0, ZMQ = 512, ZMK = 1024, ZMV = 1536, ZMO = 2048, ZMG = 2560, ZCQ = 2576, ZCKV = 2960, ZKR = 3088, ZLX = 3152, ZLG = 3664;
constexpr int NMOD = 6 * DM;
constexpr float EPS = 1e-6f;
constexpr int NWAVES = 8, NTHR = 512;

enum { I_X = 0, I_C, I_CTX, I_CCTX, I_ADAW, I_ADAB, I_N1W, I_N2W, I_WIN, I_WOUT, I_S5LRE, I_S5LIM, I_S5LDT, I_S5BRE, I_S5BIM, I_S5CRE, I_S5CIM, I_S5D, I_S5GLUW, I_S5GLUB,
       I_MLIG, I_MLFG, I_MLON, I_QAN, I_WQUP, I_KVAN, I_WKVUP, I_QN, I_KN, I_LCW, I_LCB, I_LWA, I_LBA, I_LWX, I_LBX, I_LLAM, I_W1, I_W2, N_IN };

constexpr size_t MiB = 1u << 20;
#ifndef WS_SKEW
#define WS_SKEW 1
#endif
#ifndef BLK_LAYOUT
#define BLK_LAYOUT 1
#endif
__host__ __device__ __forceinline__ size_t blk_off(int row, int col, int nct) { return BLK_LAYOUT ? (((size_t)((row >> 8) * nct + (col >> 8))) << 16) + (size_t)((row & 255) * 256 + (col & 255)) : (size_t)row * (size_t)(256 * nct) + col; }
constexpr size_t WS_CTL = 0, CTL_ZERO_BYTES = 1 * MiB;
constexpr size_t WS_MODS = 1 * MiB;
constexpr size_t WS_S5A = 5 * MiB;
constexpr size_t WS_S5BB = 5 * MiB + 512 * 1024;
constexpr size_t WS_S5CM = 6 * MiB + 512 * 1024;
constexpr size_t WS_LRUC = 7 * MiB + 512 * 1024;
constexpr size_t WS_ROPE = 7 * MiB + 640 * 1024;
constexpr size_t WS_W = 8 * MiB;
constexpr size_t WS_WIN = WS_W;
constexpr size_t WS_WOUT = WS_WIN + 17 * MiB;
constexpr size_t WS_W1 = WS_WOUT + 8 * MiB;
constexpr size_t WS_W2 = WS_W1 + 32 * MiB;
constexpr size_t WS_WGLU = WS_W2 + 32 * MiB;
constexpr size_t WS_WQUP = WS_WGLU + 1 * MiB;
constexpr size_t WS_WKVUP = WS_WQUP + 1 * MiB;
constexpr size_t WS_WLRU = WS_WKVUP + 1 * MiB;
constexpr size_t WS_X = WS_WLRU + 2 * MiB;
constexpr size_t WS_H = WS_X + 288 * MiB + WS_SKEW * 129 * 256;
constexpr size_t WS_Z = WS_H + 144 * MiB + WS_SKEW * 67 * 256;
constexpr size_t WS_Y = WS_Z + 306 * MiB + WS_SKEW * 201 * 256;
constexpr size_t WS_HID = WS_Y + 144 * MiB + WS_SKEW * 37 * 256;
constexpr size_t WS_T = WS_HID + 128 * MiB + WS_SKEW * 93 * 256;
constexpr size_t WS_XS = WS_H;
constexpr size_t WS_AQ = WS_H + 36 * MiB;
constexpr size_t WS_AKV = WS_H + 63 * MiB;
constexpr size_t WS_Q = WS_H;
constexpr size_t WS_K = WS_H + 54 * MiB;
constexpr size_t WS_VT = WS_H + 108 * MiB;
constexpr size_t WS_QRAW = WS_HID;
constexpr size_t WS_KVRAW = WS_HID + 54 * MiB;
constexpr size_t WS_LOGA = WS_T;
constexpr size_t WS_GB = WS_T + 72 * MiB;
constexpr size_t WS_YS = WS_T + 144 * MiB;
constexpr size_t WS_A5 = WS_X + 144 * MiB;
constexpr size_t WS_MH = WS_T + 216 * MiB;
constexpr size_t WS_LH = WS_T + 288 * MiB;
constexpr size_t WS_MODP = WS_Z;
constexpr size_t WS_LSUM = WS_T + 360 * MiB;
constexpr size_t WS_SHW = WS_T + 368 * MiB;
constexpr size_t WS_SSP = WS_T + 372 * MiB;
constexpr size_t WS_RSTD = WS_T + 377 * MiB;
constexpr size_t WS_END = WS_T + 378 * MiB;
static_assert(WS_END <= (size_t)1536 * MiB, "d_ws map exceeds 4 x largest input tensor");

constexpr int CW_TMO = 0, CW_CODE = 1;
constexpr int CW_BAR = 4096;
constexpr int CW_QUEUE = 8192;

constexpr int RING_OFF = 0, RING_BYTES = 131072;
constexpr int LDSCTL_OFF = RING_BYTES, MISC_OFF = LDSCTL_OFF + 320;
constexpr int LDS_BYTES = 147456;

#define GAS __attribute__((address_space(1)))
#define LAS __attribute__((address_space(3)))
typedef unsigned short bf16;
typedef unsigned v4u __attribute__((ext_vector_type(4)));
typedef unsigned v2u __attribute__((ext_vector_type(2)));
typedef float f32x4 __attribute__((ext_vector_type(4)));
typedef float f32x16 __attribute__((ext_vector_type(16)));
typedef short bf16x8 __attribute__((ext_vector_type(8)));
typedef short bf16x4 __attribute__((ext_vector_type(4)));
typedef GAS unsigned gu32;
#define RLX_AGENT __ATOMIC_RELAXED, __HIP_MEMORY_SCOPE_AGENT
#define LDS_WAIT() asm volatile("s_waitcnt lgkmcnt(0)" ::: "memory")
#define VM_WAIT() asm volatile("s_waitcnt vmcnt(0)" ::: "memory")
__device__ __forceinline__ unsigned f2bf(float f) { unsigned u = __builtin_bit_cast(unsigned, f); return (u + 0x7fffu + ((u >> 16) & 1u)) >> 16; }
typedef __bf16 bf16x2_t __attribute__((ext_vector_type(2)));
typedef float f32x2_t __attribute__((ext_vector_type(2)));
__device__ __forceinline__ unsigned pk2(float lo, float hi) { const f32x2_t v = {lo, hi}; const bf16x2_t b = __builtin_convertvector(v, bf16x2_t); return __builtin_bit_cast(unsigned, b); }
__device__ __forceinline__ float bf2f(unsigned b) { return __builtin_bit_cast(float, b << 16); }
__device__ __forceinline__ float bflo(unsigned w) { return __builtin_bit_cast(float, w << 16); }
__device__ __forceinline__ float bfhi(unsigned w) { return __builtin_bit_cast(float, w & 0xffff0000u); }
__device__ __forceinline__ void unpack8(const v4u w, float (&f)[8]) { f[0] = bflo(w.x); f[1] = bfhi(w.x); f[2] = bflo(w.y); f[3] = bfhi(w.y); f[4] = bflo(w.z); f[5] = bfhi(w.z); f[6] = bflo(w.w); f[7] = bfhi(w.w); }
__device__ __forceinline__ v4u pack8(const float (&f)[8]) { v4u w; w.x = pk2(f[0], f[1]); w.y = pk2(f[2], f[3]); w.z = pk2(f[4], f[5]); w.w = pk2(f[6], f[7]); return w; }
__device__ __forceinline__ float sigmoidf_(float x) { return __builtin_amdgcn_rcpf(1.f + __expf(-x)); }
__device__ __forceinline__ float gelu_tanh(float x) { const float u = 0.7978845608028654f * (x + 0.044715f * x * x * x); const float t = 1.f - 2.f * __builtin_amdgcn_rcpf(1.f + __expf(2.f * u)); return 0.5f * x * (1.f + t); }
__device__ __forceinline__ float softplusf_(float x) { return fmaxf(x, 0.f) + log1pf(__expf(-fabsf(x))); }
__device__ __forceinline__ float logsigmoidf_(float x) { return fminf(x, 0.f) - log1pf(__expf(-fabsf(x))); }
__device__ __forceinline__ float shx(float v, int mask, int lane) { return __builtin_bit_cast(float, __builtin_amdgcn_ds_bpermute((lane ^ mask) << 2, __builtin_bit_cast(int, v))); }
__device__ __forceinline__ float shup(float v, int delta, int lane) { return __builtin_bit_cast(float, __builtin_amdgcn_ds_bpermute(((lane - delta) & 63) << 2, __builtin_bit_cast(int, v))); }
__device__ __forceinline__ float wave_sum(float v, int lane) {
#pragma unroll
    for (int o = 1; o < 64; o <<= 1) v += shx(v, o, lane);
    return v;
}
__device__ __forceinline__ v4u zero_v4u() { unsigned z = 0u; asm volatile("" : "+v"(z)); return (v4u){z, z, z, z}; }
__device__ __forceinline__ int row_scan(int b, int dir, int p) {
    if (p < CTXL) { const int t = dir ? (CTXL - 1 - p) : p; return RL + b * CTXL + t; }
    const int q = p - CTXL; const int t = dir ? (SEQ - 1 - q) : q; return b * SEQ + t;
}
__device__ __forceinline__ int row_key(int b, int key) { return key < CTXL ? RL + b * CTXL + key : b * SEQ + (key - CTXL); }
__device__ __forceinline__ int mod_row(int r) { return r < RL ? (r >> 11) : NB; }
namespace pg8 {
#define PG8_LAS __attribute__((address_space(3)))
typedef unsigned short bf16_t;
typedef short bf16x8 __attribute__((ext_vector_type(8)));
typedef float f32x4 __attribute__((ext_vector_type(4)));
typedef unsigned u32x4 __attribute__((ext_vector_type(4)));
constexpr int BM = 256, BK = 64, HALF = 128, HTB = HALF * BK * 2  , STAGE_BYTES = 8 * HTB, NXCD = 8, WGM = 8;

__host__ __device__ __forceinline__ int lds_byte(int r, int c) { const int st = (r >> 4) * 2 + (c >> 5), rr = r & 15, cc = c & 31, ob = rr * 64 + cc * 2; return st * 1024 + (ob ^ (((ob >> 9) & 1) << 5)); }
__host__ __device__ __forceinline__ void stage_rc(int b, int& R, int& C) { const int st = b / 1024, sb = b % 1024, swz = sb ^ (((sb >> 9) & 1) << 5); R = (st >> 1) * 16 + swz / 64; C = (st & 1) * 32 + (swz % 64) / 2; }
__host__ __device__ __forceinline__ int perm32(int rho) { const int n = rho >> 4, i = rho & 15; return 8 * (i >> 2) + 4 * n + (i & 3); }

struct Unit { int pm, pn; };
struct Gemm { const bf16_t* A; const bf16_t* Bt; int M, N, K; int ld = 0, nsplit = 0, ablk = 0; };

struct StaticOrder {
    int nM, nN, nwg, G, c;
    __host__ __device__ void init(int M, int N, int G_, int c_) { nM = M / BM; nN = N / BM; nwg = nM * nN; G = G_; c = c_; }
    __host__ __device__ bool next(int i, Unit& u) const {
        const long L = (long)i * G + c; if (L >= nwg) return false;
        int wgid = (int)L; { const int q = nwg / NXCD, r = nwg % NXCD, xcd = wgid % NXCD, off = wgid / NXCD; wgid = (xcd < r ? xcd * (q + 1) : r * (q + 1) + (xcd - r) * q) + off; }
        const int nig = WGM * nN, gid = wgid / nig, fm = gid * WGM, gsz = (nM - fm) < WGM ? (nM - fm) : WGM;
        u.pm = fm + ((wgid % nig) % gsz); u.pn = (wgid % nig) / gsz; return true;
    }
    __device__ __forceinline__ void a_ready(const Unit&) const {}
    __device__ __forceinline__ void done(const Unit&) const {}
};

__device__ __forceinline__ unsigned cvt_pk_bf16(float lo, float hi) { unsigned r; asm volatile("v_cvt_pk_bf16_f32 %0, %1, %2" : "=v"(r) : "v"(lo), "v"(hi)); return r; }
typedef float f32x2 __attribute__((ext_vector_type(2)));
__device__ __forceinline__ float bf_lo(unsigned w) { return __builtin_bit_cast(float, w << 16); }
__device__ __forceinline__ float bf_hi(unsigned w) { return __builtin_bit_cast(float, w & 0xffff0000u); }
template <class T> __device__ __forceinline__ void st_stream(T* p, const T v) { if (EPI_NT) __builtin_nontemporal_store(v, p); else *p = v; }
struct EpiStoreBf16 {
    static constexpr bool PERM = true, AFTER_DRAIN = false;
    bf16_t* O; int ldc;
    __device__ __forceinline__ void operator()(const f32x4 (&acc)[2][2][4][2], const Unit& u, int wr, int wc, int fr, int fq) const {
        const int row0 = u.pm * BM + wr * 64 + fr, col0 = u.pn * BM + wc * 32 + 8 * fq;
#pragma unroll
        for (int ai = 0; ai < 2; ++ai)
#pragma unroll
            for (int m = 0; m < 4; ++m) { bf16_t* rowp = O + (size_t)(row0 + ai * HALF + m * 16) * ldc + col0;
#pragma unroll
                for (int bj = 0; bj < 2; ++bj) { const f32x4 v0 = acc[ai][bj][m][0], v1 = acc[ai][bj][m][1];
                    u32x4 w; w.x = cvt_pk_bf16(v0[0], v0[1]); w.y = cvt_pk_bf16(v0[2], v0[3]); w.z = cvt_pk_bf16(v1[0], v1[1]); w.w = cvt_pk_bf16(v1[2], v1[3]);
                    *(u32x4*)(rowp + bj * HALF) = w; } }
    }
};
struct EpiRelu2 {
    static constexpr bool PERM = true, AFTER_DRAIN = false;
    bf16_t* O; int ldc;
    __device__ __forceinline__ void operator()(const f32x4 (&acc)[2][2][4][2], const Unit& u, int wr, int wc, int fr, int fq) const {
        const int row0 = u.pm * BM + wr * 64 + fr, col0 = u.pn * BM + wc * 32 + 8 * fq;
#pragma unroll
        for (int ai = 0; ai < 2; ++ai)
#pragma unroll
            for (int m = 0; m < 4; ++m) { bf16_t* rowp = O + (size_t)(row0 + ai * HALF + m * 16) * ldc + col0;
#pragma unroll
                for (int bj = 0; bj < 2; ++bj) { f32x4 v0 = acc[ai][bj][m][0], v1 = acc[ai][bj][m][1];
#pragma unroll
                    for (int j = 0; j < 4; ++j) { const float a = fmaxf(v0[j], 0.f), b = fmaxf(v1[j], 0.f); v0[j] = a * a; v1[j] = b * b; }
                    u32x4 w; w.x = cvt_pk_bf16(v0[0], v0[1]); w.y = cvt_pk_bf16(v0[2], v0[3]); w.z = cvt_pk_bf16(v1[0], v1[1]); w.w = cvt_pk_bf16(v1[2], v1[3]);
                    *(u32x4*)(rowp + bj * HALF) = w; } }
    }
};
__device__ __forceinline__ void atomic_add_f32_dev(float* p, float v) { asm volatile("global_atomic_add_f32 %0, %1, off sc1" :: "v"(p), "v"(v) : "memory"); }
template <bool ATOMIC = false> struct EpiResT {
    static constexpr bool PERM = true, AFTER_DRAIN = false;
    const float* xin; float* xout; const float* gate; int row_base;
    __device__ __forceinline__ void operator()(const f32x4 (&acc)[2][2][4][2], const Unit& u, int wr, int wc, int fr, int fq) const {
        const int row0 = row_base + u.pm * BM + wr * 64 + fr, col0 = u.pn * BM + wc * 32 + 8 * fq;
        const int mrow = row0 < 32768 ? (row0 >> 11) : 16;
        const float* gp = gate + (size_t)mrow * 12288 + col0;
        f32x4 gv[2][2];
#pragma unroll
        for (int bj = 0; bj < 2; ++bj)
#pragma unroll
            for (int n = 0; n < 2; ++n) gv[bj][n] = *(const f32x4*)(gp + bj * HALF + n * 4);
#pragma unroll
        for (int ai = 0; ai < 2; ++ai) {
            f32x4 xv[4][2][2];
#pragma unroll
            for (int m = 0; m < 4; ++m) { const size_t off = (size_t)(row0 + ai * HALF + m * 16) * 2048 + col0;
#pragma unroll
                for (int bj = 0; bj < 2; ++bj)
#pragma unroll
                    for (int n = 0; n < 2; ++n) xv[m][bj][n] = *(const f32x4*)(xin + off + bj * HALF + n * 4); }
#pragma unroll
            for (int m = 0; m < 4; ++m) { const size_t off = (size_t)(row0 + ai * HALF + m * 16) * 2048 + col0;
#pragma unroll
                for (int bj = 0; bj < 2; ++bj)
#pragma unroll
                    for (int n = 0; n < 2; ++n) *(f32x4*)(xout + off + bj * HALF + n * 4) = xv[m][bj][n] + gv[bj][n] * acc[ai][bj][m][n]; }
            asm volatile("" ::: "memory");
        }
    }
};
typedef EpiResT<false> EpiRes;
__device__ __forceinline__ float sigm(float x) { return __builtin_amdgcn_rcpf(1.f + __expf(-x)); }
struct EpiGlu {
    static constexpr bool PERM = true, AFTER_DRAIN = false;
    const bf16_t* A5; bf16_t* Y; int ldy; const float* bias;
    __device__ __forceinline__ void operator()(const f32x4 (&acc)[2][2][4][2], const Unit& u, int wr, int wc, int fr, int fq) const {
        const int row0 = u.pm * BM + wr * 64 + fr, col0 = u.pn * BM + wc * 32 + 8 * fq;
        f32x4 bv[2][2];
#pragma unroll
        for (int bj = 0; bj < 2; ++bj)
#pragma unroll
            for (int n = 0; n < 2; ++n) bv[bj][n] = *(const f32x4*)(bias + col0 + bj * HALF + 4 * n);
#pragma unroll
        for (int ai = 0; ai < 2; ++ai)
#pragma unroll
            for (int m = 0; m < 4; ++m) { const int row = row0 + ai * HALF + m * 16;
#pragma unroll
                for (int bj = 0; bj < 2; ++bj) { const u32x4 aw = *(const u32x4*)(A5 + (size_t)row * 512 + col0 + bj * HALF);
                    const f32x4 v0 = acc[ai][bj][m][0] + bv[bj][0], v1 = acc[ai][bj][m][1] + bv[bj][1];
                    const float a0 = bf_lo(aw.x), a1 = bf_hi(aw.x), a2 = bf_lo(aw.y), a3 = bf_hi(aw.y), a4 = bf_lo(aw.z), a5 = bf_hi(aw.z), a6 = bf_lo(aw.w), a7 = bf_hi(aw.w);
                    u32x4 w; w.x = cvt_pk_bf16(a0 * sigm(v0[0]), a1 * sigm(v0[1])); w.y = cvt_pk_bf16(a2 * sigm(v0[2]), a3 * sigm(v0[3]));
                    w.z = cvt_pk_bf16(a4 * sigm(v1[0]), a5 * sigm(v1[1])); w.w = cvt_pk_bf16(a6 * sigm(v1[2]), a7 * sigm(v1[3]));
                    *(u32x4*)(Y + (size_t)row * ldy + col0 + bj * HALF) = w; } }
    }
};
struct EpiLru {
    static constexpr bool PERM = true, AFTER_DRAIN = false;
    const bf16_t* XS; bf16_t* LOGA; bf16_t* GB; const float* cst;
    __device__ __forceinline__ void operator()(const f32x4 (&acc)[2][2][4][2], const Unit& u, int wr, int wc, int fr, int fq) const {
        const int row0 = u.pm * BM + wr * 64 + fr, d = u.pn >> 2, nb = u.pn & 3, ch0 = nb * 128 + wc * 32 + 8 * fq;
        const float* cp = cst + d * 512 + ch0;
#pragma unroll
        for (int ai = 0; ai < 2; ++ai)
#pragma unroll
            for (int m = 0; m < 4; ++m) { const int row = row0 + ai * HALF + m * 16;
                const u32x4 xw = *(const u32x4*)(XS + (size_t)row * 512 + ch0);
                const float xs[8] = {bf_lo(xw.x), bf_hi(xw.x), bf_lo(xw.y), bf_hi(xw.y), bf_lo(xw.z), bf_hi(xw.z), bf_lo(xw.w), bf_hi(xw.w)};
#pragma unroll
                for (int n = 0; n < 2; ++n) { const f32x4 bav = *(const f32x4*)(cp + 4 * n), bxv = *(const f32x4*)(cp + 1024 + 4 * n), spv = *(const f32x4*)(cp + 2048 + 4 * n);
                    float la[4], gb[4];
#pragma unroll
                    for (int i = 0; i < 4; ++i) { const float r = sigm(acc[ai][0][m][n][i] + bav[i]), ig = sigm(acc[ai][1][m][n][i] + bxv[i]); const float l = -8.f * r * spv[i];
                        la[i] = l; const float x2 = 2.f * l;
                        const float em = -x2 * (1.f + 0.5f * x2 * (1.f + (1.f / 3.f) * x2 * (1.f + 0.25f * x2 * (1.f + 0.2f * x2 * (1.f + (1.f / 6.f) * x2)))));
                        gb[i] = __builtin_amdgcn_sqrtf(fmaxf(x2 > -0.25f ? em : 1.f - __expf(x2), 0.f)) * (ig * xs[4 * n + i]); }
                    typedef unsigned u32x2 __attribute__((ext_vector_type(2)));
                    u32x2 w1, w2; w1.x = cvt_pk_bf16(la[0], la[1]); w1.y = cvt_pk_bf16(la[2], la[3]); w2.x = cvt_pk_bf16(gb[0], gb[1]); w2.y = cvt_pk_bf16(gb[2], gb[3]);
                    *(u32x2*)(LOGA + (size_t)row * 1024 + d * 512 + ch0 + 4 * n) = w1; *(u32x2*)(GB + (size_t)row * 1024 + d * 512 + ch0 + 4 * n) = w2; }
                asm volatile("" ::: "memory"); }
    }
};
struct EpiNull {
    static constexpr bool PERM = false, AFTER_DRAIN = false;
    __device__ __forceinline__ void operator()(const f32x4 (&acc)[2][2][4][2], const Unit& u, int wr, int wc, int fr, int fq) const {
#pragma unroll
        for (int ai = 0; ai < 2; ++ai)
#pragma unroll
            for (int bj = 0; bj < 2; ++bj)
#pragma unroll
                for (int m = 0; m < 4; ++m)
#pragma unroll
                    for (int n = 0; n < 2; ++n) asm volatile("" :: "v"(acc[ai][bj][m][n]));
    }
};

template <bool XIN_F32> struct EpiResNT {
    static constexpr bool PERM = true, AFTER_DRAIN = false;
    const void* xin; const void* xin_ctx; bf16_t* xout; const float* gate; int row_base;
    bf16_t* H; const float* nw; const float* nscale; float* SSP;
    __device__ __forceinline__ void operator()(const f32x4 (&acc)[2][2][4][2], const Unit& u, int wr, int wc, int fr, int fq) const {
        const int row0 = row_base + u.pm * BM + wr * 64 + fr, col0 = u.pn * BM + wc * 32 + 8 * fq, lane = fq * 16 + fr;
        const int mrow = row0 < 32768 ? (row0 >> 11) : 16;
        const float* gp = gate + (size_t)mrow * 12288 + col0; const float* sp = nscale + (size_t)mrow * 12288 + col0; const void* xb = row0 < 32768 ? xin : xin_ctx;
        f32x4 gv[2][2], hs[2][2];
#pragma unroll
        for (int bj = 0; bj < 2; ++bj)
#pragma unroll
            for (int n = 0; n < 2; ++n) { gv[bj][n] = *(const f32x4*)(gp + bj * HALF + n * 4); hs[bj][n] = *(const f32x4*)(nw + col0 + bj * HALF + n * 4) * (*(const f32x4*)(sp + bj * HALF + n * 4) + 1.f); }
        constexpr int NB_ = XIN_F32 ? 4 : 2, MB_ = XIN_F32 ? 2 : 4;
#pragma unroll
        for (int am = 0; am < NB_; ++am) {
            const int ai = XIN_F32 ? (am >> 1) : am, mb = XIN_F32 ? 2 * (am & 1) : 0;
            f32x4 xv[XIN_F32 ? 2 : 1][2][2]; u32x4 xw[XIN_F32 ? 1 : 4][2];
#pragma unroll
            for (int mm = 0; mm < MB_; ++mm) { const int rowl = row0 + ai * HALF + (mb + mm) * 16; const size_t off = (size_t)rowl * 2048 + col0;
#pragma unroll
                for (int bj = 0; bj < 2; ++bj) {
                    if constexpr (XIN_F32) {
#pragma unroll
                        for (int n = 0; n < 2; ++n) xv[mm][bj][n] = *(const f32x4*)((const float*)xb + off + bj * HALF + n * 4); }
                    else xw[mm][bj] = *(const u32x4*)((const bf16_t*)xb + blk_off(rowl, col0, 8) + bj * HALF); } }
#pragma unroll
            for (int mm = 0; mm < MB_; ++mm) { const int m = mb + mm; const int row = row0 + ai * HALF + m * 16; const size_t off = blk_off(row, col0, 8); float ss = 0.f;
#pragma unroll
                for (int bj = 0; bj < 2; ++bj) { u32x4 w, xo;
#pragma unroll
                    for (int n = 0; n < 2; ++n) { f32x4 xi;
                        if constexpr (XIN_F32) xi = xv[mm][bj][n]; else xi = (f32x4){bf_lo(xw[mm][bj][2 * n]), bf_hi(xw[mm][bj][2 * n]), bf_lo(xw[mm][bj][2 * n + 1]), bf_hi(xw[mm][bj][2 * n + 1])};
                        const f32x4 xn = xi + gv[bj][n] * acc[ai][bj][m][n];
                        xo[2 * n] = cvt_pk_bf16(xn[0], xn[1]); xo[2 * n + 1] = cvt_pk_bf16(xn[2], xn[3]);
                        ss += (xn[0] * xn[0] + xn[1] * xn[1]) + (xn[2] * xn[2] + xn[3] * xn[3]);
                        const f32x4 hv = xn * hs[bj][n]; w[2 * n] = cvt_pk_bf16(hv[0], hv[1]); w[2 * n + 1] = cvt_pk_bf16(hv[2], hv[3]); }
                    st_stream((u32x4*)(xout + off + bj * HALF), xo);
                    st_stream((u32x4*)(H + off + bj * HALF), w); }
                ss += __builtin_bit_cast(float, __builtin_amdgcn_ds_bpermute((lane ^ 16) << 2, __builtin_bit_cast(int, ss)));
                ss += __builtin_bit_cast(float, __builtin_amdgcn_ds_bpermute((lane ^ 32) << 2, __builtin_bit_cast(int, ss)));
                if (fq == 0) SSP[(size_t)row * 32 + u.pn * 4 + wc] = ss; }
            asm volatile("" ::: "memory");
        }
    }
};
typedef EpiResNT<true> EpiResNF; typedef EpiResNT<false> EpiResN;
struct EpiResOut {
    static constexpr bool PERM = true, AFTER_DRAIN = false;
    const bf16_t* xin; float* xout; const float* gate; int row_base;
    __device__ __forceinline__ void operator()(const f32x4 (&acc)[2][2][4][2], const Unit& u, int wr, int wc, int fr, int fq) const {
        const int row0 = row_base + u.pm * BM + wr * 64 + fr, col0 = u.pn * BM + wc * 32 + 8 * fq;
        const int mrow = row0 < 32768 ? (row0 >> 11) : 16;
        const float* gp = gate + (size_t)mrow * 12288 + col0;
        f32x4 gv[2][2];
#pragma unroll
        for (int bj = 0; bj < 2; ++bj)
#pragma unroll
            for (int n = 0; n < 2; ++n) gv[bj][n] = *(const f32x4*)(gp + bj * HALF + n * 4);
#pragma unroll
        for (int ai = 0; ai < 2; ++ai) {
            u32x4 xw[4][2];
#pragma unroll
            for (int m = 0; m < 4; ++m) { const size_t off = blk_off(row0 + ai * HALF + m * 16, col0, 8);
#pragma unroll
                for (int bj = 0; bj < 2; ++bj) xw[m][bj] = *(const u32x4*)(xin + off + bj * HALF); }
#pragma unroll
            for (int m = 0; m < 4; ++m) { const size_t off = (size_t)(row0 + ai * HALF + m * 16) * 2048 + col0;
#pragma unroll
                for (int bj = 0; bj < 2; ++bj)
#pragma unroll
                    for (int n = 0; n < 2; ++n) { const f32x4 xi = (f32x4){bf_lo(xw[m][bj][2 * n]), bf_hi(xw[m][bj][2 * n]), bf_lo(xw[m][bj][2 * n + 1]), bf_hi(xw[m][bj][2 * n + 1])};
                        *(f32x4*)(xout + off + bj * HALF + n * 4) = xi + gv[bj][n] * acc[ai][bj][m][n]; } }
            asm volatile("" ::: "memory");
        }
    }
};
struct EpiStoreN {
    static constexpr bool PERM = true, AFTER_DRAIN = false;
    bf16_t* O; int ldc; const float* rstd; const float* shw; int ldshw;
    __device__ __forceinline__ void operator()(const f32x4 (&acc)[2][2][4][2], const Unit& u, int wr, int wc, int fr, int fq) const {
        const int row0 = u.pm * BM + wr * 64 + fr, col0 = u.pn * BM + wc * 32 + 8 * fq;
        const int mrow = row0 < 32768 ? (row0 >> 11) : 16;
        f32x4 sv[2][2];
#pragma unroll
        for (int bj = 0; bj < 2; ++bj)
#pragma unroll
            for (int n = 0; n < 2; ++n) sv[bj][n] = *(const f32x4*)(shw + (size_t)mrow * ldshw + col0 + bj * HALF + 4 * n);
#pragma unroll
        for (int ai = 0; ai < 2; ++ai)
#pragma unroll
            for (int m = 0; m < 4; ++m) { const int row = row0 + ai * HALF + m * 16; const float rs = rstd[row]; bf16_t* rowp = O + (size_t)row * ldc + col0;
#pragma unroll
                for (int bj = 0; bj < 2; ++bj) { const f32x4 v0 = acc[ai][bj][m][0] * rs + sv[bj][0], v1 = acc[ai][bj][m][1] * rs + sv[bj][1];
                    u32x4 w; w.x = cvt_pk_bf16(v0[0], v0[1]); w.y = cvt_pk_bf16(v0[2], v0[3]); w.z = cvt_pk_bf16(v1[0], v1[1]); w.w = cvt_pk_bf16(v1[2], v1[3]);
                    st_stream((u32x4*)(rowp + bj * HALF), w); } }
    }
};
struct EpiRelu2N {
    static constexpr bool PERM = true, AFTER_DRAIN = false;
    bf16_t* O; int ldc; const float* rstd; const float* shw; int ldshw; int row_base;
    __device__ __forceinline__ void operator()(const f32x4 (&acc)[2][2][4][2], const Unit& u, int wr, int wc, int fr, int fq) const {
        const int row0 = u.pm * BM + wr * 64 + fr, col0 = u.pn * BM + wc * 32 + 8 * fq, grow0 = row_base + row0;
        const int mrow = grow0 < 32768 ? (grow0 >> 11) : 16;
        f32x4 sv[2][2];
#pragma unroll
        for (int bj = 0; bj < 2; ++bj)
#pragma unroll
            for (int n = 0; n < 2; ++n) sv[bj][n] = *(const f32x4*)(shw + (size_t)mrow * ldshw + col0 + bj * HALF + 4 * n);
#pragma unroll
        for (int ai = 0; ai < 2; ++ai)
#pragma unroll
            for (int m = 0; m < 4; ++m) { const int row = row0 + ai * HALF + m * 16; const float rs = rstd[row_base + row]; bf16_t* rowp = O + blk_off(row, col0, ldc >> 8);
#pragma unroll
                for (int bj = 0; bj < 2; ++bj) { f32x4 v0 = acc[ai][bj][m][0] * rs + sv[bj][0], v1 = acc[ai][bj][m][1] * rs + sv[bj][1];
#pragma unroll
                    for (int j = 0; j < 4; ++j) { const float a = fmaxf(v0[j], 0.f), b = fmaxf(v1[j], 0.f); v0[j] = a * a; v1[j] = b * b; }
                    u32x4 w; w.x = cvt_pk_bf16(v0[0], v0[1]); w.y = cvt_pk_bf16(v0[2], v0[3]); w.z = cvt_pk_bf16(v1[0], v1[1]); w.w = cvt_pk_bf16(v1[2], v1[3]);
                    *(u32x4*)(rowp + bj * HALF) = w; } }
    }
};

struct EpiPart {
    static constexpr bool PERM = false, AFTER_DRAIN = false, VIRT = true;
    float* P; int ntile; int rows;
    __device__ __forceinline__ void operator()(const f32x4 (&acc)[2][2][4][2], const Unit& u, int wr, int wc, int fr, int fq) const {
        const int slice = u.pn / ntile, pn = u.pn % ntile, ld = 256 * ntile;
        const int row0 = u.pm * BM + wr * 64 + fr, col0 = pn * BM + wc * 32 + 4 * fq; float* base = P + (size_t)slice * rows * ld;
#pragma unroll
        for (int ai = 0; ai < 2; ++ai)
#pragma unroll
            for (int m = 0; m < 4; ++m) { float* rowp = base + (size_t)(row0 + ai * HALF + m * 16) * ld + col0;
#pragma unroll
                for (int bj = 0; bj < 2; ++bj)
#pragma unroll
                    for (int n = 0; n < 2; ++n) *(f32x4*)(rowp + bj * HALF + n * 16) = acc[ai][bj][m][n]; }
    }
};
template <class T, class = void> struct epi_virt { static constexpr bool value = false; };
template <class T> struct epi_virt<T, decltype((void)T::VIRT)> { static constexpr bool value = true; };
template <class Epi, class Sched, bool ALIGN_EPI = false, bool SP2 = false, int NSP = 0>
__device__ __forceinline__ void gemm_phase(PG8_LAS unsigned char* lds, const Gemm g, const Sched& S, const Epi& E, const int tid_in) {
    const int tid = tid_in,
    wid = __builtin_amdgcn_readfirstlane(tid >> 6), lane = tid & 63, wr = wid >> 2, wc = wid & 3, fr = lane & 15, fq = lane >> 4;
    const int K = g.K, nt = K / BK, LD = g.ld ? g.ld : g.K;
    const bool ablk = BLK_LAYOUT && g.ablk; const int LDA = ablk ? 256 : LD;
    unsigned voffA[2], voffB[2];
#pragma unroll
    for (int i = 0; i < 2; ++i) { int R, C; stage_rc(tid * 16 + i * 8192, R, C); const int Rb = Epi::PERM ? ((R & ~31) + perm32(R & 31)) : R;
        voffA[i] = (unsigned)(R * LDA + C) * 2u; voffB[i] = (unsigned)(Rb * LD + C) * 2u; }
    const size_t kstep = (size_t)(BK * 2);
    const size_t hstep = (size_t)HALF * LD * 2;
    const size_t hstepA = (size_t)HALF * LDA * 2;
#define PG8_KOFF(t) (ablk ? (((size_t)((t) >> 2) << 17) + (size_t)(((t) & 3) << 7)) : (size_t)(t) * kstep)
    const size_t tstep = 2 * hstep;
    const unsigned ldsw = (unsigned)wid * 1024u;
    const int aoff = lds_byte(wr * 64 + fr, fq * 8), boff = lds_byte(wc * 32 + fr, fq * 8);
#define PG8_SA(b, h) (((b) * 2 + (h)) * HTB)
#define PG8_SB(b, h) ((4 + (b) * 2 + (h)) * HTB)
#define PG8_STAGE(bufoff, gbase, voff) do { _Pragma("unroll") for (int _i = 0; _i < 2; ++_i) \
        __builtin_amdgcn_global_load_lds((const unsigned*)((const char*)(gbase) + (voff)[_i]), (PG8_LAS unsigned*)(lds + (bufoff) + ldsw + _i * 8192), 16, 0, 0); } while (0)
#define PG8_LDA(dst, b, h) do { _Pragma("unroll") for (int m = 0; m < 4; ++m) _Pragma("unroll") for (int k = 0; k < 2; ++k) dst[m][k] = *(const PG8_LAS bf16x8*)(lds + PG8_SA(b, h) + aoff + m * 2048 + k * 1024); } while (0)
#define PG8_LDB(dst, b, h) do { _Pragma("unroll") for (int n = 0; n < 2; ++n) _Pragma("unroll") for (int k = 0; k < 2; ++k) dst[n][k] = *(const PG8_LAS bf16x8*)(lds + PG8_SB(b, h) + boff + n * 2048 + k * 1024); } while (0)
#define PG8_MMA(ai, bj, At, Bt) do { __builtin_amdgcn_s_setprio(1); _Pragma("unroll") for (int m = 0; m < 4; ++m) _Pragma("unroll") for (int n = 0; n < 2; ++n) _Pragma("unroll") for (int k = 0; k < 2; ++k) \
        acc[ai][bj][m][n] = __builtin_amdgcn_mfma_f32_16x16x32_bf16(Bt[n][k], At[m][k], acc[ai][bj][m][n], 0, 0, 0); __builtin_amdgcn_s_setprio(0); } while (0)
#define PG8_WAIT_V(n) asm volatile("s_waitcnt vmcnt(" #n ")" ::: "memory")
#define PG8_WAIT_L(n) asm volatile("s_waitcnt lgkmcnt(" #n ")" ::: "memory")
#define PG8_BAR __builtin_amdgcn_s_barrier()
#define PG8_SCHED __builtin_amdgcn_sched_barrier(0)
    Unit cur, nxt; int ui = 0;
    if (!S.next(0, cur)) return;
    f32x4 acc[2][2][4][2];
    float zf = 0.f; asm volatile("" : "+v"(zf));
    const f32x4 zero4 = (f32x4){zf, zf, zf, zf};
#pragma unroll
    for (int a = 0; a < 2; ++a)
#pragma unroll
        for (int b = 0; b < 2; ++b)
#pragma unroll
            for (int m = 0; m < 4; ++m)
#pragma unroll
                for (int n = 0; n < 2; ++n) acc[a][b][m][n] = zero4;
    bf16x8 At[4][2], B0[2][2], B1[2][2];
#define PG8_SLICE(u) (NSP > 0 ? (u).pn / NSP : (NSP < 0 ? ((u).pn & (-NSP - 1)) : 0))
#define PG8_PNR(u) (NSP > 0 ? (u).pn % NSP : (u).pn)
#define PG8_ABASE(u) ((const char*)g.A + (size_t)(u).pm * tstep + (size_t)PG8_SLICE(u) * K * (ablk ? 512 : 2))
#define PG8_BBASE(u) ((const char*)g.Bt + (size_t)PG8_PNR(u) * tstep + (size_t)PG8_SLICE(u) * K * 2)
    const char* cA = PG8_ABASE(cur); const char* cB = PG8_BBASE(cur);
    S.a_ready(cur);
    if constexpr (SP2) {
        PG8_STAGE(PG8_SB(0, 0), cB, voffB); PG8_STAGE(PG8_SB(0, 1), cB + hstep, voffB); PG8_STAGE(PG8_SA(0, 0), cA, voffA); PG8_STAGE(PG8_SA(0, 1), cA + hstepA, voffA);
        if (wr == 1) PG8_BAR;
        PG8_WAIT_V(2); PG8_BAR;
        PG8_STAGE(PG8_SB(1, 0), cB + kstep, voffB); PG8_STAGE(PG8_SA(1, 0), cA + kstep, voffA); PG8_STAGE(PG8_SB(1, 1), cB + hstep + kstep, voffB);
        PG8_WAIT_V(6); PG8_BAR;
    } else {
        PG8_STAGE(PG8_SB(0, 0), cB, voffB); PG8_STAGE(PG8_SA(0, 0), cA, voffA); PG8_STAGE(PG8_SB(0, 1), cB + hstep, voffB); PG8_STAGE(PG8_SA(0, 1), cA + hstepA, voffA);
        if (wr == 1) PG8_BAR;
        PG8_WAIT_V(4); PG8_BAR;
        PG8_STAGE(PG8_SB(1, 0), cB + kstep, voffB); PG8_STAGE(PG8_SA(1, 0), cA + kstep, voffA); PG8_STAGE(PG8_SB(1, 1), cB + hstep + kstep, voffB);
        PG8_WAIT_V(6); PG8_BAR;
    }
    for (;;) {
        const bool has_next = S.next(ui + 1, nxt);
        const char* nA = has_next ? PG8_ABASE(nxt) : cA; const char* nB = has_next ? PG8_BBASE(nxt) : cB;
        for (int t = 0; t < nt; t += 2) {
            const bool last = (t == nt - 2);
            const char* a1 = cA + PG8_KOFF(t) + kstep;
            const char* a2 = last ? nA : cA + PG8_KOFF(t + 2); const char* b2 = last ? nB : cB + (size_t)(t + 2) * kstep;
            const char* a3 = a2 + kstep; const char* b3 = b2 + kstep;
            if (last && has_next) S.a_ready(nxt);
            if constexpr (SP2) {
            PG8_LDB(B0, 0, 0); PG8_LDB(B1, 0, 1); PG8_SCHED; PG8_LDA(At, 0, 0); PG8_STAGE(PG8_SA(1, 1), a1 + hstepA, voffA);
            PG8_WAIT_V(8); PG8_WAIT_L(0); PG8_BAR; PG8_MMA(0, 0, At, B0); PG8_MMA(0, 1, At, B1); PG8_BAR; PG8_SCHED;
            PG8_LDA(At, 0, 1); PG8_STAGE(PG8_SB(0, 0), b2, voffB); PG8_STAGE(PG8_SB(0, 1), b2 + hstep, voffB); PG8_STAGE(PG8_SA(0, 0), a2, voffA);
            PG8_WAIT_V(8); PG8_WAIT_L(0); PG8_BAR; PG8_MMA(1, 0, At, B0); PG8_MMA(1, 1, At, B1); PG8_BAR; PG8_SCHED;
            PG8_LDB(B0, 1, 0); PG8_LDB(B1, 1, 1); PG8_SCHED; PG8_LDA(At, 1, 0); PG8_STAGE(PG8_SA(0, 1), a2 + hstepA, voffA);
            PG8_WAIT_V(8); PG8_WAIT_L(0); PG8_BAR; PG8_MMA(0, 0, At, B0); PG8_MMA(0, 1, At, B1); PG8_BAR; PG8_SCHED;
            PG8_LDA(At, 1, 1); PG8_STAGE(PG8_SB(1, 0), b3, voffB); PG8_STAGE(PG8_SB(1, 1), b3 + hstep, voffB); PG8_STAGE(PG8_SA(1, 0), a3, voffA);
            PG8_WAIT_V(8); PG8_WAIT_L(0); PG8_BAR; PG8_MMA(1, 0, At, B0); PG8_MMA(1, 1, At, B1); PG8_BAR; PG8_SCHED;
            } else {
            PG8_LDB(B0, 0, 0); PG8_SCHED; PG8_LDA(At, 0, 0); PG8_STAGE(PG8_SA(1, 1), a1 + hstepA, voffA);
            PG8_WAIT_L(8); PG8_BAR; PG8_WAIT_L(0); PG8_MMA(0, 0, At, B0); PG8_BAR; PG8_SCHED;
            PG8_LDB(B1, 0, 1); PG8_STAGE(PG8_SB(0, 0), b2, voffB);
            PG8_BAR; PG8_WAIT_L(0); PG8_MMA(0, 1, At, B1); PG8_BAR;
            PG8_LDA(At, 0, 1); PG8_STAGE(PG8_SA(0, 0), a2, voffA);
            PG8_BAR; PG8_WAIT_L(0); PG8_MMA(1, 0, At, B0); PG8_BAR; PG8_SCHED;
            PG8_STAGE(PG8_SB(0, 1), b2 + hstep, voffB);
            PG8_WAIT_V(6); PG8_BAR; PG8_MMA(1, 1, At, B1); PG8_BAR;
            PG8_LDB(B0, 1, 0); PG8_SCHED; PG8_LDA(At, 1, 0); PG8_STAGE(PG8_SA(0, 1), a2 + hstepA, voffA);
            PG8_WAIT_L(8); PG8_BAR; PG8_WAIT_L(0); PG8_MMA(0, 0, At, B0); PG8_BAR; PG8_SCHED;
            PG8_LDB(B1, 1, 1); PG8_STAGE(PG8_SB(1, 0), b3, voffB);
            PG8_BAR; PG8_WAIT_L(0); PG8_MMA(0, 1, At, B1); PG8_BAR;
            PG8_LDA(At, 1, 1); PG8_STAGE(PG8_SA(1, 0), a3, voffA);
            PG8_BAR; PG8_WAIT_L(0); PG8_MMA(1, 0, At, B0); PG8_BAR; PG8_SCHED;
            PG8_STAGE(PG8_SB(1, 1), b3 + hstep, voffB);
            PG8_WAIT_V(6); PG8_BAR; PG8_MMA(1, 1, At, B1); PG8_BAR;
            }
        }
        if constexpr (ALIGN_EPI) { if (wr == 0) PG8_BAR; }
        if constexpr (!Epi::AFTER_DRAIN) { if constexpr (epi_virt<Epi>::value) E(acc, cur, wr, wc, fr, fq); else { const Unit eu{cur.pm, PG8_PNR(cur)}; E(acc, eu, wr, wc, fr, fq); } S.done(cur); }
        if (!has_next) break;
#pragma unroll
        for (int a = 0; a < 2; ++a)
#pragma unroll
            for (int b = 0; b < 2; ++b)
#pragma unroll
                for (int m = 0; m < 4; ++m)
#pragma unroll
                    for (int n = 0; n < 2; ++n) acc[a][b][m][n] = zero4;
        cur = nxt; cA = nA; cB = nB; ++ui;
        if constexpr (ALIGN_EPI) { if (wr == 1) PG8_BAR; }
    }
    PG8_WAIT_V(0);
    if constexpr (!ALIGN_EPI) { if (wr == 0) PG8_BAR; }
    PG8_BAR;
    if constexpr (Epi::AFTER_DRAIN) { E.fused(acc, cur, wr, wc, fr, fq, lds, wid, lane); S.done(cur); }
#undef PG8_SLICE
#undef PG8_PNR
#undef PG8_KOFF
#undef PG8_ABASE
#undef PG8_BBASE
#undef PG8_SA
#undef PG8_SB
#undef PG8_STAGE
#undef PG8_LDA
#undef PG8_LDB
#undef PG8_MMA
#undef PG8_WAIT_V
#undef PG8_WAIT_L
#undef PG8_BAR
#undef PG8_SCHED
}
}
namespace pg8 {
struct GrpDesc { const bf16_t* A; const bf16_t* Bt; int M, N, K, ld, bdiag; };
struct GUnit { int pm, pn, grp; };
__device__ __forceinline__ bool static_map(long L, int nM, int nN, Unit& u) {
    const int nwg = nM * nN; if (L >= nwg) return false;
    int wgid = (int)L; { const int q = nwg / NXCD, r = nwg % NXCD, xcd = wgid % NXCD, off = wgid / NXCD; wgid = (xcd < r ? xcd * (q + 1) : r * (q + 1) + (xcd - r) * q) + off; }
    const int nig = WGM * nN, gid = wgid / nig, fm = gid * WGM, gsz = (nM - fm) < WGM ? (nM - fm) : WGM;
    u.pm = fm + ((wgid % nig) % gsz); u.pn = (wgid % nig) / gsz; return true;
}
template <class E0, class E1, class E2>
__device__ __forceinline__ void gemm_group3(PG8_LAS unsigned char* lds, const GrpDesc g0, const GrpDesc g1, const GrpDesc g2, const E0& e0, const E1& e1, const E2& e2, const int Gn, const int c, const int tid_in) {
    static_assert(E0::PERM && E1::PERM && E2::PERM, "gemm_group3: the three epilogues must share the permuted weight staging");
    const int tid = tid_in, wid = __builtin_amdgcn_readfirstlane(tid >> 6), lane = tid & 63, wr = wid >> 2, wc = wid & 3, fr = lane & 15, fq = lane >> 4;
    const int n0 = (g0.M / BM) * (g0.N / BM), n1 = (g1.M / BM) * (g1.N / BM), n2 = (g2.M / BM) * (g2.N / BM);
    int sR[2], sRb[2], sC[2];
#pragma unroll
    for (int i = 0; i < 2; ++i) { int R, C; stage_rc(tid * 16 + i * 8192, R, C); sR[i] = R; sRb[i] = (R & ~31) + perm32(R & 31); sC[i] = C; }
    const size_t kstep = (size_t)(BK * 2);
    const unsigned ldsw = (unsigned)wid * 1024u;
    const int aoff = lds_byte(wr * 64 + fr, fq * 8), boff = lds_byte(wc * 32 + fr, fq * 8);
#define PG8_SA(b, h) (((b) * 2 + (h)) * HTB)
#define PG8_SB(b, h) ((4 + (b) * 2 + (h)) * HTB)
#define PG8_STAGE(bufoff, gbase, voff) do { _Pragma("unroll") for (int _i = 0; _i < 2; ++_i) \
        __builtin_amdgcn_global_load_lds((const unsigned*)((const char*)(gbase) + (voff)[_i]), (PG8_LAS unsigned*)(lds + (bufoff) + ldsw + _i * 8192), 16, 0, 0); } while (0)
#define PG8_LDA(dst, b, h) do { _Pragma("unroll") for (int m = 0; m < 4; ++m) _Pragma("unroll") for (int k = 0; k < 2; ++k) dst[m][k] = *(const PG8_LAS bf16x8*)(lds + PG8_SA(b, h) + aoff + m * 2048 + k * 1024); } while (0)
#define PG8_LDB(dst, b, h) do { _Pragma("unroll") for (int n = 0; n < 2; ++n) _Pragma("unroll") for (int k = 0; k < 2; ++k) dst[n][k] = *(const PG8_LAS bf16x8*)(lds + PG8_SB(b, h) + boff + n * 2048 + k * 1024); } while (0)
#define PG8_MMA(ai, bj, At, Bt) do { __builtin_amdgcn_s_setprio(1); _Pragma("unroll") for (int m = 0; m < 4; ++m) _Pragma("unroll") for (int n = 0; n < 2; ++n) _Pragma("unroll") for (int k = 0; k < 2; ++k) \
        acc[ai][bj][m][n] = __builtin_amdgcn_mfma_f32_16x16x32_bf16(Bt[n][k], At[m][k], acc[ai][bj][m][n], 0, 0, 0); __builtin_amdgcn_s_setprio(0); } while (0)
#define PG8_WAIT_V(n) asm volatile("s_waitcnt vmcnt(" #n ")" ::: "memory")
#define PG8_WAIT_L(n) asm volatile("s_waitcnt lgkmcnt(" #n ")" ::: "memory")
#define PG8_BAR __builtin_amdgcn_s_barrier()
#define PG8_SCHED __builtin_amdgcn_sched_barrier(0)
#define PG8_GETUNIT(L, u, ok) do { Unit t_; const long L_ = (L); ok = true; \
        if (L_ < n0) { static_map(L_, g0.M / BM, g0.N / BM, t_); u.grp = 0; } else if (L_ < n0 + n1) { static_map(L_ - n0, g1.M / BM, g1.N / BM, t_); u.grp = 1; } \
        else if (L_ < n0 + n1 + n2) { static_map(L_ - n0 - n1, g2.M / BM, g2.N / BM, t_); u.grp = 2; } else { ok = false; t_.pm = 0; t_.pn = 0; u.grp = 0; } u.pm = t_.pm; u.pn = t_.pn; } while (0)
#define PG8_GSEL(u, f) ((u).grp == 0 ? g0.f : ((u).grp == 1 ? g1.f : g2.f))
#define PG8_SETUNIT(u, pA, pB, ntv, ldv) do { const int ld_ = PG8_GSEL(u, ld), K_ = PG8_GSEL(u, K), bd_ = PG8_GSEL(u, bdiag); const int sl_ = bd_ ? ((u).pn & (bd_ - 1)) : 0; \
        pA = (const char*)PG8_GSEL(u, A) + (size_t)(u).pm * (size_t)(2 * HALF) * ld_ * 2 + (size_t)sl_ * K_ * 2; pB = (const char*)PG8_GSEL(u, Bt) + (size_t)(u).pn * (size_t)(2 * HALF) * ld_ * 2 + (size_t)sl_ * K_ * 2; ntv = K_ / BK; ldv = ld_; } while (0)
#define PG8_SETVOFF(vA, vB, ldv) do { _Pragma("unroll") for (int i = 0; i < 2; ++i) { vA[i] = (unsigned)(sR[i] * (ldv) + sC[i]) * 2u; vB[i] = (unsigned)(sRb[i] * (ldv) + sC[i]) * 2u; } } while (0)
    GUnit cur, nxt; int ui = 0; bool ok;
    PG8_GETUNIT((long)c, cur, ok);
    if (!ok) return;
    f32x4 acc[2][2][4][2];
    float zf = 0.f; asm volatile("" : "+v"(zf));
    const f32x4 zero4 = (f32x4){zf, zf, zf, zf};
#pragma unroll
    for (int a = 0; a < 2; ++a)
#pragma unroll
        for (int b = 0; b < 2; ++b)
#pragma unroll
            for (int m = 0; m < 4; ++m)
#pragma unroll
                for (int n = 0; n < 2; ++n) acc[a][b][m][n] = zero4;
    bf16x8 At[4][2], B0[2][2], B1[2][2];
    const char* cA; const char* cB; int nt, ldc_; PG8_SETUNIT(cur, cA, cB, nt, ldc_);
    unsigned voffA[2], voffB[2]; PG8_SETVOFF(voffA, voffB, ldc_);
    size_t hstep = (size_t)HALF * ldc_ * 2;
    PG8_STAGE(PG8_SB(0, 0), cB, voffB); PG8_STAGE(PG8_SB(0, 1), cB + hstep, voffB); PG8_STAGE(PG8_SA(0, 0), cA, voffA); PG8_STAGE(PG8_SA(0, 1), cA + hstep, voffA);
    if (wr == 1) PG8_BAR;
    PG8_WAIT_V(2); PG8_BAR;
    PG8_STAGE(PG8_SB(1, 0), cB + kstep, voffB); PG8_STAGE(PG8_SA(1, 0), cA + kstep, voffA); PG8_STAGE(PG8_SB(1, 1), cB + hstep + kstep, voffB);
    PG8_WAIT_V(6); PG8_BAR;
    for (;;) {
        bool has_next; PG8_GETUNIT((long)(ui + 1) * Gn + c, nxt, has_next);
        const char* nA = cA; const char* nB = cB; int ntn = nt, ldn = ldc_;
        if (has_next) PG8_SETUNIT(nxt, nA, nB, ntn, ldn);
        unsigned voffAn[2], voffBn[2]; PG8_SETVOFF(voffAn, voffBn, ldn);
        const size_t hstepn = (size_t)HALF * ldn * 2;
        for (int t = 0; t < nt; t += 2) {
            const bool last = (t == nt - 2);
            const char* a1 = cA + (size_t)(t + 1) * kstep;
            const char* a2 = last ? nA : cA + (size_t)(t + 2) * kstep; const char* b2 = last ? nB : cB + (size_t)(t + 2) * kstep;
            const char* a3 = a2 + kstep; const char* b3 = b2 + kstep;
            unsigned vA2[2], vB2[2];
#pragma unroll
            for (int i = 0; i < 2; ++i) { vA2[i] = last ? voffAn[i] : voffA[i]; vB2[i] = last ? voffBn[i] : voffB[i]; }
            const size_t h2 = last ? hstepn : hstep;
            PG8_LDB(B0, 0, 0); PG8_LDB(B1, 0, 1); PG8_SCHED; PG8_LDA(At, 0, 0); PG8_STAGE(PG8_SA(1, 1), a1 + hstep, voffA);
            PG8_WAIT_V(8); PG8_WAIT_L(0); PG8_BAR; PG8_MMA(0, 0, At, B0); PG8_MMA(0, 1, At, B1); PG8_BAR; PG8_SCHED;
            PG8_LDA(At, 0, 1); PG8_STAGE(PG8_SB(0, 0), b2, vB2); PG8_STAGE(PG8_SB(0, 1), b2 + h2, vB2); PG8_STAGE(PG8_SA(0, 0), a2, vA2);
            PG8_WAIT_V(8); PG8_WAIT_L(0); PG8_BAR; PG8_MMA(1, 0, At, B0); PG8_MMA(1, 1, At, B1); PG8_BAR; PG8_SCHED;
            PG8_LDB(B0, 1, 0); PG8_LDB(B1, 1, 1); PG8_SCHED; PG8_LDA(At, 1, 0); PG8_STAGE(PG8_SA(0, 1), a2 + h2, vA2);
            PG8_WAIT_V(8); PG8_WAIT_L(0); PG8_BAR; PG8_MMA(0, 0, At, B0); PG8_MMA(0, 1, At, B1); PG8_BAR; PG8_SCHED;
            PG8_LDA(At, 1, 1); PG8_STAGE(PG8_SB(1, 0), b3, vB2); PG8_STAGE(PG8_SB(1, 1), b3 + h2, vB2); PG8_STAGE(PG8_SA(1, 0), a3, vA2);
            PG8_WAIT_V(8); PG8_WAIT_L(0); PG8_BAR; PG8_MMA(1, 0, At, B0); PG8_MMA(1, 1, At, B1); PG8_BAR; PG8_SCHED;
        }
        if (wr == 0) PG8_BAR;
        { const Unit eu{cur.pm, cur.pn};
          if (cur.grp == 0) e0(acc, eu, wr, wc, fr, fq); else if (cur.grp == 1) e1(acc, eu, wr, wc, fr, fq); else e2(acc, eu, wr, wc, fr, fq); }
        if (!has_next) break;
#pragma unroll
        for (int a = 0; a < 2; ++a)
#pragma unroll
            for (int b = 0; b < 2; ++b)
#pragma unroll
                for (int m = 0; m < 4; ++m)
#pragma unroll
                    for (int n = 0; n < 2; ++n) acc[a][b][m][n] = zero4;
        cur = nxt; cA = nA; cB = nB; nt = ntn; ldc_ = ldn; hstep = hstepn;
#pragma unroll
        for (int i = 0; i < 2; ++i) { voffA[i] = voffAn[i]; voffB[i] = voffBn[i]; }
        ++ui;
        if (wr == 1) PG8_BAR;
    }
    PG8_WAIT_V(0);
    PG8_BAR;
#undef PG8_GETUNIT
#undef PG8_GSEL
#undef PG8_SETUNIT
#undef PG8_SETVOFF
#undef PG8_SA
#undef PG8_SB
#undef PG8_STAGE
#undef PG8_LDA
#undef PG8_LDB
#undef PG8_MMA
#undef PG8_WAIT_V
#undef PG8_WAIT_L
#undef PG8_BAR
#undef PG8_SCHED
}
}
#define XB_TMO      128
#define XB_XCNT(j)  (256  + 64 * (j))
#define XB_XSUB(j)  (1280 + 64 * (j))
#define XB_XGEN(j)  (2304 + 64 * (j))
#define XB_TOP      3328
#define XB_TOPGEN   3392
#define XCD_BAR_WORDS 3456
#define XB_SPIN_CAP (1u << 18)

__device__ __forceinline__ unsigned xb_ld(unsigned* p)              { return __hip_atomic_load(p, __ATOMIC_RELAXED, __HIP_MEMORY_SCOPE_AGENT); }
__device__ __forceinline__ unsigned xb_add(unsigned* p, unsigned v) { return __hip_atomic_fetch_add(p, v, __ATOMIC_RELAXED, __HIP_MEMORY_SCOPE_AGENT); }
__device__ __forceinline__ unsigned xb_xcc_id() { return (unsigned)__builtin_amdgcn_s_getreg((3 << 11) | 20) & 0xFu; }
#define XB_SPIN(cond, bar) do { unsigned _sp = 0; while (cond) { __builtin_amdgcn_s_sleep(1); \
    if ((++_sp & 255u) == 0u) { if (xb_ld(&(bar)[XB_TMO])) break; if (_sp > XB_SPIN_CAP) { atomicAdd(&(bar)[XB_TMO], 1u); break; } } } } while (0)

struct XcdBarrier {
    unsigned* bar; unsigned x;
    volatile LAS unsigned* st;
};

__device__ __forceinline__ XcdBarrier xcd_barrier_post(unsigned* bar, volatile LAS unsigned* st) {
    XcdBarrier b; b.bar = bar; b.x = xb_xcc_id(); b.st = st;
    if (threadIdx.x == 0) (void)xb_add(&bar[XB_XCNT(b.x)], 1u);
    return b;
}
__device__ __forceinline__ void xcd_barrier_complete(unsigned* bar, unsigned x, unsigned& nloc, unsigned& nx) {
    const unsigned G = gridDim.x * gridDim.y * gridDim.z;
    unsigned sum, cnt, mine, sp = 0u;
    for (;;) {
        sum = 0u; cnt = 0u; mine = 0u;
#pragma unroll
        for (unsigned j = 0; j < 16; ++j) { const unsigned c = xb_ld(&bar[XB_XCNT(j)]); sum += c; cnt += (c > 0u) ? 1u : 0u; mine = (j == x) ? c : mine; }
        if (sum == G) break;
        __builtin_amdgcn_s_sleep(1);
        if ((++sp & 255u) == 0u) { if (xb_ld(&bar[XB_TMO])) break; if (sp > XB_SPIN_CAP) { atomicAdd(&bar[XB_TMO], 1u); break; } }
    }
    nloc = mine > 0u ? mine : 1u; nx = cnt > 0u ? cnt : 1u;
}

__device__ __forceinline__ void xcd_barrier(const XcdBarrier& b) {
    asm volatile("s_waitcnt vmcnt(0)" ::: "memory");
    __syncthreads();
    if (threadIdx.x == 0) {
        unsigned* bar = b.bar;
        __builtin_amdgcn_s_waitcnt(0);
        unsigned nloc = b.st[0], nx = b.st[1];
        if (nloc == 0u) { xcd_barrier_complete(bar, b.x, nloc, nx); b.st[0] = nloc; b.st[1] = nx; }
        const unsigned old = xb_add(&bar[XB_XSUB(b.x)], 1u);
        const unsigned gen = old / nloc;
        if (old + 1u == (gen + 1u) * nloc) {
            __builtin_amdgcn_fence(__ATOMIC_RELEASE, "agent");
            asm volatile("s_waitcnt vmcnt(0)" ::: "memory");
            const unsigned og = xb_add(&bar[XB_TOP], 1u);
            const unsigned tg = og / nx;
            if (og + 1u == (tg + 1u) * nx) xb_add(&bar[XB_TOPGEN], 1u);
            else XB_SPIN(xb_ld(&bar[XB_TOPGEN]) == tg, bar);
            __builtin_amdgcn_fence(__ATOMIC_ACQUIRE, "agent");
            xb_add(&bar[XB_XGEN(b.x)], 1u);
            asm volatile("s_waitcnt vmcnt(0)" ::: "memory");
        } else {
            XB_SPIN(xb_ld(&bar[XB_XGEN(b.x)]) == gen, bar);
            __builtin_amdgcn_fence(__ATOMIC_ACQUIRE, "agent");
            asm volatile("s_waitcnt vmcnt(0)" ::: "memory");
        }
    }
    __syncthreads();
}
struct Args { const float* in[N_IN]; float* out; unsigned char* ws; int lo, hi; };
static_assert(sizeof(Args) == (N_IN + 2) * 8 + 8, "Args has no holes");
struct Frame {
    LAS unsigned char* lds;
    volatile LAS unsigned* MISC;
    gu32* ctl;
    int tid, lane, wave, G, bid;
    unsigned char* ws;
    const __attribute__((address_space(4))) char* kp;
    float* out;
};
#define WSP(T, off) ((T*)(F.ws + (off)))
typedef const GAS float* gcfptr_t;
#define KIN(i) ((const float*)(*(const __attribute__((address_space(4))) gcfptr_t*)(F.kp + 8 * (i))))

template <class LhsFn> __device__ __forceinline__ void skinny17_task(Frame& F, LhsFn lhs, const float* W, int N, int n0, float* out, int ldo, const float* bias) {
    LAS float* sh = (LAS float*)(F.lds + RING_OFF);
    const int lane = F.lane, bi = lane & 31, hk = lane >> 5, col = n0 + 32 * F.wave + bi, cc = min(col, N - 1);
    f32x16 acc;
#pragma unroll
    for (int e = 0; e < 16; ++e) acc[e] = 0.f;
    for (int kh = 0; kh < 2; ++kh) {
        __syncthreads();
        for (int idx = F.tid; idx < 17 * 1024; idx += NTHR) { const int b = idx >> 10, kk = idx & 1023; sh[b * 1025 + kk] = lhs(b, kh * 1024 + kk); }
        __syncthreads();
        const float* wp = W + (size_t)(kh * 1024 + hk) * N + cc; const LAS float* ap = sh + (bi < 17 ? bi : 0) * 1025 + hk;
#pragma unroll 8
        for (int ks = 0; ks < 512; ++ks) { const float bv = wp[(size_t)(2 * ks) * N]; float av = ap[2 * ks]; av = bi < 17 ? av : 0.f;
            acc = __builtin_amdgcn_mfma_f32_32x32x2f32(av, bv, acc, 0, 0, 0); }
    }
    if (col < N) { const float bz = bias ? bias[col] : 0.f;
#pragma unroll
        for (int r = 0; r < 16; ++r) { const int b = (r & 3) + 8 * (r >> 2) + 4 * hk; if (b < 17) out[(size_t)b * ldo + col] = acc[r] + bz; } }
}
__device__ __forceinline__ void p0a_prologue(Frame& F, const float* c, const float* cctx, const float* adaw, const float* adab,
                                             const float* lre, const float* lim, const float* ldt, const float* bre, const float* bim, const float* cre, const float* cim) {
    for (int t = F.bid; t < DEPTH * 48; t += F.G) { const int l = t / 48, n0 = (t % 48) * 256;
        skinny17_task(F, [&](int b, int k) { const float v = b < NB ? c[b * DM + k] : cctx[k]; return v / (1.f + __expf(-v)); },
                      adaw + (size_t)l * DM * NMOD, NMOD, n0, WSP(float, WS_MODS) + (size_t)l * 17 * NMOD, NMOD, adab + (size_t)l * NMOD); }
    __syncthreads();
    { float* RT_ = WSP(float, WS_ROPE);
      for (int i = F.bid * NTHR + F.tid; i < 1024; i += F.G * NTHR) { const int pos = i >> 4, fi = i & 15; const float inv = exp2f(-(float)fi * (13.287712379549449f / 16.f));
          float sn, cs; sincosf((float)pos * inv, &sn, &cs); RT_[2 * i] = cs; RT_[2 * i + 1] = sn; } }
    {
        float* S5A = WSP(float, WS_S5A); bf16* BB = WSP(bf16, WS_S5BB); bf16* CM = WSP(bf16, WS_S5CM);
        for (int i = F.bid * NTHR + F.tid; i < DEPTH * 2 * 32 * 64; i += F.G * NTHR) {
            const int p = i & 63, ldg = i >> 6;
            const float lr = fminf(lre[i], -1e-4f), li = lim[i], dt = __expf(ldt[ldg]);
            const float mag = expf(lr * dt), ar = mag * cosf(li * dt), ai = mag * sinf(li * dt);
            const float den = lr * lr + li * li, fr = ((ar - 1.f) * lr + ai * li) / den, fi = (ai * lr - (ar - 1.f) * li) / den;
            S5A[(size_t)i * 2] = ar; S5A[(size_t)i * 2 + 1] = ai;
            const int kre = (p & 31) + 64 * (p >> 5), kim = kre + 32;
            const int hre = 2 * (p & 31) + 64 * (p >> 5), him = hre + 1;
#pragma unroll
            for (int cc = 0; cc < 16; ++cc) { const float br = bre[(size_t)i * 16 + cc], bi = bim[(size_t)i * 16 + cc];
                BB[((size_t)ldg * 128 + kre) * 16 + cc] = (bf16)f2bf(fr * br - fi * bi); BB[((size_t)ldg * 128 + kim) * 16 + cc] = (bf16)f2bf(fr * bi + fi * br);
                CM[((size_t)ldg * 16 + cc) * 128 + hre] = (bf16)f2bf(cre[((size_t)ldg * 16 + cc) * 64 + p]); CM[((size_t)ldg * 16 + cc) * 128 + him] = (bf16)f2bf(-cim[((size_t)ldg * 16 + cc) * 64 + p]); }
        }
    }
}
__device__ __forceinline__ void p0c_shw(Frame& F, const float* win_all, const float* w1_all) {
    const float* MODS = WSP(float, WS_MODS); float* SHW = WSP(float, WS_SHW);
    for (int t = F.bid; t < DEPTH * 49; t += F.G) { const int l = t / 49, g = t % 49; const bool is1 = g >= 17; const int ish = is1 ? 3 : 0;
        const float* mp = MODS + (size_t)l * 17 * NMOD + ish * DM;
        skinny17_task(F, [&](int b, int k) { return mp[(size_t)b * NMOD + k]; },
                      is1 ? w1_all + (size_t)l * DM * DFF : win_all + (size_t)l * DM * NZ, is1 ? DFF : NZ, (is1 ? g - 17 : g) * 256,
                      SHW + (size_t)l * 17 * (LDZ + DFF) + (is1 ? LDZ : 0), LDZ + DFF, nullptr); }
    __syncthreads();
}
__device__ __forceinline__ void norm0_phase(Frame& F, const float* x, const float* ctx, const float* w, const float* mods  ) {
    bf16* H = WSP(bf16, WS_H); float* RSTD = WSP(float, WS_RSTD);
    const int gw = F.bid * NWAVES + F.wave, NGW = F.G * NWAVES, lane = F.lane;
    for (int r = gw; r < RT; r += NGW) {
        const float* xrow = r < RL ? x + (size_t)r * DM : ctx + (size_t)(r - RL) * DM; const float* sc = mods + (size_t)mod_row(r) * NMOD + 1 * DM;
        const f32x4* xr = (const f32x4*)xrow + lane; f32x4 v[8]; float s = 0.f;
#pragma unroll
        for (int j = 0; j < 8; ++j) { v[j] = xr[64 * j]; s += (v[j].x * v[j].x + v[j].y * v[j].y) + (v[j].z * v[j].z + v[j].w * v[j].w); }
        s = wave_sum(s, lane);
        if (lane == 0) RSTD[r] = rsqrtf(s * (1.f / DM) + EPS);
        v2u* o8 = (v2u*)(H + blk_off(r, 0, 8)) + lane; constexpr int JS = BLK_LAYOUT ? 16384 : 64;
#pragma unroll
        for (int j = 0; j < 8; ++j) { const int cix = 64 * j + lane; const f32x4 y = v[j] * ((const f32x4*)w)[cix] * (((const f32x4*)sc)[cix] + 1.f); v2u o; o.x = pk2(y.x, y.y); o.y = pk2(y.z, y.w); o8[JS * j] = o; }
    }
}
__device__ __forceinline__ void ctxfix_phase(Frame& F, const float* gate  , const float* w, const float* sc  ) {
    bf16* X = WSP(bf16, WS_X); const float* P = WSP(float, WS_LOGA); bf16* H = WSP(bf16, WS_H); float* RSTD = WSP(float, WS_RSTD);
    const int gw = F.bid * NWAVES + F.wave, NGW = F.G * NWAVES, lane = F.lane;
    for (int rc = gw; rc < RC; rc += NGW) { const int r = RL + rc;
        v2u* xr = (v2u*)(X + blk_off(r, 0, 8)) + lane; constexpr int JS = BLK_LAYOUT ? 16384 : 64; const f32x4* p0 = (const f32x4*)(P + (size_t)rc * DM) + lane; const f32x4* p1 = (const f32x4*)(P + (size_t)(RC + rc) * DM) + lane;
        f32x4 v[8]; float s = 0.f;
#pragma unroll
        for (int j = 0; j < 8; ++j) { const int cix = 64 * j + lane; const v2u xw = xr[JS * j]; const f32x4 xi = (f32x4){bflo(xw.x), bfhi(xw.x), bflo(xw.y), bfhi(xw.y)};
            v[j] = xi + ((const f32x4*)gate)[cix] * (p0[64 * j] + p1[64 * j]); s += (v[j].x * v[j].x + v[j].y * v[j].y) + (v[j].z * v[j].z + v[j].w * v[j].w); }
        s = wave_sum(s, lane);
        if (lane == 0) RSTD[r] = rsqrtf(s * (1.f / DM) + EPS);
        v2u* o8 = (v2u*)(H + blk_off(r, 0, 8)) + lane;
#pragma unroll
        for (int j = 0; j < 8; ++j) { const int cix = 64 * j + lane; v2u xo; xo.x = pk2(v[j].x, v[j].y); xo.y = pk2(v[j].z, v[j].w); xr[JS * j] = xo;
            const f32x4 y = v[j] * ((const f32x4*)w)[cix] * (((const f32x4*)sc)[cix] + 1.f); v2u o; o.x = pk2(y.x, y.y); o.y = pk2(y.z, y.w); o8[JS * j] = o; }
    }
}
__device__ __forceinline__ void rstd_phase(Frame& F, int nrows) {
    const float* SSP = WSP(float, WS_SSP); float* RSTD = WSP(float, WS_RSTD);
    for (int r = F.bid * NTHR + F.tid; r < nrows; r += F.G * NTHR) { const f32x4* sp = (const f32x4*)(SSP + (size_t)r * 32); float s = 0.f;
#pragma unroll
        for (int j = 0; j < 8; ++j) { const f32x4 v = sp[j]; s += (v.x + v.y) + (v.z + v.w); }
        RSTD[r] = rsqrtf(s * (1.f / DM) + EPS); }
}
__device__ __forceinline__ void transpose_item(const float* W, int K, int N, bf16* WT, int ldt, LAS float* scr, int item, int lane) {
    const int nblk = (N + 31) / 32, kb = item / nblk, nb = item % nblk, k0 = 64 * kb, n0 = 32 * nb;
    const int nr = min(n0 + (lane & 31), N - 1);
#pragma unroll 8
    for (int i = 0; i < 32; ++i) { const int kk = 2 * i + (lane >> 5); scr[kk * 33 + (lane & 31)] = W[(size_t)(k0 + kk) * N + nr]; }
    LDS_WAIT(); asm volatile("" ::: "memory");
    const int cch = lane & 7;
#pragma unroll
    for (int j = 0; j < 4; ++j) { const int n = (lane >> 3) + 8 * j; const LAS float* s = scr + (8 * cch) * 33 + n;
        v4u o; o.x = pk2(s[0 * 33], s[1 * 33]); o.y = pk2(s[2 * 33], s[3 * 33]); o.z = pk2(s[4 * 33], s[5 * 33]); o.w = pk2(s[6 * 33], s[7 * 33]);
        if (n0 + n < N) *(v4u*)(WT + (size_t)(n0 + n) * ldt + k0 + 8 * cch) = o; }
    LDS_WAIT(); asm volatile("" ::: "memory");
}
__device__ __forceinline__ void norm_row(const float* xrow, bf16* orow, const float* w, const float* shift, const float* scale, int lane) {
    const f32x4* xr = (const f32x4*)xrow + lane;
    f32x4 v[8]; float s = 0.f;
#pragma unroll
    for (int j = 0; j < 8; ++j) { v[j] = xr[64 * j]; s += (v[j].x * v[j].x + v[j].y * v[j].y) + (v[j].z * v[j].z + v[j].w * v[j].w); }
    const float rstd = rsqrtf(wave_sum(s, lane) * (1.f / DM) + EPS);
    v2u* o8 = (v2u*)orow + lane;
#pragma unroll
    for (int j = 0; j < 8; ++j) { const int cix = 64 * j + lane; const f32x4 wv = ((const f32x4*)w)[cix], sh = ((const f32x4*)shift)[cix], sc = ((const f32x4*)scale)[cix];
        const f32x4 y = v[j] * rstd * wv * (sc + 1.f) + sh; v2u o; o.x = pk2(y.x, y.y); o.y = pk2(y.z, y.w); o8[64 * j] = o; }
}
__device__ __forceinline__ void norm_phase(Frame& F, const float* X, bf16* H, const float* w, const float* mods  , int ishift, int iscale, int nrows) {
    const int gw = F.bid * NWAVES + F.wave, NGW = F.G * NWAVES;
    for (int r = gw; r < nrows; r += NGW) { const float* mp = mods + (size_t)mod_row(r) * NMOD;
        norm_row(X + (size_t)r * DM, H + (size_t)r * DM, w, mp + ishift * DM, mp + iscale * DM, F.lane); }
}
constexpr int CV_1 = 32 * 256, CV_2 = 128 * 64, CV_OUT = 32 * 64, CV_G = 8 * 16, CV_OWN = CV_1 + CV_2 + CV_OUT + CV_G, CV_IN = 32 * 131, CV_Q = 6 * 24, CV_KV = 2 * 32, CV_NEXT = CV_IN + CV_Q + CV_KV;
__device__ __forceinline__ void convert_item(Frame& F, const Args& A, int lo, int ln, int it, LAS float* scr) {
    int r = it;
    if (r < CV_OWN) { if (lo < 0) return;
        if (r < CV_1) { transpose_item(KIN(I_W1) + (size_t)lo * DM * DFF, DM, DFF, WSP(bf16, WS_W1), DM, scr, r, F.lane); return; } r -= CV_1;
        if (r < CV_2) { transpose_item(KIN(I_W2) + (size_t)lo * DFF * DM, DFF, DM, WSP(bf16, WS_W2), DFF, scr, r, F.lane); return; } r -= CV_2;
        if (r < CV_OUT) { transpose_item(KIN(I_WOUT) + (size_t)lo * DM * DM, DM, DM, WSP(bf16, WS_WOUT), DM, scr, r, F.lane); return; } r -= CV_OUT;
        transpose_item(KIN(I_S5GLUW) + (size_t)lo * 512 * 512, 512, 512, WSP(bf16, WS_WGLU), 512, scr, r, F.lane); return; }
    r -= CV_OWN; if (ln >= DEPTH) return;
    if (r < CV_IN) { transpose_item(KIN(I_WIN) + (size_t)ln * DM * NZ, DM, NZ, WSP(bf16, WS_WIN), DM, scr, r, F.lane); return; } r -= CV_IN;
    if (r < CV_Q) { transpose_item(KIN(I_WQUP) + (size_t)ln * 384 * 768, 384, 768, WSP(bf16, WS_WQUP), 384, scr, r, F.lane); return; } r -= CV_Q;
    transpose_item(KIN(I_WKVUP) + (size_t)ln * 128 * 1024, 128, 1024, WSP(bf16, WS_WKVUP), 256, scr, r, F.lane);
}
__device__ __forceinline__ void convert_misc(Frame& F, const Args& A, int ln, int t0, int nt) {
    if (ln >= DEPTH) return;
    { v4u* p = WSP(v4u, WS_WKVUP); const v4u z4 = zero_v4u(); for (int i = t0; i < 1024 * 16; i += nt) { const int n = i >> 4, c8 = i & 15; p[(size_t)n * 32 + 16 + c8] = z4; } }
    { float* cst = WSP(float, WS_LRUC); const float* ba = KIN(I_LBA) + (size_t)ln * 1024; const float* bx = KIN(I_LBX) + (size_t)ln * 1024; const float* lam = KIN(I_LLAM) + (size_t)ln * 1024;
      for (int i = t0; i < 1024; i += nt) { cst[i] = ba[i]; cst[1024 + i] = bx[i]; cst[2048 + i] = softplusf_(-lam[i]); } }
    { const float* wa = KIN(I_LWA) + (size_t)ln * 2 * 4 * 128 * 128; const float* wx = KIN(I_LWX) + (size_t)ln * 2 * 4 * 128 * 128; v4u* p = WSP(v4u, WS_WLRU);
      for (int i = t0; i < 2048 * 64; i += nt) { const int cidx = i >> 6, k8 = (i & 63) * 8; const int pn = cidx >> 8, type = (cidx >> 7) & 1, j = cidx & 127, d = pn >> 2, nb = pn & 3;
          v4u o = zero_v4u();
          if ((k8 >> 7) == nb) { const float* src = (type ? wx : wa) + ((size_t)(d * 4 + nb) * 128 + (k8 & 127)) * 128 + j;
              o.x = pk2(src[0 * 128], src[1 * 128]); o.y = pk2(src[2 * 128], src[3 * 128]); o.z = pk2(src[4 * 128], src[5 * 128]); o.w = pk2(src[6 * 128], src[7 * 128]); }
          p[i] = o; } }
}
__device__ __forceinline__ void convert_weights(Frame& F, const Args& A, int lo, int ln) {
    LAS float* scr = (LAS float*)(F.lds + RING_OFF + F.wave * 16384);
    for (int it = F.bid * NWAVES + F.wave; it < CV_OWN + CV_NEXT; it += F.G * NWAVES) convert_item(F, A, lo, ln, it, scr);
    convert_misc(F, A, ln, F.bid * NTHR + F.tid, F.G * NTHR);
}
constexpr int CV_UNITS = (CV_OWN + CV_NEXT + 63) / 64 + 1;
__device__ __forceinline__ void convert_unit(Frame& F, const Args& A, int lo, int ln, int cu) {
    if (cu == CV_UNITS - 1) { convert_misc(F, A, ln, F.tid, NTHR); return; }
    LAS float* scr = (LAS float*)(F.lds + RING_OFF + F.wave * 16384);
    for (int j = 0; j < 8; ++j) { const int it = cu * 64 + j * 8 + F.wave; if (it < CV_OWN + CV_NEXT) convert_item(F, A, lo, ln, it, scr); }
}
__device__ __forceinline__ void prep_phase(Frame& F, const Args& A, int l) {
    const bf16* Z = WSP(bf16, WS_Z); bf16* XS = WSP(bf16, WS_XS); bf16* AQ = WSP(bf16, WS_AQ); bf16* AKV = WSP(bf16, WS_AKV);
    const float* cw = KIN(I_LCW) + (size_t)l * 4 * 512; const float* cb = KIN(I_LCB) + (size_t)l * 512;
    const float* qan = KIN(I_QAN) + (size_t)l * 384; const float* kvan = KIN(I_KVAN) + (size_t)l * 128;
    for (size_t i = (size_t)F.bid * NTHR + F.tid; i < (size_t)RT * 64; i += (size_t)F.G * NTHR) {
        const int r = (int)(i >> 6), c8 = (int)(i & 63) * 8;
        int t, len; if (r < RL) { t = r & (SEQ - 1); len = SEQ; } else { t = (r - RL) & (CTXL - 1); len = CTXL; }
        float acc[8];
#pragma unroll
        for (int j = 0; j < 8; ++j) acc[j] = cb[c8 + j];
#pragma unroll
        for (int tap = 0; tap < 4; ++tap) { const int tt = t + tap - 2;
            if (tt >= 0 && tt < len) { const v4u w = *(const v4u*)(Z + (size_t)(r + tap - 2) * LDZ + ZLX + c8); float f[8]; unpack8(w, f);
#pragma unroll
                for (int j = 0; j < 8; ++j) acc[j] += f[j] * cw[tap * 512 + c8 + j]; } }
        *(v4u*)(XS + (size_t)r * 512 + c8) = pack8(acc);
    }
    const int gw = F.bid * NWAVES + F.wave, NGW = F.G * NWAVES;
    for (int r = gw; r < RT; r += NGW) {
        const bool isq = F.lane < 48; const int e0 = isq ? F.lane * 8 : (F.lane - 48) * 8;
        const v4u w = *(const v4u*)(Z + (size_t)r * LDZ + (isq ? ZCQ : ZCKV) + e0); float f[8]; unpack8(w, f);
        float ss = 0.f;
#pragma unroll
        for (int j = 0; j < 8; ++j) ss += f[j] * f[j];
        const float sq = wave_sum(isq ? ss : 0.f, F.lane), skv = wave_sum(isq ? 0.f : ss, F.lane);
        const float rstd = isq ? rsqrtf(sq * (1.f / 384.f) + EPS) : rsqrtf(skv * (1.f / 128.f) + EPS);
        const float* nw = isq ? qan + e0 : kvan + e0;
#pragma unroll
        for (int j = 0; j < 8; ++j) f[j] = f[j] * rstd * nw[j];
        if (isq) *(v4u*)(AQ + (size_t)r * 384 + e0) = pack8(f);
        else { *(v4u*)(AKV + (size_t)r * 256 + e0) = pack8(f); *(v4u*)(AKV + (size_t)r * 256 + 128 + e0) = zero_v4u(); }
    }
}
constexpr float ATTN_SCALE_LOG2E = 0.07216878364870322f * 1.4426950408889634f;
__device__ __forceinline__ void rope8(float (&f)[8], int li, int t, int lane, const float* rope) {
    const bool second = (li & 2) != 0;
    const int pos = (li < 20) ? (t >> 6) : (t & 63);
    const f32x4* tp = (const f32x4*)(rope + (size_t)(pos * 16 + 8 * (li & 1)) * 2);
    const f32x4 t0 = tp[0], t1 = tp[1], t2 = tp[2], t3 = tp[3];
    const float cs[8] = {t0.x, t0.z, t1.x, t1.z, t2.x, t2.z, t3.x, t3.z}, sn[8] = {t0.y, t0.w, t1.y, t1.w, t2.y, t2.w, t3.y, t3.w};
    float o[8];
#pragma unroll
    for (int j = 0; j < 8; ++j) { const float other = shx(f[j], 2, lane); o[j] = second ? (f[j] * cs[j] + other * sn[j]) : (f[j] * cs[j] - other * sn[j]); }
#pragma unroll
    for (int j = 0; j < 8; ++j) f[j] = o[j];
}
__device__ __forceinline__ void mla_finish(Frame& F, const Args& A, int l, bool need_ctx, int wg0, int nwg) {
    const bf16* Z = WSP(bf16, WS_Z); const bf16* KVRAW = WSP(bf16, WS_KVRAW); bf16* K = WSP(bf16, WS_K);
    const float* kn = KIN(I_KN) + (size_t)l * 192; const float* rope = WSP(float, WS_ROPE);
    const int gw = (F.bid - wg0) * NWAVES + F.wave, NGW = nwg * NWAVES;
    const int li = F.lane & 31, hh = F.lane >> 5; const bool act = li < 24;
    float knw[8];
#pragma unroll
    for (int j = 0; j < 8; ++j) knw[j] = act ? kn[8 * li + j] : 0.f;
    for (int r = gw; r < RT; r += NGW) {
        const bool lat = r < RL; const int t = r & (SEQ - 1);
        v4u wk[2];
#pragma unroll
        for (int it = 0; it < 2; ++it) { const int h = it * 2 + hh;
            wk[it] = li < 16 ? *(const v4u*)(KVRAW + (size_t)r * 1024 + h * 256 + 8 * li) : (li < 24 ? *(const v4u*)(Z + (size_t)r * LDZ + ZKR + 8 * (li - 16)) : zero_v4u()); }
        int b, key; if (lat) { b = r >> 11; key = CTXL + t; } else { b = (r - RL) >> 8; key = (r - RL) & (CTXL - 1); }
#pragma unroll
        for (int it = 0; it < 2; ++it) { const int h = it * 2 + hh;
            float g[8]; unpack8(wk[it], g);
            float sk = 0.f;
#pragma unroll
            for (int j = 0; j < 8; ++j) sk += g[j] * g[j];
#pragma unroll
            for (int o = 1; o < 32; o <<= 1) sk += shx(sk, o, F.lane);
            const float rk = rsqrtf(sk * (1.f / 192.f) + EPS);
#pragma unroll
            for (int j = 0; j < 8; ++j) g[j] = g[j] * rk * knw[j];
            if (lat) { if (li >= 16 && li < 24) rope8(g, li, t, F.lane, rope); }
            if (act) *(v4u*)(K + ((size_t)b * TOK + key) * 768 + h * 192 + 8 * li) = pack8(g);
        }
    }
}
template <bool FINAL> __device__ __forceinline__ void lru_chunk(Frame& F, int wunit) {
    const bf16* LOGA = WSP(bf16, WS_LOGA); const bf16* GB = WSP(bf16, WS_GB); bf16* LH = WSP(bf16, WS_LH); float* SUM = WSP(float, WS_LSUM);
    const int b = wunit / 72, d = (wunit / 36) & 1, c = wunit % 36, c8 = 8 * F.lane, step = d ? -1 : 1;
    const int r0 = row_scan(b, d, 64 * c);
    float* sp = SUM + ((size_t)((b * 2 + d) * 36) * 2) * 512 + c8;
    float h[8], P[8];
#pragma unroll
    for (int j = 0; j < 8; ++j) { h[j] = 0.f; P[j] = 0.f; }
    if (FINAL) {
        for (int cc = 0; cc < c; ++cc) { const f32x4 p0 = *(const f32x4*)(sp + (size_t)cc * 1024), p1 = *(const f32x4*)(sp + (size_t)cc * 1024 + 4), e0 = *(const f32x4*)(sp + (size_t)cc * 1024 + 512), e1 = *(const f32x4*)(sp + (size_t)cc * 1024 + 516);
#pragma unroll
            for (int j = 0; j < 4; ++j) { h[j] = __expf(p0[j]) * h[j] + e0[j]; h[4 + j] = __expf(p1[j]) * h[4 + j] + e1[j]; } }
    }
    const bf16* lap = LOGA + d * 512 + c8; const bf16* gbp = GB + d * 512 + c8; bf16* lhp = LH + (size_t)d * RT * 512 + c8;
    for (int t0 = 0; t0 < 64; t0 += 8) {
        v4u la[8], gb[8];
#pragma unroll
        for (int j = 0; j < 8; ++j) { const size_t row = (size_t)(r0 + step * (t0 + j)); la[j] = *(const v4u*)(lap + row * 1024); gb[j] = *(const v4u*)(gbp + row * 1024); }
#pragma unroll
        for (int j = 0; j < 8; ++j) { float a[8], g[8]; unpack8(la[j], a); unpack8(gb[j], g);
#pragma unroll
            for (int e = 0; e < 8; ++e) { h[e] = __expf(a[e]) * h[e] + g[e]; if (!FINAL) P[e] += a[e]; }
            if (FINAL) *(v4u*)(lhp + (size_t)(r0 + step * (t0 + j)) * 512) = pack8(h); }
    }
    if (!FINAL) { float* o = sp + (size_t)c * 1024;
        *(f32x4*)(o) = (f32x4){P[0], P[1], P[2], P[3]}; *(f32x4*)(o + 4) = (f32x4){P[4], P[5], P[6], P[7]};
        *(f32x4*)(o + 512) = (f32x4){h[0], h[1], h[2], h[3]}; *(f32x4*)(o + 516) = (f32x4){h[4], h[5], h[6], h[7]}; }
}
template <bool DO_S5, bool DO_REST> __device__ __forceinline__ void finish_phase(Frame& F, const Args& A, int l, int nrows) {
    const bf16* Z = WSP(bf16, WS_Z); bf16* Y = WSP(bf16, WS_Y); bf16* A5 = WSP(bf16, WS_A5);
    const bf16* YS = WSP(bf16, WS_YS); const bf16* MH = WSP(bf16, WS_MH); const bf16* LH = WSP(bf16, WS_LH);
    const float* s5d = KIN(I_S5D) + (size_t)l * 512; const float* on = KIN(I_MLON) + (size_t)l * 512;
    const int gw = F.bid * NWAVES + F.wave, NGW = F.G * NWAVES; const int c8 = F.lane * 8;
    for (int r = gw; r < nrows; r += NGW) {
        float a[8], b[8], o[8];
        if (DO_S5) { unpack8(*(const v4u*)(YS + (size_t)r * 512 + c8), a); unpack8(*(const v4u*)(YS + ((size_t)RT + r) * 512 + c8), b); unpack8(*(const v4u*)(Z + (size_t)r * LDZ + ZU + c8), o);
#pragma unroll
          for (int j = 0; j < 8; ++j) a[j] = gelu_tanh(a[j] + b[j] + s5d[c8 + j] * o[j]);
          *(v4u*)(A5 + (size_t)r * 512 + c8) = pack8(a); }
        if (DO_REST) { unpack8(*(const v4u*)(LH + (size_t)r * 512 + c8), a); unpack8(*(const v4u*)(LH + ((size_t)RT + r) * 512 + c8), b); unpack8(*(const v4u*)(Z + (size_t)r * LDZ + ZLG + c8), o);
#pragma unroll
          for (int j = 0; j < 8; ++j) a[j] = (a[j] + b[j]) * gelu_tanh(o[j]);
          *(v4u*)(Y + (size_t)r * DM + 1536 + c8) = pack8(a); }
        if (DO_REST) { unpack8(*(const v4u*)(MH + (size_t)r * 512 + c8), a); unpack8(*(const v4u*)(MH + ((size_t)RT + r) * 512 + c8), b); unpack8(*(const v4u*)(Z + (size_t)r * LDZ + ZMO + c8), o);
          float ss = 0.f;
#pragma unroll
          for (int j = 0; j < 8; ++j) { a[j] += b[j]; ss += a[j] * a[j]; }
#pragma unroll
          for (int s = 1; s < 16; s <<= 1) ss += shx(ss, s, F.lane);
          const float rstd = rsqrtf(ss * (1.f / 128.f) + EPS);
#pragma unroll
          for (int j = 0; j < 8; ++j) a[j] = a[j] * rstd * on[c8 + j] * sigmoidf_(o[j]);
          *(v4u*)(Y + (size_t)r * DM + 512 + c8) = pack8(a); }
    }
}
#define MFMA16(a, b, c) __builtin_amdgcn_mfma_f32_16x16x32_bf16((a), (b), (c), 0, 0, 0)
#define MFMA32(a, b, c) __builtin_amdgcn_mfma_f32_32x32x16_bf16((a), (b), (c), 0, 0, 0)
__device__ __forceinline__ bf16x8 ldsfrag(const LAS bf16* p) { return *(const LAS bf16x8*)p; }

__device__ __forceinline__ void s5_scan(Frame& F, int l, int unit, int d) {
    const bf16* Z = WSP(bf16, WS_Z); bf16* YS = WSP(bf16, WS_YS);
    const float* S5A = WSP(float, WS_S5A); const bf16* BB = WSP(bf16, WS_S5BB); const bf16* CM = WSP(bf16, WS_S5CM);
    LAS bf16* Hs = (LAS bf16*)(F.lds + RING_OFF + F.wave * 8704);
    const int lane = F.lane, j = lane & 31, hl = lane >> 5, i16 = lane & 15, q4 = lane >> 4;
    const int hb = (j >> 2) & 1, tt = (j & 3) + 4 * (j >> 3);
    bf16* A5 = WSP(bf16, WS_A5); const float* s5d = KIN(I_S5D) + (size_t)l * 512;
    {
        const int bp = unit & 7, g = unit >> 3, b0 = 2 * bp, ldg = (l * 2 + d) * 32 + g;
        bf16x8 Bf[4], Cf[4];
#pragma unroll
        for (int t = 0; t < 4; ++t) { Bf[t] = *(const bf16x8*)(BB + ((size_t)ldg * 128 + t * 32 + j) * 16 + 8 * hl); Cf[t] = *(const bf16x8*)(CM + ((size_t)ldg * 16 + i16) * 128 + 32 * t + 8 * q4); }
        const float ar0 = S5A[((size_t)ldg * 64 + j) * 2], ai0 = S5A[((size_t)ldg * 64 + j) * 2 + 1], ar1 = S5A[((size_t)ldg * 64 + j + 32) * 2], ai1 = S5A[((size_t)ldg * 64 + j + 32) * 2 + 1];
        float hr0 = 0.f, hi0 = 0.f, hr1 = 0.f, hi1 = 0.f;
        const bf16* zu = Z + ZU + g * 16 + 8 * hl;
        bf16x8 a0 = *(const bf16x8*)(zu + (size_t)row_scan(b0 + hb, d, tt) * LDZ);
        bf16x8 a1 = *(const bf16x8*)(zu + (size_t)row_scan(b0 + hb, d, 16 + tt) * LDZ);
        for (int blk = 0; blk < TOK / 16; ++blk) {
            const int p0 = blk * 16, pn = min(blk + 2, TOK / 16 - 1) * 16;
            if (blk == CTXL / 32 || blk == CTXL / 16 + SEQ / 32) { asm volatile("s_waitcnt vmcnt(0)" ::: "memory"); __syncthreads(); }
            const bool fin = (blk >= CTXL / 32 && blk < CTXL / 16) || blk >= CTXL / 16 + SEQ / 32;
            const bf16x8 a2 = *(const bf16x8*)(zu + (size_t)row_scan(b0 + hb, d, pn + tt) * LDZ);
            f32x16 acc[4];
#pragma unroll
            for (int t = 0; t < 4; ++t) { f32x16 z;
#pragma unroll
                for (int e = 0; e < 16; ++e) z[e] = 0.f;
                acc[t] = MFMA32(a0, Bf[t], z); }
            LAS unsigned* hrow = (LAS unsigned*)(Hs + hl * (16 * 136)) + j;
#pragma unroll
            for (int r = 0; r < 16; ++r) {
                const float nr0 = ar0 * hr0 - ai0 * hi0 + acc[0][r], ni0 = ar0 * hi0 + ai0 * hr0 + acc[1][r];
                const float nr1 = ar1 * hr1 - ai1 * hi1 + acc[2][r], ni1 = ar1 * hi1 + ai1 * hr1 + acc[3][r];
                hr0 = nr0; hi0 = ni0; hr1 = nr1; hi1 = ni1;
                hrow[r * 68] = pk2(nr0, ni0); hrow[r * 68 + 32] = pk2(nr1, ni1);
            }
            asm volatile("s_waitcnt lgkmcnt(0)" ::: "memory");
#pragma unroll
            for (int h2 = 0; h2 < 2; ++h2) {
                f32x4 y = (f32x4){0.f, 0.f, 0.f, 0.f};
#pragma unroll
                for (int ks = 0; ks < 4; ++ks) y = MFMA16(Cf[ks], ldsfrag(Hs + h2 * (16 * 136) + i16 * 136 + 32 * ks + 8 * q4), y);
                { const int rr = row_scan(b0 + h2, d, p0 + i16);
                  if (!fin) { v2u o; o.x = pk2(y[0], y[1]); o.y = pk2(y[2], y[3]); *(v2u*)(YS + ((size_t)d * RT + rr) * 512 + g * 16 + 4 * q4) = o; }
                  else { const v2u yf = *(const v2u*)(YS + ((size_t)(1 - d) * RT + rr) * 512 + g * 16 + 4 * q4), uw = *(const v2u*)(Z + (size_t)rr * LDZ + ZU + g * 16 + 4 * q4); const f32x4 dv = *(const f32x4*)(s5d + g * 16 + 4 * q4);
                      const float a0 = gelu_tanh(y[0] + bflo(yf.x) + dv[0] * bflo(uw.x)), a1 = gelu_tanh(y[1] + bfhi(yf.x) + dv[1] * bfhi(uw.x));
                      const float a2 = gelu_tanh(y[2] + bflo(yf.y) + dv[2] * bflo(uw.y)), a3 = gelu_tanh(y[3] + bfhi(yf.y) + dv[3] * bfhi(uw.y));
                      v2u o; o.x = pk2(a0, a1); o.y = pk2(a2, a3); *(v2u*)(A5 + (size_t)rr * 512 + g * 16 + 4 * q4) = o; } }
            }
            asm volatile("s_waitcnt lgkmcnt(0)" ::: "memory");
            a0 = a1; a1 = a2;
        }
    }
}

constexpr int ML_QS = 0, ML_KS = 17408, ML_VS = 34816, ML_KW = 53248, ML_CT = 71680, ML_SP = 108544, ML_FL = 118784;
constexpr int ML_P = 144, ML_SPP = 80;
typedef short v4i16_t __attribute__((ext_vector_type(4)));
__device__ __forceinline__ v2u tr16(const LAS bf16* p) { return __builtin_bit_cast(v2u, __builtin_amdgcn_ds_read_tr16_b64_v4i16((LAS v4i16_t*)p)); }
__device__ __forceinline__ bf16x8 trfrag(const LAS bf16* base, int pitch, int k0, int n0) {
    const v2u lo = tr16(base + k0 * pitch + n0), hi = tr16(base + (k0 + 4) * pitch + n0);
    const v4u w = (v4u){lo.x, lo.y, hi.x, hi.y}; return __builtin_bit_cast(bf16x8, w);
}
__device__ __forceinline__ void mlstm_chain(Frame& F, const Args& A, int l, int unit) {
    const bf16* Z = WSP(bf16, WS_Z); bf16* MH = WSP(bf16, WS_MH);
    const int b = unit >> 3, head = (unit >> 1) & 3, dir = unit & 1;
    LAS bf16* Qs = (LAS bf16*)(F.lds + ML_QS); LAS bf16* Ks = (LAS bf16*)(F.lds + ML_KS); LAS bf16* Vs = (LAS bf16*)(F.lds + ML_VS);
    LAS bf16* Kw = (LAS bf16*)(F.lds + ML_KW); LAS bf16* Ct = (LAS bf16*)(F.lds + ML_CT); LAS bf16* Sp = (LAS bf16*)(F.lds + ML_SP);
    LAS float* bcum = (LAS float*)(F.lds + ML_FL); LAS float* lis = bcum + 64; LAS float* den = bcum + 128; LAS float* nq = bcum + 192; LAS float* nvec = bcum + 256; LAS float* nadd = bcum + 384;
    int lane_l = F.lane; asm volatile("" : "+v"(lane_l));
    const int lane = lane_l, w = F.wave, tid = w * 64 + lane, i16 = lane & 15, q4 = lane >> 4;
    const float igb = KIN(I_MLIG)[(l * 2 + dir) * 4 + head], fgb = KIN(I_MLFG)[(l * 2 + dir) * 4 + head];
    const float kscale = 0.08838834764831845f;
    f32x4 C[8];
#pragma unroll
    for (int e = 0; e < 8; ++e) C[e] = (f32x4){0.f, 0.f, 0.f, 0.f};
    __syncthreads();
    if (tid < 128) { nvec[tid] = 0.f; nadd[tid] = 0.f; }
    float gb[5], gl[5];
#pragma unroll
    for (int j = 0; j < 5; ++j) { const int cc = 8 * j + w; gb[j] = 0.f; gl[j] = 0.f;
        if (cc < TOK / 64) { const bf16* zr = Z + (size_t)row_scan(b, dir, 64 * cc + lane) * LDZ + ZMG + dir * 8 + head; gl[j] = bf2f(zr[0]) + igb; gb[j] = logsigmoidf_(bf2f(zr[4]) + fgb); } }
#pragma unroll
    for (int o = 1; o < 64; o <<= 1) {
#pragma unroll
        for (int j = 0; j < 5; ++j) { const float t = shup(gb[j], o, lane); if (lane >= o) gb[j] += t; } }
    const int trq = (8 * q4 + (i16 >> 2)), trc = 4 * (i16 & 3);
    const LAS bf16* vs_tr = Vs + trq * ML_P + trc; const LAS bf16* kw_tr = Kw + trq * ML_P + trc; const LAS bf16* ct_tr = Ct + trq * ML_P + trc; const LAS bf16* sp_tr = Sp + trq * ML_SPP + trc;
    v4u qreg[2], kreg[2], vreg[2];
    auto load_chunk = [&](int c) {
#pragma unroll
        for (int i = 0; i < 2; ++i) { const int idx = tid + 512 * i, s = idx >> 4, c8 = (idx & 15) * 8; const bf16* zr = Z + (size_t)row_scan(b, dir, 64 * c + s) * LDZ + head * 128 + c8;
            qreg[i] = *(const v4u*)(zr + ZMQ); kreg[i] = *(const v4u*)(zr + ZMK); vreg[i] = *(const v4u*)(zr + ZMV); }
    };
    load_chunk(0);
    float eBprev = 1.f;
    for (int c = 0; c < TOK / 64; ++c) {
        __syncthreads();
        if (w == (c & 7)) { float bv = gb[0], lv = gl[0];
#pragma unroll
            for (int j = 1; j < 5; ++j) if ((c >> 3) == j) { bv = gb[j]; lv = gl[j]; }
            bcum[lane] = bv; lis[lane] = lv; }
        if (tid < 128) { nvec[tid] = eBprev * nvec[tid] + nadd[tid]; nadd[tid] = 0.f; }
#pragma unroll
        for (int i = 0; i < 2; ++i) { const int idx = tid + 512 * i, s = idx >> 4, c8 = (idx & 15) * 8;
            *(LAS v4u*)(Qs + s * 136 + c8) = qreg[i];
            *(LAS v4u*)(Vs + s * ML_P + c8) = vreg[i]; }
#pragma unroll
        for (int et = 0; et < 8; ++et) { v2u cw; cw.x = pk2(C[et][0], C[et][1]); cw.y = pk2(C[et][2], C[et][3]); *(LAS v2u*)(Ct + (16 * et + i16) * ML_P + 16 * w + 4 * q4) = cw; }
        float kf[2][8];
#pragma unroll
        for (int i = 0; i < 2; ++i) { const int idx = tid + 512 * i, s = idx >> 4, c8 = (idx & 15) * 8;
            unpack8(kreg[i], kf[i]);
#pragma unroll
            for (int jj = 0; jj < 8; ++jj) kf[i][jj] *= kscale;
            *(LAS v4u*)(Ks + s * 136 + c8) = pack8(kf[i]); }
        if (c + 1 < TOK / 64) load_chunk(c + 1);
        __syncthreads();
        const float Btot = bcum[63];
#pragma unroll
        for (int i = 0; i < 2; ++i) { const int idx = tid + 512 * i, s = idx >> 4, c8 = (idx & 15) * 8; const float ws = __expf(Btot - bcum[s] + lis[s]);
#pragma unroll
            for (int jj = 0; jj < 8; ++jj) kf[i][jj] *= ws;
            *(LAS v4u*)(Kw + s * ML_P + c8) = pack8(kf[i]); }
#pragma unroll
        for (int ti = 0; ti < 2; ++ti) { const int idx = 2 * w + ti, tt = idx >> 2, st = idx & 3; const int srow = 16 * st + i16;
            f32x4 acc = (f32x4){0.f, 0.f, 0.f, 0.f};
            if (st <= tt) {
#pragma unroll
                for (int ks = 0; ks < 4; ++ks) acc = MFMA16(ldsfrag(Qs + (16 * tt + i16) * 136 + 32 * ks + 8 * q4), ldsfrag(Ks + srow * 136 + 32 * ks + 8 * q4), acc); }
            const float bs = bcum[srow], ls = lis[srow]; const f32x4 bt = *(const LAS f32x4*)(bcum + 16 * tt + 4 * q4); float v[4];
#pragma unroll
            for (int r = 0; r < 4; ++r) { const int t = 16 * tt + 4 * q4 + r; v[r] = (srow <= t && st <= tt) ? acc[r] * __expf(bt[r] - bs + ls) : 0.f; }
            v2u sw; sw.x = pk2(v[0], v[1]); sw.y = pk2(v[2], v[3]); *(LAS v2u*)(Sp + srow * ML_SPP + 16 * tt + 4 * q4) = sw; }
        __syncthreads();
        bf16x8 vfr[2], cfr[4], nfr[4];
        const bf16x8 onesf = __builtin_bit_cast(bf16x8, (v4u){0x3f803f80u, 0x3f803f80u, 0x3f803f80u, 0x3f803f80u});
#pragma unroll
        for (int ks = 0; ks < 2; ++ks) vfr[ks] = trfrag(vs_tr, ML_P, 32 * ks, 16 * w);
#pragma unroll
        for (int ks = 0; ks < 4; ++ks) { cfr[ks] = trfrag(ct_tr, ML_P, 32 * ks, 16 * w);
            const f32x4 n0 = *(const LAS f32x4*)(nvec + 32 * ks + 8 * q4), n1 = *(const LAS f32x4*)(nvec + 32 * ks + 8 * q4 + 4);
            const float nf[8] = {n0.x, n0.y, n0.z, n0.w, n1.x, n1.y, n1.z, n1.w}; nfr[ks] = __builtin_bit_cast(bf16x8, pack8(nf)); }
#pragma unroll 1
        for (int tt = 0; tt < 4; ++tt) {
            f32x4 a1 = (f32x4){0.f, 0.f, 0.f, 0.f}, a2 = (f32x4){0.f, 0.f, 0.f, 0.f}, ad = (f32x4){0.f, 0.f, 0.f, 0.f}, an = (f32x4){0.f, 0.f, 0.f, 0.f};
#pragma unroll
            for (int ks = 0; ks < 2; ++ks) { const bf16x8 sf = trfrag(sp_tr, ML_SPP, 32 * ks, 16 * tt); a1 = MFMA16(vfr[ks], sf, a1); ad = MFMA16(onesf, sf, ad); }
#pragma unroll
            for (int ks = 0; ks < 4; ++ks) { const bf16x8 qf = ldsfrag(Qs + (16 * tt + i16) * 136 + 32 * ks + 8 * q4); a2 = MFMA16(cfr[ks], qf, a2); an = MFMA16(nfr[ks], qf, an); }
            const int rr = row_scan(b, dir, 64 * c + 16 * tt + i16);
            { const float eb = __expf(bcum[16 * tt + i16]), dn = ad[0] + eb * an[0], inv = __builtin_amdgcn_rcpf(fmaxf(fabsf(dn), 1.f));
              v2u o; o.x = pk2((a1[0] + eb * a2[0]) * inv, (a1[1] + eb * a2[1]) * inv); o.y = pk2((a1[2] + eb * a2[2]) * inv, (a1[3] + eb * a2[3]) * inv);
              *(v2u*)(MH + ((size_t)dir * RT + rr) * 512 + head * 128 + 16 * w + 4 * q4) = o; }
        }
        const float eB = __expf(Btot);
#pragma unroll
        for (int et = 0; et < 8; ++et) { f32x4 acc = C[et] * eB;
#pragma unroll
            for (int ks = 0; ks < 2; ++ks) acc = MFMA16(vfr[ks], trfrag(kw_tr, ML_P, 32 * ks, 16 * et), acc);
            C[et] = acc; __builtin_amdgcn_sched_barrier(0); }
        { const int e = tid & 127, part = tid >> 7; float s = 0.f;
#pragma unroll
          for (int ss = 0; ss < 16; ++ss) s += bf2f(Kw[(16 * part + ss) * ML_P + e]);
          __hip_atomic_fetch_add(nadd + e, s, __ATOMIC_RELAXED, __HIP_MEMORY_SCOPE_WORKGROUP); }
        eBprev = eB;
    }
    __syncthreads();
}

constexpr int AT_K = 0, AT_V = 25600, AT_VP = 144, AT_BUF = 44032;
__device__ __forceinline__ void attn_unit(Frame& F, int b, int h, int qrow0, int nkt, const float* qn  ) {
    const bf16* Q = WSP(bf16, WS_QRAW); const bf16* K = WSP(bf16, WS_K); const bf16* KVRAW = WSP(bf16, WS_KVRAW); bf16* Y = WSP(bf16, WS_Y);
    LAS bf16* Kl = (LAS bf16*)(F.lds + AT_K); LAS bf16* Vl = (LAS bf16*)(F.lds + AT_V);
    int lane_l = F.lane; asm volatile("" : "+v"(lane_l));
    const int lane = lane_l, w = F.wave, tid = w * 64 + lane, i16 = lane & 15, q4 = lane >> 4;
    bf16x8 qf[2][6];
    const bf16* Qb = Q + (size_t)qrow0 * 768 + h * 192;
    const unsigned qoff = (unsigned)((32 * w + i16) * 768 + 8 * q4);
#pragma unroll
    for (int qt = 0; qt < 2; ++qt)
#pragma unroll
        for (int ks = 0; ks < 6; ++ks) qf[qt][ks] = *(const bf16x8*)(Qb + (qoff + (unsigned)(16 * qt * 768 + 32 * ks)));
    { const float* rope = WSP(float, WS_ROPE); const bool lat = qrow0 < RL;
#pragma unroll
      for (int qt = 0; qt < 2; ++qt) {
          float f[6][8]; float ss = 0.f;
#pragma unroll
          for (int ks = 0; ks < 6; ++ks) { unpack8(__builtin_bit_cast(v4u, qf[qt][ks]), f[ks]);
#pragma unroll
              for (int j = 0; j < 8; ++j) ss += f[ks][j] * f[ks][j]; }
          ss += shx(ss, 16, lane); ss += shx(ss, 32, lane);
          const float rs = rsqrtf(ss * (1.f / 192.f) + EPS);
#pragma unroll
          for (int ks = 0; ks < 6; ++ks) { const f32x4 n0 = *(const f32x4*)(qn + 32 * ks + 8 * q4), n1 = *(const f32x4*)(qn + 32 * ks + 8 * q4 + 4);
#pragma unroll
              for (int j = 0; j < 4; ++j) { f[ks][j] *= rs * n0[j]; f[ks][4 + j] *= rs * n1[j]; } }
          if (lat) { const int t = (qrow0 + 32 * w + 16 * qt + i16) & (SEQ - 1); const bool second = (q4 & 2) != 0;
#pragma unroll
              for (int part = 0; part < 2; ++part) {
                  const int pos = part ? (t & 63) : (t >> 6); const f32x4* tp = (const f32x4*)(rope + (size_t)(pos * 16 + 8 * (q4 & 1)) * 2);
                  const f32x4 t0 = tp[0], t1 = tp[1], t2 = tp[2], t3 = tp[3];
                  const float cs[8] = {t0.x, t0.z, t1.x, t1.z, t2.x, t2.z, t3.x, t3.z}, sn[8] = {t0.y, t0.w, t1.y, t1.w, t2.y, t2.w, t3.y, t3.w};
#pragma unroll
                  for (int j = 0; j < 8; ++j) { const float me = f[4 + part][j], other = shx(me, 32, lane); f[4 + part][j] = second ? (me * cs[j] + other * sn[j]) : (me * cs[j] - other * sn[j]); } } }
#pragma unroll
          for (int ks = 0; ks < 6; ++ks) {
#pragma unroll
              for (int j = 0; j < 8; ++j) f[ks][j] *= ATTN_SCALE_LOG2E;
              qf[qt][ks] = __builtin_bit_cast(bf16x8, pack8(f[ks])); }
      } }
    f32x4 O[2][8];
#pragma unroll
    for (int qt = 0; qt < 2; ++qt)
#pragma unroll
        for (int dt = 0; dt < 8; ++dt) O[qt][dt] = (f32x4){0.f, 0.f, 0.f, 0.f};
    float mrun[2] = {-1e30f, -1e30f}, lsum[2] = {0.f, 0.f};
    const bf16* kbase = K + (size_t)b * TOK * 768 + h * 192;
    v4u kr[3], vr[2];
    unsigned koff[3], voff[2];
#pragma unroll
    for (int i = 0; i < 3; ++i) { const int idx = tid + 512 * i, r = idx / 24, cc = idx % 24; koff[i] = (unsigned)(r * 768 + 8 * cc); }
#pragma unroll
    for (int i = 0; i < 2; ++i) { const int idx = tid + 512 * i, r = idx >> 4, cc = idx & 15; voff[i] = (unsigned)(r * 1024 + 8 * cc); }
    auto load_tile = [&](int kt) {
        const bf16* kb = kbase + (size_t)kt * (64 * 768); const bf16* vb = KVRAW + (size_t)row_key(b, 64 * kt) * 1024 + h * 256 + 128;
#pragma unroll
        for (int i = 0; i < 3; ++i) kr[i] = *(const v4u*)(kb + koff[i]);
#pragma unroll
        for (int i = 0; i < 2; ++i) vr[i] = *(const v4u*)(vb + voff[i]);
    };
    const LAS bf16* vtr0 = Vl + (4 * q4 + (i16 >> 2)) * AT_VP + 4 * (i16 & 3);
    int kwo[3], vwo[2];
#pragma unroll
    for (int i = 0; i < 3; ++i) { const int idx = tid + 512 * i, r = idx / 24, cc = idx % 24; kwo[i] = r * 200 + 8 * cc; }
#pragma unroll
    for (int i = 0; i < 2; ++i) { const int idx = tid + 512 * i, r = idx >> 4, cc = idx & 15; vwo[i] = r * AT_VP + 8 * cc; }
    load_tile(0);
    __syncthreads();
#pragma unroll
    for (int i = 0; i < 3; ++i) *(LAS v4u*)(Kl + kwo[i]) = kr[i];
#pragma unroll
    for (int i = 0; i < 2; ++i) *(LAS v4u*)(Vl + vwo[i]) = vr[i];
    __syncthreads();
    for (int kt = 0; kt < nkt; ++kt) {
        const int bo = (kt & 1) * (AT_BUF / 2);
        const LAS bf16* Kc = Kl + bo; const LAS bf16* vtrc = vtr0 + bo;
        if (kt + 1 < nkt) load_tile(kt + 1);
        f32x4 s[2][4];
#pragma unroll
        for (int k4 = 0; k4 < 4; ++k4) {
            f32x4 s0 = (f32x4){0.f, 0.f, 0.f, 0.f}, s1 = (f32x4){0.f, 0.f, 0.f, 0.f};
#pragma unroll
            for (int ks = 0; ks < 6; ++ks) { const bf16x8 kf = ldsfrag(Kc + (16 * k4 + i16) * 200 + 32 * ks + 8 * q4); s0 = MFMA16(kf, qf[0][ks], s0); s1 = MFMA16(kf, qf[1][ks], s1); }
            s[0][k4] = s0; s[1][k4] = s1;
        }
        bf16x8 pf[2][2];
#pragma unroll
        for (int qt = 0; qt < 2; ++qt) {
            float tm = -1e30f;
#pragma unroll
            for (int k4 = 0; k4 < 4; ++k4)
#pragma unroll
                for (int r = 0; r < 4; ++r) tm = fmaxf(tm, s[qt][k4][r]);
            tm = fmaxf(tm, shx(tm, 16, lane)); tm = fmaxf(tm, shx(tm, 32, lane));
            const float mn = fmaxf(mrun[qt], tm), alpha = __builtin_amdgcn_exp2f(mrun[qt] - mn);
            mrun[qt] = mn;
            float ps = 0.f; float p[4][4];
#pragma unroll
            for (int k4 = 0; k4 < 4; ++k4)
#pragma unroll
                for (int r = 0; r < 4; ++r) { p[k4][r] = __builtin_amdgcn_exp2f(s[qt][k4][r] - mn); ps += p[k4][r]; }
            lsum[qt] = lsum[qt] * alpha + ps;
#pragma unroll
            for (int dt = 0; dt < 8; ++dt) O[qt][dt] = O[qt][dt] * alpha;
#pragma unroll
            for (int kk = 0; kk < 2; ++kk) { v4u pw; pw.x = pk2(p[2 * kk][0], p[2 * kk][1]); pw.y = pk2(p[2 * kk][2], p[2 * kk][3]); pw.z = pk2(p[2 * kk + 1][0], p[2 * kk + 1][1]); pw.w = pk2(p[2 * kk + 1][2], p[2 * kk + 1][3]);
                pf[qt][kk] = __builtin_bit_cast(bf16x8, pw); }
        }
#pragma unroll
        for (int dt = 0; dt < 8; ++dt)
#pragma unroll
            for (int kk = 0; kk < 2; ++kk) {
                const v2u lo = tr16(vtrc + (32 * kk) * AT_VP + 16 * dt), hi = tr16(vtrc + (32 * kk + 16) * AT_VP + 16 * dt);
                const v4u vw = (v4u){lo.x, lo.y, hi.x, hi.y}; const bf16x8 vf = __builtin_bit_cast(bf16x8, vw);
                O[0][dt] = MFMA16(vf, pf[0][kk], O[0][dt]); O[1][dt] = MFMA16(vf, pf[1][kk], O[1][dt]);
            }
        if (kt + 1 < nkt) { const int bn = ((kt + 1) & 1) * (AT_BUF / 2);
#pragma unroll
            for (int i = 0; i < 3; ++i) *(LAS v4u*)(Kl + bn + kwo[i]) = kr[i];
#pragma unroll
            for (int i = 0; i < 2; ++i) *(LAS v4u*)(Vl + bn + vwo[i]) = vr[i]; }
        __syncthreads();
    }
#pragma unroll
    for (int qt = 0; qt < 2; ++qt) {
        float lt = lsum[qt]; lt += shx(lt, 16, lane); lt += shx(lt, 32, lane);
        const float inv = 1.f / lt;
        bf16* Yb = Y + (size_t)qrow0 * DM + 1024 + h * 128; const unsigned yoff = (unsigned)((32 * w + 16 * qt + i16) * DM + 4 * q4);
#pragma unroll
        for (int dt = 0; dt < 8; ++dt) { const f32x4 o = O[qt][dt] * inv; v2u ow; ow.x = pk2(o[0], o[1]); ow.y = pk2(o[2], o[3]); *(v2u*)(Yb + (yoff + (unsigned)(16 * dt))) = ow; }
    }
    __syncthreads();
}
template <class E_> __device__ __forceinline__ void probe_redirect(E_&, float*) {}
__device__ __forceinline__ void probe_redirect(pg8::EpiRes& e, float* dummy) { e.xout = dummy; }

__global__ void __launch_bounds__(NTHR, 2) trunk_fwd(Args A) {
    extern __shared__ __attribute__((aligned(16))) unsigned char lds[];
    Frame F;
    F.lds = (LAS unsigned char*)lds;
    F.MISC = (volatile LAS unsigned*)(F.lds + MISC_OFF);
    F.tid = threadIdx.x; F.lane = F.tid & 63; F.wave = __builtin_amdgcn_readfirstlane(F.tid >> 6);
    F.G = gridDim.x; F.bid = blockIdx.x;
    F.ws = A.ws; F.out = A.out; F.kp = (const __attribute__((address_space(4))) char*)__builtin_amdgcn_kernarg_segment_ptr();
    unsigned char* const ws0 = A.ws; const __attribute__((address_space(4))) char* const kp0 = F.kp;
    F.ctl = (gu32*)(A.ws + WS_CTL);
    for (int u = F.tid; u < (LDS_BYTES - LDSCTL_OFF) / 4; u += NTHR) ((LAS unsigned*)(F.lds + LDSCTL_OFF))[u] = 0u;
    __syncthreads();
    XcdBarrier bar = xcd_barrier_post((unsigned*)(F.ctl + CW_BAR), F.MISC + 8);
    const int lo = A.lo, hi = A.hi, wave0 = F.wave;
    int st = 0;
#define RELAUNDER() do { int w_s = wave0; asm volatile("" : "+s"(w_s)); F.wave = w_s; { unsigned m_ = ~0u; asm volatile("" : "+v"(m_)); F.lane = (int)__builtin_amdgcn_mbcnt_hi(m_, __builtin_amdgcn_mbcnt_lo(m_, 0u)); } F.tid = w_s * 64 + F.lane; int b_ = blockIdx.x, g_ = gridDim.x; asm volatile("" : "+s"(b_), "+s"(g_)); F.bid = b_; F.G = g_; GAS unsigned char* w_ = (GAS unsigned char*)ws0; asm volatile("" : "+s"(w_)); F.ws = (unsigned char*)w_; const __attribute__((address_space(4))) char* k_ = kp0; asm volatile("" : "+s"(k_)); F.kp = k_; } while (0)
#define STEP_BEGIN if (st >= lo && st < hi) { asm volatile("; STEP_MARK_BEGIN %0" :: "n"(__LINE__)); RELAUNDER();
#define STEP_END   asm volatile("; STEP_MARK_END %0" :: "n"(__LINE__)); if (st + 1 < hi) { xcd_barrier(bar); if (PROBE_DUP == 11) xcd_barrier(bar); } } ++st;
#define PROBE_REDIRECT(e) probe_redirect(e, WSP(float, WS_Z))
#define GEMM_STAGGER() do { if (STAG_GROUPS > 1) { const int sg_ = (F.bid >> 3) % STAG_GROUPS; for (int i_ = 0; i_ < sg_; ++i_) __builtin_amdgcn_s_sleep(STAG_SLEEP); } } while (0)
#define GEMM_RUN(EPI) { if (PROBE_DUP == 8) { auto E2_ = E; PROBE_REDIRECT(E2_); pg8::gemm_phase<decltype(E2_), pg8::StaticOrder, GEMM_ALIGN, GEMM_SP2>(ring, g, S, E2_, F.tid); RELAUNDER(); } \
    if (PROBE_DUP == 1) { pg8::EpiNull EN_; pg8::gemm_phase<pg8::EpiNull, pg8::StaticOrder, GEMM_ALIGN, GEMM_SP2>(ring, g, S, EN_, F.tid); RELAUNDER(); } \
    pg8::gemm_phase<pg8::EPI, pg8::StaticOrder, GEMM_ALIGN, GEMM_SP2>(ring, g, S, E, F.tid); }
#define GEMM_RUN_NSP(EPI, NSPV) { pg8::gemm_phase<pg8::EPI, pg8::StaticOrder, GEMM_ALIGN, GEMM_SP2, NSPV>(ring, g, S, E, F.tid); }
#define MODS_L (WSP(float, WS_MODS) + (size_t)l * 17 * NMOD)
    LAS unsigned char* ring = F.lds + RING_OFF;

    STEP_BEGIN
        for (int rep = 0; rep < (PROBE_DUP == 7 ? 2 : 1); ++rep)
        p0a_prologue(F, KIN(I_C), KIN(I_CCTX), KIN(I_ADAW), KIN(I_ADAB), KIN(I_S5LRE), KIN(I_S5LIM), KIN(I_S5LDT), KIN(I_S5BRE), KIN(I_S5BIM), KIN(I_S5CRE), KIN(I_S5CIM));
    STEP_END
    STEP_BEGIN
        for (int rep = 0; rep < (PROBE_DUP == 24 ? 2 : 1); ++rep) { p0c_shw(F, KIN(I_WIN), KIN(I_W1)); RELAUNDER(); }
    STEP_END

    for (int l = 0; l < DEPTH; ++l) {
        const bool need_ctx = l < DEPTH - 1;
        const int nrows = need_ctx ? RT : RL;
        STEP_BEGIN
            for (int rep = 0; rep < ((PROBE_DUP == 4 || PROBE_DUP == 20) ? 2 : 1); ++rep) {
            convert_weights(F, A, l, l);
            RELAUNDER();
            if (l == 0) norm0_phase(F, KIN(I_X), KIN(I_CTX), KIN(I_N1W), WSP(float, WS_MODS));
            else { rstd_phase(F, RL); RELAUNDER(); if (rep == 0) ctxfix_phase(F, MODS_L - 17 * NMOD + 16 * NMOD + 5 * DM, KIN(I_N1W) + (size_t)l * DM, MODS_L + 16 * NMOD + 1 * DM); }
            RELAUNDER(); }
        STEP_END
        STEP_BEGIN
            pg8::Gemm g{WSP(bf16, WS_H), WSP(bf16, WS_WIN), RT, LDZ, DM}; g.ablk = 1; pg8::StaticOrder S; S.init(RT, LDZ, F.G, F.bid);
            for (int rep = 0; rep < (PROBE_DUP == 14 ? 2 : 1); ++rep) {
            pg8::EpiStoreN E{WSP(bf16, WS_Z), LDZ, WSP(float, WS_RSTD), WSP(float, WS_SHW) + (size_t)l * 17 * (LDZ + DFF), LDZ + DFF};
            GEMM_STAGGER(); GEMM_RUN(EpiStoreN)
            RELAUNDER(); }
        STEP_END
        STEP_BEGIN
            for (int rep = 0; rep < ((PROBE_DUP == 4 || PROBE_DUP == 21) ? 2 : 1); ++rep) { prep_phase(F, A, l); RELAUNDER(); }
        STEP_END
        STEP_BEGIN
            for (int rep = 0; rep < (PROBE_DUP == 12 ? 2 : 1); ++rep) {
            { const pg8::GrpDesc gl{WSP(bf16, WS_XS), WSP(bf16, WS_WLRU), RT, 2048, 128, 512, 4}, gk{WSP(bf16, WS_AKV), WSP(bf16, WS_WKVUP), RT, 1024, 256, 256, 0},
                                 gq{WSP(bf16, WS_AQ), WSP(bf16, WS_WQUP), need_ctx ? RT : RL, 768, 384, 384, 0};
              const pg8::EpiLru el{WSP(bf16, WS_XS), WSP(bf16, WS_LOGA), WSP(bf16, WS_GB), WSP(float, WS_LRUC)};
              const pg8::EpiStoreBf16 ek{WSP(bf16, WS_KVRAW), 1024}, eq{WSP(bf16, WS_QRAW), 768};
              pg8::gemm_group3(ring, gl, gk, gq, el, ek, eq, F.G, F.bid, F.tid); }
            RELAUNDER(); }
        STEP_END
        STEP_BEGIN
            for (int rep = 0; rep < (PROBE_DUP == 3 ? 2 : 1); ++rep) {
            const int s5wg = (S5_IN_L4 && F.G >= 256) ? 64 : 0;
            if (F.bid < s5wg) s5_scan(F, l, F.bid * 4 + (F.wave >> 1), F.wave & 1);
            else {
            for (int wu = (F.bid - s5wg) * NWAVES + F.wave; wu < NB * 2 * 36; wu += (F.G - s5wg) * NWAVES) lru_chunk<false>(F, wu);
            RELAUNDER();
            mla_finish(F, A, l, need_ctx, s5wg, F.G - s5wg); }
            RELAUNDER(); }
        STEP_END
        STEP_BEGIN
            const int nattn = 704 + (need_ctx ? 64 : 0), nunits = nattn + 144;
            volatile LAS unsigned* slot = F.MISC + 16;
            for (int rep = 0; rep < ((PROBE_DUP == 2 || PROBE_DUP == 5 || PROBE_DUP == 6 || PROBE_DUP == 9) ? 2 : 1); ++rep) {
            gu32* qh = F.ctl + CW_QUEUE + 64 * (l + 4 * rep);
            const int ubase = (rep == 1 && PROBE_DUP == 6) ? 192 : (rep == 1 && PROBE_DUP == 9) ? 128 : 0;
            const int ulim = (rep == 1 && PROBE_DUP == 5) ? 128 : (rep == 1 && PROBE_DUP == 9) ? 192 : nunits;
            for (;;) {
                __syncthreads();
                if (F.tid == 0) slot[0] = __hip_atomic_fetch_add(qh, 1u, __ATOMIC_RELAXED, __HIP_MEMORY_SCOPE_AGENT);
                __syncthreads();
                const int u = ubase + __builtin_amdgcn_readfirstlane((int)slot[0]);
                if (u >= ulim) break;
                if (u < 128) mlstm_chain(F, A, l, u);
                else if (u < 192) s5_scan(F, l, (u - 128) * 4 + (F.wave >> 1), F.wave & 1);
                else if (u >= nattn) lru_chunk<true>(F, (u - nattn) * 8 + F.wave);
                else { int ab, ah, aq, an; const int ua = u - 192;
                    if (ua < 512) { ab = ua >> 5; ah = (ua >> 3) & 3; aq = (ua >> 5) * SEQ + 256 * (ua & 7); an = TOK / 64; }
                    else { const int uc = ua - 512; ab = uc >> 2; ah = uc & 3; aq = RL + (uc >> 2) * CTXL; an = CTXL / 64; }
                    attn_unit(F, ab, ah, aq, an, KIN(I_QN) + (size_t)l * 192); }
                RELAUNDER();
            }
            }
        STEP_END
        STEP_BEGIN
            pg8::Gemm g{WSP(bf16, WS_A5), WSP(bf16, WS_WGLU), nrows, 512, 512}; pg8::StaticOrder S; S.init(nrows, 512, F.G, F.bid);
            for (int rep = 0; rep < (PROBE_DUP == 13 ? 2 : 1); ++rep) {
            pg8::EpiGlu E{WSP(bf16, WS_A5), WSP(bf16, WS_Y), DM, KIN(I_S5GLUB) + (size_t)l * 512};
            GEMM_RUN(EpiGlu)
            RELAUNDER();
            finish_phase<false, true>(F, A, l, nrows);
            RELAUNDER(); }
        STEP_END
        STEP_BEGIN
            pg8::Gemm g{WSP(bf16, WS_Y), WSP(bf16, WS_WOUT), nrows, DM, DM}; pg8::StaticOrder S; S.init(nrows, DM, F.G, F.bid);
            if (l == 0) {
                pg8::EpiResNF E{KIN(I_X), KIN(I_CTX) - (size_t)RL * DM, WSP(bf16, WS_X), MODS_L + 2 * DM, 0, WSP(bf16, WS_H), KIN(I_N2W) + (size_t)l * DM, MODS_L + 4 * DM, WSP(float, WS_SSP)};
                GEMM_RUN(EpiResNF)
            } else {
                pg8::EpiResN E{WSP(bf16, WS_X), WSP(bf16, WS_X), WSP(bf16, WS_X), MODS_L + 2 * DM, 0, WSP(bf16, WS_H), KIN(I_N2W) + (size_t)l * DM, MODS_L + 4 * DM, WSP(float, WS_SSP)};
                GEMM_RUN(EpiResN)
            }
        STEP_END
        STEP_BEGIN
            for (int rep = 0; rep < (PROBE_DUP == 23 ? 2 : 1); ++rep) { rstd_phase(F, nrows); RELAUNDER(); }
        STEP_END
        { const int nch = (nrows + MLP_CHUNK - 1) / MLP_CHUNK;
          for (int c = 0; c <= nch; ++c) {
            STEP_BEGIN
                const int g1first = (MLP_ALT && c >= 1 && c < nch) ? ((F.bid >> 3) & 1) : 0;
                for (int ord = 0; ord < 2; ++ord) { const int which = ord ^ g1first;
                if (which == 0) {
                if (c >= 1) { const int r0 = (c - 1) * MLP_CHUNK, m = min(MLP_CHUNK, nrows - r0); const bf16* hid = WSP(bf16, WS_Z) + (size_t)((c - 1) & 1) * MLP_CHUNK * DFF;
                    if (m >= 8192) {
                        if (need_ctx) {
                            pg8::Gemm g{hid, WSP(bf16, WS_W2), m, DM, DFF}; g.ablk = 1; pg8::StaticOrder S; S.init(m, DM, F.G, F.bid);
                            pg8::EpiResN E{WSP(bf16, WS_X), WSP(bf16, WS_X), WSP(bf16, WS_X), MODS_L + 5 * DM, r0,
                                           WSP(bf16, WS_H), KIN(I_N1W) + (size_t)(l + 1) * DM, MODS_L + 17 * NMOD + 1 * DM, WSP(float, WS_SSP)};
                            GEMM_RUN(EpiResN)
                        } else {
                            pg8::Gemm g{hid, WSP(bf16, WS_W2), m, DM, DFF}; g.ablk = 1; pg8::StaticOrder S; S.init(m, DM, F.G, F.bid);
                            pg8::EpiResOut E{WSP(bf16, WS_X), F.out, MODS_L + 5 * DM, r0};
                            GEMM_RUN(EpiResOut)
                        }
                    } else {
                        pg8::Gemm g{hid, WSP(bf16, WS_W2), m, 2 * DM, DFF / 2, DFF, DM / 256}; g.ablk = 1; pg8::StaticOrder S; S.init(m, 2 * DM, F.G, F.bid);
                        pg8::EpiPart E{WSP(float, WS_LOGA), DM / 256, RC};
                        GEMM_RUN_NSP(EpiPart, 8)
                    }
                    RELAUNDER(); }
                } else {
                if (c < nch) { const int r0 = c * MLP_CHUNK, m = min(MLP_CHUNK, nrows - r0);
                    pg8::Gemm g{WSP(bf16, WS_H) + (size_t)r0 * DM, WSP(bf16, WS_W1), m, DFF, DM}; g.ablk = 1; pg8::StaticOrder S; S.init(m, DFF, F.G, F.bid);
                    pg8::EpiRelu2N E{WSP(bf16, WS_Z) + (size_t)(c & 1) * MLP_CHUNK * DFF, DFF, WSP(float, WS_RSTD), WSP(float, WS_SHW) + (size_t)l * 17 * (LDZ + DFF) + LDZ, LDZ + DFF, r0};
                    if (PROBE_DUP == 25) { GEMM_RUN(EpiRelu2N) RELAUNDER(); }
                    GEMM_RUN(EpiRelu2N) }
                }
                RELAUNDER(); }
            STEP_END
          } }
    }
#undef STEP_BEGIN
#undef STEP_END
}

extern "C" void kernel_launch(void* const* d_in, const int* in_sizes, int n_in, void* d_out, int out_size, void* d_ws, size_t ws_size, hipStream_t stream) {
    static int grid = 0;
    if (grid == 0) {
        if (n_in != N_IN || in_sizes[0] != RL * DM || out_size != RL * DM || ws_size < WS_END) {
            fprintf(stderr, "kernel_launch: shape/workspace mismatch: n_in %d in0 %d out %d ws %zu (need %zu); nothing launched\n", n_in, n_in > 0 ? in_sizes[0] : -1, out_size, ws_size, (size_t)WS_END); grid = -1; return; }
        int dev = 0, cus = 0, per_cu = 0;
        if (hipGetDevice(&dev) != hipSuccess || hipDeviceGetAttribute(&cus, hipDeviceAttributeMultiprocessorCount, dev) != hipSuccess) { grid = -1; return; }
        if (hipFuncSetAttribute((const void*)trunk_fwd, hipFuncAttributeMaxDynamicSharedMemorySize, LDS_BYTES) != hipSuccess) { fprintf(stderr, "kernel_launch: hipFuncSetAttribute failed\n"); grid = -1; return; }
        if (hipOccupancyMaxActiveBlocksPerMultiprocessor(&per_cu, (const void*)trunk_fwd, NTHR, LDS_BYTES) != hipSuccess || per_cu < 1)
            fprintf(stderr, "kernel_launch: note: occupancy query reports %d workgroups per CU\n", per_cu);
        (void)hipGetLastError();
        grid = cus;
    }
    if (grid < 0) return;
    if (hipMemsetAsync((char*)d_ws + WS_CTL, 0, CTL_ZERO_BYTES, stream) != hipSuccess) return;
    Args a{};
    for (int i = 0; i < N_IN; ++i) a.in[i] = (const float*)d_in[i];
    a.out = (float*)d_out; a.ws = (unsigned char*)d_ws;
#ifndef MK_SPLIT
    a.lo = 0; a.hi = 1 << 20;
    hipLaunchKernelGGL(trunk_fwd, dim3(grid), dim3(NTHR), LDS_BYTES, stream, a);
#else
    for (int s = 0; s < MK_SPLIT; ++s) { a.lo = s; a.hi = s + 1; hipLaunchKernelGGL(trunk_fwd, dim3(grid), dim3(NTHR), LDS_BYTES, stream, a); }
#endif
}
```

```cpp
#include <hip/hip_runtime.h>
#include <cstdio>
#include <cstdint>
#ifndef GEMM_ALIGN
#define GEMM_ALIGN true
#endif
#ifndef GEMM_SP2
#define GEMM_SP2 true
#endif
#ifndef MLP_CHUNK
#define MLP_CHUNK 8192
#endif
#ifndef STAG_GROUPS
#define STAG_GROUPS 1
#define STAG_SLEEP 64
#endif
#ifndef EPI_NT
#define EPI_NT 0
#endif
#ifndef S5_IN_L4
#define S5_IN_L4 0
#endif
#ifndef MLP_ALT
#define MLP_ALT 0
#endif
#ifndef WOUT_STAG_GROUPS
#define WOUT_STAG_GROUPS 1
#define WOUT_STAG_STEPS 4
#endif
#ifndef PROBE_DUP
#define PROBE_DUP 0
#endif

constexpr int DM = 2048, NB = 16, SEQ = 2048, CTXL = 256, DEPTH = 4, DFF = 8192;
constexpr int RL = NB * SEQ;
constexpr int RC = NB * CTXL;
constexpr int RT = RL + RC;
constexpr int TOK = SEQ + CTXL;
constexpr int NZ = 4176, LDZ = 4352;
constexpr int ZU = 0, ZMQ = 512, ZMK = 1024, ZMV = 1536, ZMO = 2048, ZMG = 2560, ZCQ = 2576, ZCKV = 2960, ZKR = 3088, ZLX = 3152, ZLG = 3664;
constexpr int NMOD = 6 * DM;
constexpr float EPS = 1e-6f;
constexpr int NWAVES = 8, NTHR = 512;

enum { I_X = 0, I_C, I_CTX, I_CCTX, I_ADAW, I_ADAB, I_N1W, I_N2W, I_WIN, I_WOUT, I_S5LRE, I_S5LIM, I_S5LDT, I_S5BRE, I_S5BIM, I_S5CRE, I_S5CIM, I_S5D, I_S5GLUW, I_S5GLUB,
       I_MLIG, I_MLFG, I_MLON, I_QAN, I_WQUP, I_KVAN, I_WKVUP, I_QN, I_KN, I_LCW, I_LCB, I_LWA, I_LBA, I_LWX, I_LBX, I_LLAM, I_W1, I_W2, N_IN };

constexpr size_t MiB = 1u << 20;
#ifndef WS_SKEW
#define WS_SKEW 1
#endif
#ifndef BLK_LAYOUT
#define BLK_LAYOUT 1
#endif
__host__ __device__ __forceinline__ size_t blk_off(int row, int col, int nct) { return BLK_LAYOUT ? (((size_t)((row >> 8) * nct + (col >> 8))) << 16) + (size_t)((row & 255) * 256 + (col & 255)) : (size_t)row * (size_t)(256 * nct) + col; }
constexpr size_t WS_CTL = 0, CTL_ZERO_BYTES = 1 * MiB;
constexpr size_t WS_MODS = 1 * MiB;
constexpr size_t WS_S5A = 5 * MiB;
constexpr size_t WS_S5BB = 5 * MiB + 512 * 1024;
constexpr size_t WS_S5CM = 6 * MiB + 512 * 1024;
constexpr size_t WS_LRUC = 7 * MiB + 512 * 1024;
constexpr size_t WS_ROPE = 7 * MiB + 640 * 1024;
constexpr size_t WS_W = 8 * MiB;
constexpr size_t WS_WIN = WS_W;
constexpr size_t WS_WOUT = WS_WIN + 17 * MiB;
constexpr size_t WS_W1 = WS_WOUT + 8 * MiB;
constexpr size_t WS_W2 = WS_W1 + 32 * MiB;
constexpr size_t WS_WGLU = WS_W2 + 32 * MiB;
constexpr size_t WS_WQUP = WS_WGLU + 1 * MiB;
constexpr size_t WS_WKVUP = WS_WQUP + 1 * MiB;
constexpr size_t WS_WLRU = WS_WKVUP + 1 * MiB;
constexpr size_t WS_X = WS_WLRU + 2 * MiB;
constexpr size_t WS_H = WS_X + 288 * MiB + WS_SKEW * 129 * 256;
constexpr size_t WS_Z = WS_H + 144 * MiB + WS_SKEW * 67 * 256;
constexpr size_t WS_Y = WS_Z + 306 * MiB + WS_SKEW * 201 * 256;
constexpr size_t WS_HID = WS_Y + 144 * MiB + WS_SKEW * 37 * 256;
constexpr size_t WS_T = WS_HID + 128 * MiB + WS_SKEW * 93 * 256;
constexpr size_t WS_XS = WS_H;
constexpr size_t WS_AQ = WS_H + 36 * MiB;
constexpr size_t WS_AKV = WS_H + 63 * MiB;
constexpr size_t WS_Q = WS_H;
constexpr size_t WS_K = WS_H + 54 * MiB;
constexpr size_t WS_VT = WS_H + 108 * MiB;
constexpr size_t WS_QRAW = WS_HID;
constexpr size_t WS_KVRAW = WS_HID + 54 * MiB;
constexpr size_t WS_LOGA = WS_T;
constexpr size_t WS_GB = WS_T + 72 * MiB;
constexpr size_t WS_YS = WS_T + 144 * MiB;
constexpr size_t WS_A5 = WS_X + 144 * MiB;
constexpr size_t WS_MH = WS_T + 216 * MiB;
constexpr size_t WS_LH = WS_T + 288 * MiB;
constexpr size_t WS_MODP = WS_Z;
constexpr size_t WS_LSUM = WS_T + 360 * MiB;
constexpr size_t WS_SHW = WS_T + 368 * MiB;
constexpr size_t WS_SSP = WS_T + 372 * MiB;
constexpr size_t WS_RSTD = WS_T + 377 * MiB;
constexpr size_t WS_END = WS_T + 378 * MiB;
static_assert(WS_END <= (size_t)1536 * MiB, "d_ws map exceeds 4 x largest input tensor");

constexpr int CW_TMO = 0, CW_CODE = 1;
constexpr int CW_BAR = 4096;
constexpr int CW_QUEUE = 8192;

constexpr int RING_OFF = 0, RING_BYTES = 131072;
constexpr int LDSCTL_OFF = RING_BYTES, MISC_OFF = LDSCTL_OFF + 320;
constexpr int LDS_BYTES = 147456;

#define GAS __attribute__((address_space(1)))
#define LAS __attribute__((address_space(3)))
typedef unsigned short bf16;
typedef unsigned v4u __attribute__((ext_vector_type(4)));
typedef unsigned v2u __attribute__((ext_vector_type(2)));
typedef float f32x4 __attribute__((ext_vector_type(4)));
typedef float f32x16 __attribute__((ext_vector_type(16)));
typedef short bf16x8 __attribute__((ext_vector_type(8)));
typedef short bf16x4 __attribute__((ext_vector_type(4)));
typedef GAS unsigned gu32;
#define RLX_AGENT __ATOMIC_RELAXED, __HIP_MEMORY_SCOPE_AGENT
#define LDS_WAIT() asm volatile("s_waitcnt lgkmcnt(0)" ::: "memory")
#define VM_WAIT() asm volatile("s_waitcnt vmcnt(0)" ::: "memory")
__device__ __forceinline__ unsigned f2bf(float f) { unsigned u = __builtin_bit_cast(unsigned, f); return (u + 0x7fffu + ((u >> 16) & 1u)) >> 16; }
typedef __bf16 bf16x2_t __attribute__((ext_vector_type(2)));
typedef float f32x2_t __attribute__((ext_vector_type(2)));
__device__ __forceinline__ unsigned pk2(float lo, float hi) { const f32x2_t v = {lo, hi}; const bf16x2_t b = __builtin_convertvector(v, bf16x2_t); return __builtin_bit_cast(unsigned, b); }
__device__ __forceinline__ float bf2f(unsigned b) { return __builtin_bit_cast(float, b << 16); }
__device__ __forceinline__ float bflo(unsigned w) { return __builtin_bit_cast(float, w << 16); }
__device__ __forceinline__ float bfhi(unsigned w) { return __builtin_bit_cast(float, w & 0xffff0000u); }
__device__ __forceinline__ void unpack8(const v4u w, float (&f)[8]) { f[0] = bflo(w.x); f[1] = bfhi(w.x); f[2] = bflo(w.y); f[3] = bfhi(w.y); f[4] = bflo(w.z); f[5] = bfhi(w.z); f[6] = bflo(w.w); f[7] = bfhi(w.w); }
__device__ __forceinline__ v4u pack8(const float (&f)[8]) { v4u w; w.x = pk2(f[0], f[1]); w.y = pk2(f[2], f[3]); w.z = pk2(f[4], f[5]); w.w = pk2(f[6], f[7]); return w; }
__device__ __forceinline__ float sigmoidf_(float x) { return __builtin_amdgcn_rcpf(1.f + __expf(-x)); }
__device__ __forceinline__ float gelu_tanh(float x) { const float u = 0.7978845608028654f * (x + 0.044715f * x * x * x); const float t = 1.f - 2.f * __builtin_amdgcn_rcpf(1.f + __expf(2.f * u)); return 0.5f * x * (1.f + t); }
__device__ __forceinline__ float softplusf_(float x) { return fmaxf(x, 0.f) + log1pf(__expf(-fabsf(x))); }
__device__ __forceinline__ float logsigmoidf_(float x) { return fminf(x, 0.f) - log1pf(__expf(-fabsf(x))); }
__device__ __forceinline__ float shx(float v, int mask, int lane) { return __builtin_bit_cast(float, __builtin_amdgcn_ds_bpermute((lane ^ mask) << 2, __builtin_bit_cast(int, v))); }
__device__ __forceinline__ float shup(float v, int delta, int lane) { return __builtin_bit_cast(float, __builtin_amdgcn_ds_bpermute(((lane - delta) & 63) << 2, __builtin_bit_cast(int, v))); }
__device__ __forceinline__ float wave_sum(float v, int lane) {
#pragma unroll
    for (int o = 1; o < 64; o <<= 1) v += shx(v, o, lane);
    return v;
}
__device__ __forceinline__ v4u zero_v4u() { unsigned z = 0u; asm volatile("" : "+v"(z)); return (v4u){z, z, z, z}; }
__device__ __forceinline__ int row_scan(int b, int dir, int p) {
    if (p < CTXL) { const int t = dir ? (CTXL - 1 - p) : p; return RL + b * CTXL + t; }
    const int q = p - CTXL; const int t = dir ? (SEQ - 1 - q) : q; return b * SEQ + t;
}
__device__ __forceinline__ int row_key(int b, int key) { return key < CTXL ? RL + b * CTXL + key : b * SEQ + (key - CTXL); }
__device__ __forceinline__ int mod_row(int r) { return r < RL ? (r >> 11) : NB; }
namespace pg8 {
#define PG8_LAS __attribute__((address_space(3)))
typedef unsigned short bf16_t;
typedef short bf16x8 __attribute__((ext_vector_type(8)));
typedef float f32x4 __attribute__((ext_vector_type(4)));
typedef unsigned u32x4 __attribute__((ext_vector_type(4)));
constexpr int BM = 256, BK = 64, HALF = 128, HTB = HALF * BK * 2  , STAGE_BYTES = 8 * HTB, NXCD = 8, WGM = 8;

__host__ __device__ __forceinline__ int lds_byte(int r, int c) { const int st = (r >> 4) * 2 + (c >> 5), rr = r & 15, cc = c & 31, ob = rr * 64 + cc * 2; return st * 1024 + (ob ^ (((ob >> 9) & 1) << 5)); }
__host__ __device__ __forceinline__ void stage_rc(int b, int& R, int& C) { const int st = b / 1024, sb = b % 1024, swz = sb ^ (((sb >> 9) & 1) << 5); R = (st >> 1) * 16 + swz / 64; C = (st & 1) * 32 + (swz % 64) / 2; }
__host__ __device__ __forceinline__ int perm32(int rho) { const int n = rho >> 4, i = rho & 15; return 8 * (i >> 2) + 4 * n + (i & 3); }

struct Unit { int pm, pn; };
struct Gemm { const bf16_t* A; const bf16_t* Bt; int M, N, K; int ld = 0, nsplit = 0, ablk = 0; };

struct StaticOrder {
    int nM, nN, nwg, G, c;
    __host__ __device__ void init(int M, int N, int G_, int c_) { nM = M / BM; nN = N / BM; nwg = nM * nN; G = G_; c = c_; }
    __host__ __device__ bool next(int i, Unit& u) const {
        const long L = (long)i * G + c; if (L >= nwg) return false;
        int wgid = (int)L; { const int q = nwg / NXCD, r = nwg % NXCD, xcd = wgid % NXCD, off = wgid / NXCD; wgid = (xcd < r ? xcd * (q + 1) : r * (q + 1) + (xcd - r) * q) + off; }
        const int nig = WGM * nN, gid = wgid / nig, fm = gid * WGM, gsz = (nM - fm) < WGM ? (nM - fm) : WGM;
        u.pm = fm + ((wgid % nig) % gsz); u.pn = (wgid % nig) / gsz; return true;
    }
    __device__ __forceinline__ void a_ready(const Unit&) const {}
    __device__ __forceinline__ void done(const Unit&) const {}
};

__device__ __forceinline__ unsigned cvt_pk_bf16(float lo, float hi) { unsigned r; asm volatile("v_cvt_pk_bf16_f32 %0, %1, %2" : "=v"(r) : "v"(lo), "v"(hi)); return r; }
typedef float f32x2 __attribute__((ext_vector_type(2)));
__device__ __forceinline__ float bf_lo(unsigned w) { return __builtin_bit_cast(float, w << 16); }
__device__ __forceinline__ float bf_hi(unsigned w) { return __builtin_bit_cast(float, w & 0xffff0000u); }
template <class T> __device__ __forceinline__ void st_stream(T* p, const T v) { if (EPI_NT) __builtin_nontemporal_store(v, p); else *p = v; }
struct EpiStoreBf16 {
    static constexpr bool PERM = true, AFTER_DRAIN = false;
    bf16_t* O; int ldc;
    __device__ __forceinline__ void operator()(const f32x4 (&acc)[2][2][4][2], const Unit& u, int wr, int wc, int fr, int fq) const {
        const int row0 = u.pm * BM + wr * 64 + fr, col0 = u.pn * BM + wc * 32 + 8 * fq;
#pragma unroll
        for (int ai = 0; ai < 2; ++ai)
#pragma unroll
            for (int m = 0; m < 4; ++m) { bf16_t* rowp = O + (size_t)(row0 + ai * HALF + m * 16) * ldc + col0;
#pragma unroll
                for (int bj = 0; bj < 2; ++bj) { const f32x4 v0 = acc[ai][bj][m][0], v1 = acc[ai][bj][m][1];
                    u32x4 w; w.x = cvt_pk_bf16(v0[0], v0[1]); w.y = cvt_pk_bf16(v0[2], v0[3]); w.z = cvt_pk_bf16(v1[0], v1[1]); w.w = cvt_pk_bf16(v1[2], v1[3]);
                    *(u32x4*)(rowp + bj * HALF) = w; } }
    }
};
struct EpiRelu2 {
    static constexpr bool PERM = true, AFTER_DRAIN = false;
    bf16_t* O; int ldc;
    __device__ __forceinline__ void operator()(const f32x4 (&acc)[2][2][4][2], const Unit& u, int wr, int wc, int fr, int fq) const {
        const int row0 = u.pm * BM + wr * 64 + fr, col0 = u.pn * BM + wc * 32 + 8 * fq;
#pragma unroll
        for (int ai = 0; ai < 2; ++ai)
#pragma unroll
            for (int m = 0; m < 4; ++m) { bf16_t* rowp = O + (size_t)(row0 + ai * HALF + m * 16) * ldc + col0;
#pragma unroll
                for (int bj = 0; bj < 2; ++bj) { f32x4 v0 = acc[ai][bj][m][0], v1 = acc[ai][bj][m][1];
#pragma unroll
                    for (int j = 0; j < 4; ++j) { const float a = fmaxf(v0[j], 0.f), b = fmaxf(v1[j], 0.f); v0[j] = a * a; v1[j] = b * b; }
                    u32x4 w; w.x = cvt_pk_bf16(v0[0], v0[1]); w.y = cvt_pk_bf16(v0[2], v0[3]); w.z = cvt_pk_bf16(v1[0], v1[1]); w.w = cvt_pk_bf16(v1[2], v1[3]);
                    *(u32x4*)(rowp + bj * HALF) = w; } }
    }
};
__device__ __forceinline__ void atomic_add_f32_dev(float* p, float v) { asm volatile("global_atomic_add_f32 %0, %1, off sc1" :: "v"(p), "v"(v) : "memory"); }
template <bool ATOMIC = false> struct EpiResT {
    static constexpr bool PERM = true, AFTER_DRAIN = false;
    const float* xin; float* xout; const float* gate; int row_base;
    __device__ __forceinline__ void operator()(const f32x4 (&acc)[2][2][4][2], const Unit& u, int wr, int wc, int fr, int fq) const {
        const int row0 = row_base + u.pm * BM + wr * 64 + fr, col0 = u.pn * BM + wc * 32 + 8 * fq;
        const int mrow = row0 < 32768 ? (row0 >> 11) : 16;
        const float* gp = gate + (size_t)mrow * 12288 + col0;
        f32x4 gv[2][2];
#pragma unroll
        for (int bj = 0; bj < 2; ++bj)
#pragma unroll
            for (int n = 0; n < 2; ++n) gv[bj][n] = *(const f32x4*)(gp + bj * HALF + n * 4);
#pragma unroll
        for (int ai = 0; ai < 2; ++ai) {
            f32x4 xv[4][2][2];
#pragma unroll
            for (int m = 0; m < 4; ++m) { const size_t off = (size_t)(row0 + ai * HALF + m * 16) * 2048 + col0;
#pragma unroll
                for (int bj = 0; bj < 2; ++bj)
#pragma unroll
                    for (int n = 0; n < 2; ++n) xv[m][bj][n] = *(const f32x4*)(xin + off + bj * HALF + n * 4); }
#pragma unroll
            for (int m = 0; m < 4; ++m) { const size_t off = (size_t)(row0 + ai * HALF + m * 16) * 2048 + col0;
#pragma unroll
                for (int bj = 0; bj < 2; ++bj)
#pragma unroll
                    for (int n = 0; n < 2; ++n) *(f32x4*)(xout + off + bj * HALF + n * 4) = xv[m][bj][n] + gv[bj][n] * acc[ai][bj][m][n]; }
            asm volatile("" ::: "memory");
        }
    }
};
typedef EpiResT<false> EpiRes;
__device__ __forceinline__ float sigm(float x) { return __builtin_amdgcn_rcpf(1.f + __expf(-x)); }
struct EpiGlu {
    static constexpr bool PERM = true, AFTER_DRAIN = false;
    const bf16_t* A5; bf16_t* Y; int ldy; const float* bias;
    __device__ __forceinline__ void operator()(const f32x4 (&acc)[2][2][4][2], const Unit& u, int wr, int wc, int fr, int fq) const {
        const int row0 = u.pm * BM + wr * 64 + fr, col0 = u.pn * BM + wc * 32 + 8 * fq;
        f32x4 bv[2][2];
#pragma unroll
        for (int bj = 0; bj < 2; ++bj)
#pragma unroll
            for (int n = 0; n < 2; ++n) bv[bj][n] = *(const f32x4*)(bias + col0 + bj * HALF + 4 * n);
#pragma unroll
        for (int ai = 0; ai < 2; ++ai)
#pragma unroll
            for (int m = 0; m < 4; ++m) { const int row = row0 + ai * HALF + m * 16;
#pragma unroll
                for (int bj = 0; bj < 2; ++bj) { const u32x4 aw = *(const u32x4*)(A5 + (size_t)row * 512 + col0 + bj * HALF);
                    const f32x4 v0 = acc[ai][bj][m][0] + bv[bj][0], v1 = acc[ai][bj][m][1] + bv[bj][1];
                    const float a0 = bf_lo(aw.x), a1 = bf_hi(aw.x), a2 = bf_lo(aw.y), a3 = bf_hi(aw.y), a4 = bf_lo(aw.z), a5 = bf_hi(aw.z), a6 = bf_lo(aw.w), a7 = bf_hi(aw.w);
                    u32x4 w; w.x = cvt_pk_bf16(a0 * sigm(v0[0]), a1 * sigm(v0[1])); w.y = cvt_pk_bf16(a2 * sigm(v0[2]), a3 * sigm(v0[3]));
                    w.z = cvt_pk_bf16(a4 * sigm(v1[0]), a5 * sigm(v1[1])); w.w = cvt_pk_bf16(a6 * sigm(v1[2]), a7 * sigm(v1[3]));
                    *(u32x4*)(Y + (size_t)row * ldy + col0 + bj * HALF) = w; } }
    }
};
struct EpiLru {
    static constexpr bool PERM = true, AFTER_DRAIN = false;
    const bf16_t* XS; bf16_t* LOGA; bf16_t* GB; const float* cst;
    __device__ __forceinline__ void operator()(const f32x4 (&acc)[2][2][4][2], const Unit& u, int wr, int wc, int fr, int fq) const {
        const int row0 = u.pm * BM + wr * 64 + fr, d = u.pn >> 2, nb = u.pn & 3, ch0 = nb * 128 + wc * 32 + 8 * fq;
        const float* cp = cst + d * 512 + ch0;
#pragma unroll
        for (int ai = 0; ai < 2; ++ai)
#pragma unroll
            for (int m = 0; m < 4; ++m) { const int row = row0 + ai * HALF + m * 16;
                const u32x4 xw = *(const u32x4*)(XS + (size_t)row * 512 + ch0);
                const float xs[8] = {bf_lo(xw.x), bf_hi(xw.x), bf_lo(xw.y), bf_hi(xw.y), bf_lo(xw.z), bf_hi(xw.z), bf_lo(xw.w), bf_hi(xw.w)};
#pragma unroll
                for (int n = 0; n < 2; ++n) { const f32x4 bav = *(const f32x4*)(cp + 4 * n), bxv = *(const f32x4*)(cp + 1024 + 4 * n), spv = *(const f32x4*)(cp + 2048 + 4 * n);
                    float la[4], gb[4];
#pragma unroll
                    for (int i = 0; i < 4; ++i) { const float r = sigm(acc[ai][0][m][n][i] + bav[i]), ig = sigm(acc[ai][1][m][n][i] + bxv[i]); const float l = -8.f * r * spv[i];
                        la[i] = l; const float x2 = 2.f * l;
                        const float em = -x2 * (1.f + 0.5f * x2 * (1.f + (1.f / 3.f) * x2 * (1.f + 0.25f * x2 * (1.f + 0.2f * x2 * (1.f + (1.f / 6.f) * x2)))));
                        gb[i] = __builtin_amdgcn_sqrtf(fmaxf(x2 > -0.25f ? em : 1.f - __expf(x2), 0.f)) * (ig * xs[4 * n + i]); }
                    typedef unsigned u32x2 __attribute__((ext_vector_type(2)));
                    u32x2 w1, w2; w1.x = cvt_pk_bf16(la[0], la[1]); w1.y = cvt_pk_bf16(la[2], la[3]); w2.x = cvt_pk_bf16(gb[0], gb[1]); w2.y = cvt_pk_bf16(gb[2], gb[3]);
                    *(u32x2*)(LOGA + (size_t)row * 1024 + d * 512 + ch0 + 4 * n) = w1; *(u32x2*)(GB + (size_t)row * 1024 + d * 512 + ch0 + 4 * n) = w2; }
                asm volatile("" ::: "memory"); }
    }
};
struct EpiNull {
    static constexpr bool PERM = false, AFTER_DRAIN = false;
    __device__ __forceinline__ void operator()(const f32x4 (&acc)[2][2][4][2], const Unit& u, int wr, int wc, int fr, int fq) const {
#pragma unroll
        for (int ai = 0; ai < 2; ++ai)
#pragma unroll
            for (int bj = 0; bj < 2; ++bj)
#pragma unroll
                for (int m = 0; m < 4; ++m)
#pragma unroll
                    for (int n = 0; n < 2; ++n) asm volatile("" :: "v"(acc[ai][bj][m][n]));
    }
};

template <bool XIN_F32> struct EpiResNT {
    static constexpr bool PERM = true, AFTER_DRAIN = false;
    const void* xin; const void* xin_ctx; bf16_t* xout; const float* gate; int row_base;
    bf16_t* H; const float* nw; const float* nscale; float* SSP;
    __device__ __forceinline__ void operator()(const f32x4 (&acc)[2][2][4][2], const Unit& u, int wr, int wc, int fr, int fq) const {
        const int row0 = row_base + u.pm * BM + wr * 64 + fr, col0 = u.pn * BM + wc * 32 + 8 * fq, lane = fq * 16 + fr;
        const int mrow = row0 < 32768 ? (row0 >> 11) : 16;
        const float* gp = gate + (size_t)mrow * 12288 + col0; const float* sp = nscale + (size_t)mrow * 12288 + col0; const void* xb = row0 < 32768 ? xin : xin_ctx;
        f32x4 gv[2][2], hs[2][2];
#pragma unroll
        for (int bj = 0; bj < 2; ++bj)
#pragma unroll
            for (int n = 0; n < 2; ++n) { gv[bj][n] = *(const f32x4*)(gp + bj * HALF + n * 4); hs[bj][n] = *(const f32x4*)(nw + col0 + bj * HALF + n * 4) * (*(const f32x4*)(sp + bj * HALF + n * 4) + 1.f); }
        constexpr int NB_ = XIN_F32 ? 4 : 2, MB_ = XIN_F32 ? 2 : 4;
#pragma unroll
        for (int am = 0; am < NB_; ++am) {
            const int ai = XIN_F32 ? (am >> 1) : am, mb = XIN_F32 ? 2 * (am & 1) : 0;
            f32x4 xv[XIN_F32 ? 2 : 1][2][2]; u32x4 xw[XIN_F32 ? 1 : 4][2];
#pragma unroll
            for (int mm = 0; mm < MB_; ++mm) { const int rowl = row0 + ai * HALF + (mb + mm) * 16; const size_t off = (size_t)rowl * 2048 + col0;
#pragma unroll
                for (int bj = 0; bj < 2; ++bj) {
                    if constexpr (XIN_F32) {
#pragma unroll
                        for (int n = 0; n < 2; ++n) xv[mm][bj][n] = *(const f32x4*)((const float*)xb + off + bj * HALF + n * 4); }
                    else xw[mm][bj] = *(const u32x4*)((const bf16_t*)xb + blk_off(rowl, col0, 8) + bj * HALF); } }
#pragma unroll
            for (int mm = 0; mm < MB_; ++mm) { const int m = mb + mm; const int row = row0 + ai * HALF + m * 16; const size_t off = blk_off(row, col0, 8); float ss = 0.f;
#pragma unroll
                for (int bj = 0; bj < 2; ++bj) { u32x4 w, xo;
#pragma unroll
                    for (int n = 0; n < 2; ++n) { f32x4 xi;
                        if constexpr (XIN_F32) xi = xv[mm][bj][n]; else xi = (f32x4){bf_lo(xw[mm][bj][2 * n]), bf_hi(xw[mm][bj][2 * n]), bf_lo(xw[mm][bj][2 * n + 1]), bf_hi(xw[mm][bj][2 * n + 1])};
                        const f32x4 xn = xi + gv[bj][n] * acc[ai][bj][m][n];
                        xo[2 * n] = cvt_pk_bf16(xn[0], xn[1]); xo[2 * n + 1] = cvt_pk_bf16(xn[2], xn[3]);
                        ss += (xn[0] * xn[0] + xn[1] * xn[1]) + (xn[2] * xn[2] + xn[3] * xn[3]);
                        const f32x4 hv = xn * hs[bj][n]; w[2 * n] = cvt_pk_bf16(hv[0], hv[1]); w[2 * n + 1] = cvt_pk_bf16(hv[2], hv[3]); }
                    st_stream((u32x4*)(xout + off + bj * HALF), xo);
                    st_stream((u32x4*)(H + off + bj * HALF), w); }
                ss += __builtin_bit_cast(float, __builtin_amdgcn_ds_bpermute((lane ^ 16) << 2, __builtin_bit_cast(int, ss)));
                ss += __builtin_bit_cast(float, __builtin_amdgcn_ds_bpermute((lane ^ 32) << 2, __builtin_bit_cast(int, ss)));
                if (fq == 0) SSP[(size_t)row * 32 + u.pn * 4 + wc] = ss; }
            asm volatile("" ::: "memory");
        }
    }
};
typedef EpiResNT<true> EpiResNF; typedef EpiResNT<false> EpiResN;
struct EpiResOut {
    static constexpr bool PERM = true, AFTER_DRAIN = false;
    const bf16_t* xin; float* xout; const float* gate; int row_base;
    __device__ __forceinline__ void operator()(const f32x4 (&acc)[2][2][4][2], const Unit& u, int wr, int wc, int fr, int fq) const {
        const int row0 = row_base + u.pm * BM + wr * 64 + fr, col0 = u.pn * BM + wc * 32 + 8 * fq;
        const int mrow = row0 < 32768 ? (row0 >> 11) : 16;
        const float* gp = gate + (size_t)mrow * 12288 + col0;
        f32x4 gv[2][2];
#pragma unroll
        for (int bj = 0; bj < 2; ++bj)
#pragma unroll
            for (int n = 0; n < 2; ++n) gv[bj][n] = *(const f32x4*)(gp + bj * HALF + n * 4);
#pragma unroll
        for (int ai = 0; ai < 2; ++ai) {
            u32x4 xw[4][2];
#pragma unroll
            for (int m = 0; m < 4; ++m) { const size_t off = blk_off(row0 + ai * HALF + m * 16, col0, 8);
#pragma unroll
                for (int bj = 0; bj < 2; ++bj) xw[m][bj] = *(const u32x4*)(xin + off + bj * HALF); }
#pragma unroll
            for (int m = 0; m < 4; ++m) { const size_t off = (size_t)(row0 + ai * HALF + m * 16) * 2048 + col0;
#pragma unroll
                for (int bj = 0; bj < 2; ++bj)
#pragma unroll
                    for (int n = 0; n < 2; ++n) { const f32x4 xi = (f32x4){bf_lo(xw[m][bj][2 * n]), bf_hi(xw[m][bj][2 * n]), bf_lo(xw[m][bj][2 * n + 1]), bf_hi(xw[m][bj][2 * n + 1])};
                        *(f32x4*)(xout + off + bj * HALF + n * 4) = xi + gv[bj][n] * acc[ai][bj][m][n]; } }
            asm volatile("" ::: "memory");
        }
    }
};
struct EpiStoreN {
    static constexpr bool PERM = true, AFTER_DRAIN = false;
    bf16_t* O; int ldc; const float* rstd; const float* shw; int ldshw;
    __device__ __forceinline__ void operator()(const f32x4 (&acc)[2][2][4][2], const Unit& u, int wr, int wc, int fr, int fq) const {
        const int row0 = u.pm * BM + wr * 64 + fr, col0 = u.pn * BM + wc * 32 + 8 * fq;
        const int mrow = row0 < 32768 ? (row0 >> 11) : 16;
        f32x4 sv[2][2];
#pragma unroll
        for (int bj = 0; bj < 2; ++bj)
#pragma unroll
            for (int n = 0; n < 2; ++n) sv[bj][n] = *(const f32x4*)(shw + (size_t)mrow * ldshw + col0 + bj * HALF + 4 * n);
#pragma unroll
        for (int ai = 0; ai < 2; ++ai)
#pragma unroll
            for (int m = 0; m < 4; ++m) { const int row = row0 + ai * HALF + m * 16; const float rs = rstd[row]; bf16_t* rowp = O + (size_t)row * ldc + col0;
#pragma unroll
                for (int bj = 0; bj < 2; ++bj) { const f32x4 v0 = acc[ai][bj][m][0] * rs + sv[bj][0], v1 = acc[ai][bj][m][1] * rs + sv[bj][1];
                    u32x4 w; w.x = cvt_pk_bf16(v0[0], v0[1]); w.y = cvt_pk_bf16(v0[2], v0[3]); w.z = cvt_pk_bf16(v1[0], v1[1]); w.w = cvt_pk_bf16(v1[2], v1[3]);
                    st_stream((u32x4*)(rowp + bj * HALF), w); } }
    }
};
struct EpiRelu2N {
    static constexpr bool PERM = true, AFTER_DRAIN = false;
    bf16_t* O; int ldc; const float* rstd; const float* shw; int ldshw; int row_base;
    __device__ __forceinline__ void operator()(const f32x4 (&acc)[2][2][4][2], const Unit& u, int wr, int wc, int fr, int fq) const {
        const int row0 = u.pm * BM + wr * 64 + fr, col0 = u.pn * BM + wc * 32 + 8 * fq, grow0 = row_base + row0;
        const int mrow = grow0 < 32768 ? (grow0 >> 11) : 16;
        f32x4 sv[2][2];
#pragma unroll
        for (int bj = 0; bj < 2; ++bj)
#pragma unroll
            for (int n = 0; n < 2; ++n) sv[bj][n] = *(const f32x4*)(shw + (size_t)mrow * ldshw + col0 + bj * HALF + 4 * n);
#pragma unroll
        for (int ai = 0; ai < 2; ++ai)
#pragma unroll
            for (int m = 0; m < 4; ++m) { const int row = row0 + ai * HALF + m * 16; const float rs = rstd[row_base + row]; bf16_t* rowp = O + blk_off(row, col0, ldc >> 8);
#pragma unroll
                for (int bj = 0; bj < 2; ++bj) { f32x4 v0 = acc[ai][bj][m][0] * rs + sv[bj][0], v1 = acc[ai][bj][m][1] * rs + sv[bj][1];
#pragma unroll
                    for (int j = 0; j < 4; ++j) { const float a = fmaxf(v0[j], 0.f), b = fmaxf(v1[j], 0.f); v0[j] = a * a; v1[j] = b * b; }
                    u32x4 w; w.x = cvt_pk_bf16(v0[0], v0[1]); w.y = cvt_pk_bf16(v0[2], v0[3]); w.z = cvt_pk_bf16(v1[0], v1[1]); w.w = cvt_pk_bf16(v1[2], v1[3]);
                    *(u32x4*)(rowp + bj * HALF) = w; } }
    }
};

struct EpiPart {
    static constexpr bool PERM = false, AFTER_DRAIN = false, VIRT = true;
    float* P; int ntile; int rows;
    __device__ __forceinline__ void operator()(const f32x4 (&acc)[2][2][4][2], const Unit& u, int wr, int wc, int fr, int fq) const {
        const int slice = u.pn / ntile, pn = u.pn % ntile, ld = 256 * ntile;
        const int row0 = u.pm * BM + wr * 64 + fr, col0 = pn * BM + wc * 32 + 4 * fq; float* base = P + (size_t)slice * rows * ld;
#pragma unroll
        for (int ai = 0; ai < 2; ++ai)
#pragma unroll
            for (int m = 0; m < 4; ++m) { float* rowp = base + (size_t)(row0 + ai * HALF + m * 16) * ld + col0;
#pragma unroll
                for (int bj = 0; bj < 2; ++bj)
#pragma unroll
                    for (int n = 0; n < 2; ++n) *(f32x4*)(rowp + bj * HALF + n * 16) = acc[ai][bj][m][n]; }
    }
};
template <class T, class = void> struct epi_virt { static constexpr bool value = false; };
template <class T> struct epi_virt<T, decltype((void)T::VIRT)> { static constexpr bool value = true; };
template <class Epi, class Sched, bool ALIGN_EPI = false, bool SP2 = false, int NSP = 0>
__device__ __forceinline__ void gemm_phase(PG8_LAS unsigned char* lds, const Gemm g, const Sched& S, const Epi& E, const int tid_in) {
    const int tid = tid_in,
    wid = __builtin_amdgcn_readfirstlane(tid >> 6), lane = tid & 63, wr = wid >> 2, wc = wid & 3, fr = lane & 15, fq = lane >> 4;
    const int K = g.K, nt = K / BK, LD = g.ld ? g.ld : g.K;
    const bool ablk = BLK_LAYOUT && g.ablk; const int LDA = ablk ? 256 : LD;
    unsigned voffA[2], voffB[2];
#pragma unroll
    for (int i = 0; i < 2; ++i) { int R, C; stage_rc(tid * 16 + i * 8192, R, C); const int Rb = Epi::PERM ? ((R & ~31) + perm32(R & 31)) : R;
        voffA[i] = (unsigned)(R * LDA + C) * 2u; voffB[i] = (unsigned)(Rb * LD + C) * 2u; }
    const size_t kstep = (size_t)(BK * 2);
    const size_t hstep = (size_t)HALF * LD * 2;
    const size_t hstepA = (size_t)HALF * LDA * 2;
#define PG8_KOFF(t) (ablk ? (((size_t)((t) >> 2) << 17) + (size_t)(((t) & 3) << 7)) : (size_t)(t) * kstep)
    const size_t tstep = 2 * hstep;
    const unsigned ldsw = (unsigned)wid * 1024u;
    const int aoff = lds_byte(wr * 64 + fr, fq * 8), boff = lds_byte(wc * 32 + fr, fq * 8);
#define PG8_SA(b, h) (((b) * 2 + (h)) * HTB)
#define PG8_SB(b, h) ((4 + (b) * 2 + (h)) * HTB)
#define PG8_STAGE(bufoff, gbase, voff) do { _Pragma("unroll") for (int _i = 0; _i < 2; ++_i) \
        __builtin_amdgcn_global_load_lds((const unsigned*)((const char*)(gbase) + (voff)[_i]), (PG8_LAS unsigned*)(lds + (bufoff) + ldsw + _i * 8192), 16, 0, 0); } while (0)
#define PG8_LDA(dst, b, h) do { _Pragma("unroll") for (int m = 0; m < 4; ++m) _Pragma("unroll") for (int k = 0; k < 2; ++k) dst[m][k] = *(const PG8_LAS bf16x8*)(lds + PG8_SA(b, h) + aoff + m * 2048 + k * 1024); } while (0)
#define PG8_LDB(dst, b, h) do { _Pragma("unroll") for (int n = 0; n < 2; ++n) _Pragma("unroll") for (int k = 0; k < 2; ++k) dst[n][k] = *(const PG8_LAS bf16x8*)(lds + PG8_SB(b, h) + boff + n * 2048 + k * 1024); } while (0)
#define PG8_MMA(ai, bj, At, Bt) do { __builtin_amdgcn_s_setprio(1); _Pragma("unroll") for (int m = 0; m < 4; ++m) _Pragma("unroll") for (int n = 0; n < 2; ++n) _Pragma("unroll") for (int k = 0; k < 2; ++k) \
        acc[ai][bj][m][n] = __builtin_amdgcn_mfma_f32_16x16x32_bf16(Bt[n][k], At[m][k], acc[ai][bj][m][n], 0, 0, 0); __builtin_amdgcn_s_setprio(0); } while (0)
#define PG8_WAIT_V(n) asm volatile("s_waitcnt vmcnt(" #n ")" ::: "memory")
#define PG8_WAIT_L(n) asm volatile("s_waitcnt lgkmcnt(" #n ")" ::: "memory")
#define PG8_BAR __builtin_amdgcn_s_barrier()
#define PG8_SCHED __builtin_amdgcn_sched_barrier(0)
    Unit cur, nxt; int ui = 0;
    if (!S.next(0, cur)) return;
    f32x4 acc[2][2][4][2];
    float zf = 0.f; asm volatile("" : "+v"(zf));
    const f32x4 zero4 = (f32x4){zf, zf, zf, zf};
#pragma unroll
    for (int a = 0; a < 2; ++a)
#pragma unroll
        for (int b = 0; b < 2; ++b)
#pragma unroll
            for (int m = 0; m < 4; ++m)
#pragma unroll
                for (int n = 0; n < 2; ++n) acc[a][b][m][n] = zero4;
    bf16x8 At[4][2], B0[2][2], B1[2][2];
#define PG8_SLICE(u) (NSP > 0 ? (u).pn / NSP : (NSP < 0 ? ((u).pn & (-NSP - 1)) : 0))
#define PG8_PNR(u) (NSP > 0 ? (u).pn % NSP : (u).pn)
#define PG8_ABASE(u) ((const char*)g.A + (size_t)(u).pm * tstep + (size_t)PG8_SLICE(u) * K * (ablk ? 512 : 2))
#define PG8_BBASE(u) ((const char*)g.Bt + (size_t)PG8_PNR(u) * tstep + (size_t)PG8_SLICE(u) * K * 2)
    const char* cA = PG8_ABASE(cur); const char* cB = PG8_BBASE(cur);
    S.a_ready(cur);
    if constexpr (SP2) {
        PG8_STAGE(PG8_SB(0, 0), cB, voffB); PG8_STAGE(PG8_SB(0, 1), cB + hstep, voffB); PG8_STAGE(PG8_SA(0, 0), cA, voffA); PG8_STAGE(PG8_SA(0, 1), cA + hstepA, voffA);
        if (wr == 1) PG8_BAR;
        PG8_WAIT_V(2); PG8_BAR;
        PG8_STAGE(PG8_SB(1, 0), cB + kstep, voffB); PG8_STAGE(PG8_SA(1, 0), cA + kstep, voffA); PG8_STAGE(PG8_SB(1, 1), cB + hstep + kstep, voffB);
        PG8_WAIT_V(6); PG8_BAR;
    } else {
        PG8_STAGE(PG8_SB(0, 0), cB, voffB); PG8_STAGE(PG8_SA(0, 0), cA, voffA); PG8_STAGE(PG8_SB(0, 1), cB + hstep, voffB); PG8_STAGE(PG8_SA(0, 1), cA + hstepA, voffA);
        if (wr == 1) PG8_BAR;
        PG8_WAIT_V(4); PG8_BAR;
        PG8_STAGE(PG8_SB(1, 0), cB + kstep, voffB); PG8_STAGE(PG8_SA(1, 0), cA + kstep, voffA); PG8_STAGE(PG8_SB(1, 1), cB + hstep + kstep, voffB);
        PG8_WAIT_V(6); PG8_BAR;
    }
    for (;;) {
        const bool has_next = S.next(ui + 1, nxt);
        const char* nA = has_next ? PG8_ABASE(nxt) : cA; const char* nB = has_next ? PG8_BBASE(nxt) : cB;
        for (int t = 0; t < nt; t += 2) {
            const bool last = (t == nt - 2);
            const char* a1 = cA + PG8_KOFF(t) + kstep;
            const char* a2 = last ? nA : cA + PG8_KOFF(t + 2); const char* b2 = last ? nB : cB + (size_t)(t + 2) * kstep;
            const char* a3 = a2 + kstep; const char* b3 = b2 + kstep;
            if (last && has_next) S.a_ready(nxt);
            if constexpr (SP2) {
            PG8_LDB(B0, 0, 0); PG8_LDB(B1, 0, 1); PG8_SCHED; PG8_LDA(At, 0, 0); PG8_STAGE(PG8_SA(1, 1), a1 + hstepA, voffA);
            PG8_WAIT_V(8); PG8_WAIT_L(0); PG8_BAR; PG8_MMA(0, 0, At, B0); PG8_MMA(0, 1, At, B1); PG8_BAR; PG8_SCHED;
            PG8_LDA(At, 0, 1); PG8_STAGE(PG8_SB(0, 0), b2, voffB); PG8_STAGE(PG8_SB(0, 1), b2 + hstep, voffB); PG8_STAGE(PG8_SA(0, 0), a2, voffA);
            PG8_WAIT_V(8); PG8_WAIT_L(0); PG8_BAR; PG8_MMA(1, 0, At, B0); PG8_MMA(1, 1, At, B1); PG8_BAR; PG8_SCHED;
            PG8_LDB(B0, 1, 0); PG8_LDB(B1, 1, 1); PG8_SCHED; PG8_LDA(At, 1, 0); PG8_STAGE(PG8_SA(0, 1), a2 + hstepA, voffA);
            PG8_WAIT_V(8); PG8_WAIT_L(0); PG8_BAR; PG8_MMA(0, 0, At, B0); PG8_MMA(0, 1, At, B1); PG8_BAR; PG8_SCHED;
            PG8_LDA(At, 1, 1); PG8_STAGE(PG8_SB(1, 0), b3, voffB); PG8_STAGE(PG8_SB(1, 1), b3 + hstep, voffB); PG8_STAGE(PG8_SA(1, 0), a3, voffA);
            PG8_WAIT_V(8); PG8_WAIT_L(0); PG8_BAR; PG8_MMA(1, 0, At, B0); PG8_MMA(1, 1, At, B1); PG8_BAR; PG8_SCHED;
            } else {
            PG8_LDB(B0, 0, 0); PG8_SCHED; PG8_LDA(At, 0, 0); PG8_STAGE(PG8_SA(1, 1), a1 + hstepA, voffA);
            PG8_WAIT_L(8); PG8_BAR; PG8_WAIT_L(0); PG8_MMA(0, 0, At, B0); PG8_BAR; PG8_SCHED;
            PG8_LDB(B1, 0, 1); PG8_STAGE(PG8_SB(0, 0), b2, voffB);
            PG8_BAR; PG8_WAIT_L(0); PG8_MMA(0, 1, At, B1); PG8_BAR;
            PG8_LDA(At, 0, 1); PG8_STAGE(PG8_SA(0, 0), a2, voffA);
            PG8_BAR; PG8_WAIT_L(0); PG8_MMA(1, 0, At, B0); PG8_BAR; PG8_SCHED;
            PG8_STAGE(PG8_SB(0, 1), b2 + hstep, voffB);
            PG8_WAIT_V(6); PG8_BAR; PG8_MMA(1, 1, At, B1); PG8_BAR;
            PG8_LDB(B0, 1, 0); PG8_SCHED; PG8_LDA(At, 1, 0); PG8_STAGE(PG8_SA(0, 1), a2 + hstepA, voffA);
            PG8_WAIT_L(8); PG8_BAR; PG8_WAIT_L(0); PG8_MMA(0, 0, At, B0); PG8_BAR; PG8_SCHED;
            PG8_LDB(B1, 1, 1); PG8_STAGE(PG8_SB(1, 0), b3, voffB);
            PG8_BAR; PG8_WAIT_L(0); PG8_MMA(0, 1, At, B1); PG8_BAR;
            PG8_LDA(At, 1, 1); PG8_STAGE(PG8_SA(1, 0), a3, voffA);
            PG8_BAR; PG8_WAIT_L(0); PG8_MMA(1, 0, At, B0); PG8_BAR; PG8_SCHED;
            PG8_STAGE(PG8_SB(1, 1), b3 + hstep, voffB);
            PG8_WAIT_V(6); PG8_BAR; PG8_MMA(1, 1, At, B1); PG8_BAR;
            }
        }
        if constexpr (ALIGN_EPI) { if (wr == 0) PG8_BAR; }
        if constexpr (!Epi::AFTER_DRAIN) { if constexpr (epi_virt<Epi>::value) E(acc, cur, wr, wc, fr, fq); else { const Unit eu{cur.pm, PG8_PNR(cur)}; E(acc, eu, wr, wc, fr, fq); } S.done(cur); }
        if (!has_next) break;
#pragma unroll
        for (int a = 0; a < 2; ++a)
#pragma unroll
            for (int b = 0; b < 2; ++b)
#pragma unroll
                for (int m = 0; m < 4; ++m)
#pragma unroll
                    for (int n = 0; n < 2; ++n) acc[a][b][m][n] = zero4;
        cur = nxt; cA = nA; cB = nB; ++ui;
        if constexpr (ALIGN_EPI) { if (wr == 1) PG8_BAR; }
    }
    PG8_WAIT_V(0);
    if constexpr (!ALIGN_EPI) { if (wr == 0) PG8_BAR; }
    PG8_BAR;
    if constexpr (Epi::AFTER_DRAIN) { E.fused(acc, cur, wr, wc, fr, fq, lds, wid, lane); S.done(cur); }
#undef PG8_SLICE
#undef PG8_PNR
#undef PG8_KOFF
#undef PG8_ABASE
#undef PG8_BBASE
#undef PG8_SA
#undef PG8_SB
#undef PG8_STAGE
#undef PG8_LDA
#undef PG8_LDB
#undef PG8_MMA
#undef PG8_WAIT_V
#undef PG8_WAIT_L
#undef PG8_BAR
#undef PG8_SCHED
}
}
namespace pg8 {
struct GrpDesc { const bf16_t* A; const bf16_t* Bt; int M, N, K, ld, bdiag; };
struct GUnit { int pm, pn, grp; };
__device__ __forceinline__ bool static_map(long L, int nM, int nN, Unit& u) {
    const int nwg = nM * nN; if (L >= nwg) return false;
    int wgid = (int)L; { const int q = nwg / NXCD, r = nwg % NXCD, xcd = wgid % NXCD, off = wgid / NXCD; wgid = (xcd < r ? xcd * (q + 1) : r * (q + 1) + (xcd - r) * q) + off; }
    const int nig = WGM * nN, gid = wgid / nig, fm = gid * WGM, gsz = (nM - fm) < WGM ? (nM - fm) : WGM;
    u.pm = fm + ((wgid % nig) % gsz); u.pn = (wgid % nig) / gsz; return true;
}
template <class E0, class E1, class E2>
__device__ __forceinline__ void gemm_group3(PG8_LAS unsigned char* lds, const GrpDesc g0, const GrpDesc g1, const GrpDesc g2, const E0& e0, const E1& e1, const E2& e2, const int Gn, const int c, const int tid_in) {
    static_assert(E0::PERM && E1::PERM && E2::PERM, "gemm_group3: the three epilogues must share the permuted weight staging");
    const int tid = tid_in, wid = __builtin_amdgcn_readfirstlane(tid >> 6), lane = tid & 63, wr = wid >> 2, wc = wid & 3, fr = lane & 15, fq = lane >> 4;
    const int n0 = (g0.M / BM) * (g0.N / BM), n1 = (g1.M / BM) * (g1.N / BM), n2 = (g2.M / BM) * (g2.N / BM);
    int sR[2], sRb[2], sC[2];
#pragma unroll
    for (int i = 0; i < 2; ++i) { int R, C; stage_rc(tid * 16 + i * 8192, R, C); sR[i] = R; sRb[i] = (R & ~31) + perm32(R & 31); sC[i] = C; }
    const size_t kstep = (size_t)(BK * 2);
    const unsigned ldsw = (unsigned)wid * 1024u;
    const int aoff = lds_byte(wr * 64 + fr, fq * 8), boff = lds_byte(wc * 32 + fr, fq * 8);
#define PG8_SA(b, h) (((b) * 2 + (h)) * HTB)
#define PG8_SB(b, h) ((4 + (b) * 2 + (h)) * HTB)
#define PG8_STAGE(bufoff, gbase, voff) do { _Pragma("unroll") for (int _i = 0; _i < 2; ++_i) \
        __builtin_amdgcn_global_load_lds((const unsigned*)((const char*)(gbase) + (voff)[_i]), (PG8_LAS unsigned*)(lds + (bufoff) + ldsw + _i * 8192), 16, 0, 0); } while (0)
#define PG8_LDA(dst, b, h) do { _Pragma("unroll") for (int m = 0; m < 4; ++m) _Pragma("unroll") for (int k = 0; k < 2; ++k) dst[m][k] = *(const PG8_LAS bf16x8*)(lds + PG8_SA(b, h) + aoff + m * 2048 + k * 1024); } while (0)
#define PG8_LDB(dst, b, h) do { _Pragma("unroll") for (int n = 0; n < 2; ++n) _Pragma("unroll") for (int k = 0; k < 2; ++k) dst[n][k] = *(const PG8_LAS bf16x8*)(lds + PG8_SB(b, h) + boff + n * 2048 + k * 1024); } while (0)
#define PG8_MMA(ai, bj, At, Bt) do { __builtin_amdgcn_s_setprio(1); _Pragma("unroll") for (int m = 0; m < 4; ++m) _Pragma("unroll") for (int n = 0; n < 2; ++n) _Pragma("unroll") for (int k = 0; k < 2; ++k) \
        acc[ai][bj][m][n] = __builtin_amdgcn_mfma_f32_16x16x32_bf16(Bt[n][k], At[m][k], acc[ai][bj][m][n], 0, 0, 0); __builtin_amdgcn_s_setprio(0); } while (0)
#define PG8_WAIT_V(n) asm volatile("s_waitcnt vmcnt(" #n ")" ::: "memory")
#define PG8_WAIT_L(n) asm volatile("s_waitcnt lgkmcnt(" #n ")" ::: "memory")
#define PG8_BAR __builtin_amdgcn_s_barrier()
#define PG8_SCHED __builtin_amdgcn_sched_barrier(0)
#define PG8_GETUNIT(L, u, ok) do { Unit t_; const long L_ = (L); ok = true; \
        if (L_ < n0) { static_map(L_, g0.M / BM, g0.N / BM, t_); u.grp = 0; } else if (L_ < n0 + n1) { static_map(L_ - n0, g1.M / BM, g1.N / BM, t_); u.grp = 1; } \
        else if (L_ < n0 + n1 + n2) { static_map(L_ - n0 - n1, g2.M / BM, g2.N / BM, t_); u.grp = 2; } else { ok = false; t_.pm = 0; t_.pn = 0; u.grp = 0; } u.pm = t_.pm; u.pn = t_.pn; } while (0)
#define PG8_GSEL(u, f) ((u).grp == 0 ? g0.f : ((u).grp == 1 ? g1.f : g2.f))
#define PG8_SETUNIT(u, pA, pB, ntv, ldv) do { const int ld_ = PG8_GSEL(u, ld), K_ = PG8_GSEL(u, K), bd_ = PG8_GSEL(u, bdiag); const int sl_ = bd_ ? ((u).pn & (bd_ - 1)) : 0; \
        pA = (const char*)PG8_GSEL(u, A) + (size_t)(u).pm * (size_t)(2 * HALF) * ld_ * 2 + (size_t)sl_ * K_ * 2; pB = (const char*)PG8_GSEL(u, Bt) + (size_t)(u).pn * (size_t)(2 * HALF) * ld_ * 2 + (size_t)sl_ * K_ * 2; ntv = K_ / BK; ldv = ld_; } while (0)
#define PG8_SETVOFF(vA, vB, ldv) do { _Pragma("unroll") for (int i = 0; i < 2; ++i) { vA[i] = (unsigned)(sR[i] * (ldv) + sC[i]) * 2u; vB[i] = (unsigned)(sRb[i] * (ldv) + sC[i]) * 2u; } } while (0)
    GUnit cur, nxt; int ui = 0; bool ok;
    PG8_GETUNIT((long)c, cur, ok);
    if (!ok) return;
    f32x4 acc[2][2][4][2];
    float zf = 0.f; asm volatile("" : "+v"(zf));
    const f32x4 zero4 = (f32x4){zf, zf, zf, zf};
#pragma unroll
    for (int a = 0; a < 2; ++a)
#pragma unroll
        for (int b = 0; b < 2; ++b)
#pragma unroll
            for (int m = 0; m < 4; ++m)
#pragma unroll
                for (int n = 0; n < 2; ++n) acc[a][b][m][n] = zero4;
    bf16x8 At[4][2], B0[2][2], B1[2][2];
    const char* cA; const char* cB; int nt, ldc_; PG8_SETUNIT(cur, cA, cB, nt, ldc_);
    unsigned voffA[2], voffB[2]; PG8_SETVOFF(voffA, voffB, ldc_);
    size_t hstep = (size_t)HALF * ldc_ * 2;
    PG8_STAGE(PG8_SB(0, 0), cB, voffB); PG8_STAGE(PG8_SB(0, 1), cB + hstep, voffB); PG8_STAGE(PG8_SA(0, 0), cA, voffA); PG8_STAGE(PG8_SA(0, 1), cA + hstep, voffA);
    if (wr == 1) PG8_BAR;
    PG8_WAIT_V(2); PG8_BAR;
    PG8_STAGE(PG8_SB(1, 0), cB + kstep, voffB); PG8_STAGE(PG8_SA(1, 0), cA + kstep, voffA); PG8_STAGE(PG8_SB(1, 1), cB + hstep + kstep, voffB);
    PG8_WAIT_V(6); PG8_BAR;
    for (;;) {
        bool has_next; PG8_GETUNIT((long)(ui + 1) * Gn + c, nxt, has_next);
        const char* nA = cA; const char* nB = cB; int ntn = nt, ldn = ldc_;
        if (has_next) PG8_SETUNIT(nxt, nA, nB, ntn, ldn);
        unsigned voffAn[2], voffBn[2]; PG8_SETVOFF(voffAn, voffBn, ldn);
        const size_t hstepn = (size_t)HALF * ldn * 2;
        for (int t = 0; t < nt; t += 2) {
            const bool last = (t == nt - 2);
            const char* a1 = cA + (size_t)(t + 1) * kstep;
            const char* a2 = last ? nA : cA + (size_t)(t + 2) * kstep; const char* b2 = last ? nB : cB + (size_t)(t + 2) * kstep;
            const char* a3 = a2 + kstep; const char* b3 = b2 + kstep;
            unsigned vA2[2], vB2[2];
#pragma unroll
            for (int i = 0; i < 2; ++i) { vA2[i] = last ? voffAn[i] : voffA[i]; vB2[i] = last ? voffBn[i] : voffB[i]; }
            const size_t h2 = last ? hstepn : hstep;
            PG8_LDB(B0, 0, 0); PG8_LDB(B1, 0, 1); PG8_SCHED; PG8_LDA(At, 0, 0); PG8_STAGE(PG8_SA(1, 1), a1 + hstep, voffA);
            PG8_WAIT_V(8); PG8_WAIT_L(0); PG8_BAR; PG8_MMA(0, 0, At, B0); PG8_MMA(0, 1, At, B1); PG8_BAR; PG8_SCHED;
            PG8_LDA(At, 0, 1); PG8_STAGE(PG8_SB(0, 0), b2, vB2); PG8_STAGE(PG8_SB(0, 1), b2 + h2, vB2); PG8_STAGE(PG8_SA(0, 0), a2, vA2);
            PG8_WAIT_V(8); PG8_WAIT_L(0); PG8_BAR; PG8_MMA(1, 0, At, B0); PG8_MMA(1, 1, At, B1); PG8_BAR; PG8_SCHED;
            PG8_LDB(B0, 1, 0); PG8_LDB(B1, 1, 1); PG8_SCHED; PG8_LDA(At, 1, 0); PG8_STAGE(PG8_SA(0, 1), a2 + h2, vA2);
            PG8_WAIT_V(8); PG8_WAIT_L(0); PG8_BAR; PG8_MMA(0, 0, At, B0); PG8_MMA(0, 1, At, B1); PG8_BAR; PG8_SCHED;
            PG8_LDA(At, 1, 1); PG8_STAGE(PG8_SB(1, 0), b3, vB2); PG8_STAGE(PG8_SB(1, 1), b3 + h2, vB2); PG8_STAGE(PG8_SA(1, 0), a3, vA2);
            PG8_WAIT_V(8); PG8_WAIT_L(0); PG8_BAR; PG8_MMA(1, 0, At, B0); PG8_MMA(1, 1, At, B1); PG8_BAR; PG8_SCHED;
        }
        if (wr == 0) PG8_BAR;
        { const Unit eu{cur.pm, cur.pn};
          if (cur.grp == 0) e0(acc, eu, wr, wc, fr, fq); else if (cur.grp == 1) e1(acc, eu, wr, wc, fr, fq); else e2(acc, eu, wr, wc, fr, fq); }
        if (!has_next) break;
#pragma unroll
        for (int a = 0; a < 2; ++a)
#pragma unroll
            for (int b = 0; b < 2; ++b)
#pragma unroll
                for (int m = 0; m < 4; ++m)
#pragma unroll
                    for (int n = 0; n < 2; ++n) acc[a][b][m][n] = zero4;
        cur = nxt; cA = nA; cB = nB; nt = ntn; ldc_ = ldn; hstep = hstepn;
#pragma unroll
        for (int i = 0; i < 2; ++i) { voffA[i] = voffAn[i]; voffB[i] = voffBn[i]; }
        ++ui;
        if (wr == 1) PG8_BAR;
    }
    PG8_WAIT_V(0);
    PG8_BAR;
#undef PG8_GETUNIT
#undef PG8_GSEL
#undef PG8_SETUNIT
#undef PG8_SETVOFF
#undef PG8_SA
#undef PG8_SB
#undef PG8_STAGE
#undef PG8_LDA
#undef PG8_LDB
#undef PG8_MMA
#undef PG8_WAIT_V
#undef PG8_WAIT_L
#undef PG8_BAR
#undef PG8_SCHED
}
}
#define XB_TMO      128
#define XB_XCNT(j)  (256  + 64 * (j))
#define XB_XSUB(j)  (1280 + 64 * (j))
#define XB_XGEN(j)  (2304 + 64 * (j))
#define XB_TOP      3328
#define XB_TOPGEN   3392
#define XCD_BAR_WORDS 3456
#define XB_SPIN_CAP (1u << 18)

__device__ __forceinline__ unsigned xb_ld(unsigned* p)              { return __hip_atomic_load(p, __ATOMIC_RELAXED, __HIP_MEMORY_SCOPE_AGENT); }
__device__ __forceinline__ unsigned xb_add(unsigned* p, unsigned v) { return __hip_atomic_fetch_add(p, v, __ATOMIC_RELAXED, __HIP_MEMORY_SCOPE_AGENT); }
__device__ __forceinline__ unsigned xb_xcc_id() { return (unsigned)__builtin_amdgcn_s_getreg((3 << 11) | 20) & 0xFu; }
#define XB_SPIN(cond, bar) do { unsigned _sp = 0; while (cond) { __builtin_amdgcn_s_sleep(1); \
    if ((++_sp & 255u) == 0u) { if (xb_ld(&(bar)[XB_TMO])) break; if (_sp > XB_SPIN_CAP) { atomicAdd(&(bar)[XB_TMO], 1u); break; } } } } while (0)

struct XcdBarrier {
    unsigned* bar; unsigned x;
    volatile LAS unsigned* st;
};

__device__ __forceinline__ XcdBarrier xcd_barrier_post(unsigned* bar, volatile LAS unsigned* st) {
    XcdBarrier b; b.bar = bar; b.x = xb_xcc_id(); b.st = st;
    if (threadIdx.x == 0) (void)xb_add(&bar[XB_XCNT(b.x)], 1u);
    return b;
}
__device__ __forceinline__ void xcd_barrier_complete(unsigned* bar, unsigned x, unsigned& nloc, unsigned& nx) {
    const unsigned G = gridDim.x * gridDim.y * gridDim.z;
    unsigned sum, cnt, mine, sp = 0u;
    for (;;) {
        sum = 0u; cnt = 0u; mine = 0u;
#pragma unroll
        for (unsigned j = 0; j < 16; ++j) { const unsigned c = xb_ld(&bar[XB_XCNT(j)]); sum += c; cnt += (c > 0u) ? 1u : 0u; mine = (j == x) ? c : mine; }
        if (sum == G) break;
        __builtin_amdgcn_s_sleep(1);
        if ((++sp & 255u) == 0u) { if (xb_ld(&bar[XB_TMO])) break; if (sp > XB_SPIN_CAP) { atomicAdd(&bar[XB_TMO], 1u); break; } }
    }
    nloc = mine > 0u ? mine : 1u; nx = cnt > 0u ? cnt : 1u;
}

__device__ __forceinline__ void xcd_barrier(const XcdBarrier& b) {
    asm volatile("s_waitcnt vmcnt(0)" ::: "memory");
    __syncthreads();
    if (threadIdx.x == 0) {
        unsigned* bar = b.bar;
        __builtin_amdgcn_s_waitcnt(0);
        unsigned nloc = b.st[0], nx = b.st[1];
        if (nloc == 0u) { xcd_barrier_complete(bar, b.x, nloc, nx); b.st[0] = nloc; b.st[1] = nx; }
        const unsigned old = xb_add(&bar[XB_XSUB(b.x)], 1u);
        const unsigned gen = old / nloc;
        if (old + 1u == (gen + 1u) * nloc) {
            __builtin_amdgcn_fence(__ATOMIC_RELEASE, "agent");
            asm volatile("s_waitcnt vmcnt(0)" ::: "memory");
            const unsigned og = xb_add(&bar[XB_TOP], 1u);
            const unsigned tg = og / nx;
            if (og + 1u == (tg + 1u) * nx) xb_add(&bar[XB_TOPGEN], 1u);
            else XB_SPIN(xb_ld(&bar[XB_TOPGEN]) == tg, bar);
            __builtin_amdgcn_fence(__ATOMIC_ACQUIRE, "agent");
            xb_add(&bar[XB_XGEN(b.x)], 1u);
            asm volatile("s_waitcnt vmcnt(0)" ::: "memory");
        } else {
            XB_SPIN(xb_ld(&bar[XB_XGEN(b.x)]) == gen, bar);
            __builtin_amdgcn_fence(__ATOMIC_ACQUIRE, "agent");
            asm volatile("s_waitcnt vmcnt(0)" ::: "memory");
        }
    }
    __syncthreads();
}
struct Args { const float* in[N_IN]; float* out; unsigned char* ws; int lo, hi; };
static_assert(sizeof(Args) == (N_IN + 2) * 8 + 8, "Args has no holes");
struct Frame {
    LAS unsigned char* lds;
    volatile LAS unsigned* MISC;
    gu32* ctl;
    int tid, lane, wave, G, bid;
    unsigned char* ws;
    const __attribute__((address_space(4))) char* kp;
    float* out;
};
#define WSP(T, off) ((T*)(F.ws + (off)))
typedef const GAS float* gcfptr_t;
#define KIN(i) ((const float*)(*(const __attribute__((address_space(4))) gcfptr_t*)(F.kp + 8 * (i))))

template <class LhsFn> __device__ __forceinline__ void skinny17_task(Frame& F, LhsFn lhs, const float* W, int N, int n0, float* out, int ldo, const float* bias) {
    LAS float* sh = (LAS float*)(F.lds + RING_OFF);
    const int lane = F.lane, bi = lane & 31, hk = lane >> 5, col = n0 + 32 * F.wave + bi, cc = min(col, N - 1);
    f32x16 acc;
#pragma unroll
    for (int e = 0; e < 16; ++e) acc[e] = 0.f;
    for (int kh = 0; kh < 2; ++kh) {
        __syncthreads();
        for (int idx = F.tid; idx < 17 * 1024; idx += NTHR) { const int b = idx >> 10, kk = idx & 1023; sh[b * 1025 + kk] = lhs(b, kh * 1024 + kk); }
        __syncthreads();
        const float* wp = W + (size_t)(kh * 1024 + hk) * N + cc; const LAS float* ap = sh + (bi < 17 ? bi : 0) * 1025 + hk;
#pragma unroll 8
        for (int ks = 0; ks < 512; ++ks) { const float bv = wp[(size_t)(2 * ks) * N]; float av = ap[2 * ks]; av = bi < 17 ? av : 0.f;
            acc = __builtin_amdgcn_mfma_f32_32x32x2f32(av, bv, acc, 0, 0, 0); }
    }
    if (col < N) { const float bz = bias ? bias[col] : 0.f;
#pragma unroll
        for (int r = 0; r < 16; ++r) { const int b = (r & 3) + 8 * (r >> 2) + 4 * hk; if (b < 17) out[(size_t)b * ldo + col] = acc[r] + bz; } }
}
__device__ __forceinline__ void p0a_prologue(Frame& F, const float* c, const float* cctx, const float* adaw, const float* adab,
                                             const float* lre, const float* lim, const float* ldt, const float* bre, const float* bim, const float* cre, const float* cim) {
    for (int t = F.bid; t < DEPTH * 48; t += F.G) { const int l = t / 48, n0 = (t % 48) * 256;
        skinny17_task(F, [&](int b, int k) { const float v = b < NB ? c[b * DM + k] : cctx[k]; return v / (1.f + __expf(-v)); },
                      adaw + (size_t)l * DM * NMOD, NMOD, n0, WSP(float, WS_MODS) + (size_t)l * 17 * NMOD, NMOD, adab + (size_t)l * NMOD); }
    __syncthreads();
    { float* RT_ = WSP(float, WS_ROPE);
      for (int i = F.bid * NTHR + F.tid; i < 1024; i += F.G * NTHR) { const int pos = i >> 4, fi = i & 15; const float inv = exp2f(-(float)fi * (13.287712379549449f / 16.f));
          float sn, cs; sincosf((float)pos * inv, &sn, &cs); RT_[2 * i] = cs; RT_[2 * i + 1] = sn; } }
    {
        float* S5A = WSP(float, WS_S5A); bf16* BB = WSP(bf16, WS_S5BB); bf16* CM = WSP(bf16, WS_S5CM);
        for (int i = F.bid * NTHR + F.tid; i < DEPTH * 2 * 32 * 64; i += F.G * NTHR) {
            const int p = i & 63, ldg = i >> 6;
            const float lr = fminf(lre[i], -1e-4f), li = lim[i], dt = __expf(ldt[ldg]);
            const float mag = expf(lr * dt), ar = mag * cosf(li * dt), ai = mag * sinf(li * dt);
            const float den = lr * lr + li * li, fr = ((ar - 1.f) * lr + ai * li) / den, fi = (ai * lr - (ar - 1.f) * li) / den;
            S5A[(size_t)i * 2] = ar; S5A[(size_t)i * 2 + 1] = ai;
            const int kre = (p & 31) + 64 * (p >> 5), kim = kre + 32;
            const int hre = 2 * (p & 31) + 64 * (p >> 5), him = hre + 1;
#pragma unroll
            for (int cc = 0; cc < 16; ++cc) { const float br = bre[(size_t)i * 16 + cc], bi = bim[(size_t)i * 16 + cc];
                BB[((size_t)ldg * 128 + kre) * 16 + cc] = (bf16)f2bf(fr * br - fi * bi); BB[((size_t)ldg * 128 + kim) * 16 + cc] = (bf16)f2bf(fr * bi + fi * br);
                CM[((size_t)ldg * 16 + cc) * 128 + hre] = (bf16)f2bf(cre[((size_t)ldg * 16 + cc) * 64 + p]); CM[((size_t)ldg * 16 + cc) * 128 + him] = (bf16)f2bf(-cim[((size_t)ldg * 16 + cc) * 64 + p]); }
        }
    }
}
__device__ __forceinline__ void p0c_shw(Frame& F, const float* win_all, const float* w1_all) {
    const float* MODS = WSP(float, WS_MODS); float* SHW = WSP(float, WS_SHW);
    for (int t = F.bid; t < DEPTH * 49; t += F.G) { const int l = t / 49, g = t % 49; const bool is1 = g >= 17; const int ish = is1 ? 3 : 0;
        const float* mp = MODS + (size_t)l * 17 * NMOD + ish * DM;
        skinny17_task(F, [&](int b, int k) { return mp[(size_t)b * NMOD + k]; },
                      is1 ? w1_all + (size_t)l * DM * DFF : win_all + (size_t)l * DM * NZ, is1 ? DFF : NZ, (is1 ? g - 17 : g) * 256,
                      SHW + (size_t)l * 17 * (LDZ + DFF) + (is1 ? LDZ : 0), LDZ + DFF, nullptr); }
    __syncthreads();
}
__device__ __forceinline__ void norm0_phase(Frame& F, const float* x, const float* ctx, const float* w, const float* mods  ) {
    bf16* H = WSP(bf16, WS_H); float* RSTD = WSP(float, WS_RSTD);
    const int gw = F.bid * NWAVES + F.wave, NGW = F.G * NWAVES, lane = F.lane;
    for (int r = gw; r < RT; r += NGW) {
        const float* xrow = r < RL ? x + (size_t)r * DM : ctx + (size_t)(r - RL) * DM; const float* sc = mods + (size_t)mod_row(r) * NMOD + 1 * DM;
        const f32x4* xr = (const f32x4*)xrow + lane; f32x4 v[8]; float s = 0.f;
#pragma unroll
        for (int j = 0; j < 8; ++j) { v[j] = xr[64 * j]; s += (v[j].x * v[j].x + v[j].y * v[j].y) + (v[j].z * v[j].z + v[j].w * v[j].w); }
        s = wave_sum(s, lane);
        if (lane == 0) RSTD[r] = rsqrtf(s * (1.f / DM) + EPS);
        v2u* o8 = (v2u*)(H + blk_off(r, 0, 8)) + lane; constexpr int JS = BLK_LAYOUT ? 16384 : 64;
#pragma unroll
        for (int j = 0; j < 8; ++j) { const int cix = 64 * j + lane; const f32x4 y = v[j] * ((const f32x4*)w)[cix] * (((const f32x4*)sc)[cix] + 1.f); v2u o; o.x = pk2(y.x, y.y); o.y = pk2(y.z, y.w); o8[JS * j] = o; }
    }
}
__device__ __forceinline__ void ctxfix_phase(Frame& F, const float* gate  , const float* w, const float* sc  ) {
    bf16* X = WSP(bf16, WS_X); const float* P = WSP(float, WS_LOGA); bf16* H = WSP(bf16, WS_H); float* RSTD = WSP(float, WS_RSTD);
    const int gw = F.bid * NWAVES + F.wave, NGW = F.G * NWAVES, lane = F.lane;
    for (int rc = gw; rc < RC; rc += NGW) { const int r = RL + rc;
        v2u* xr = (v2u*)(X + blk_off(r, 0, 8)) + lane; constexpr int JS = BLK_LAYOUT ? 16384 : 64; const f32x4* p0 = (const f32x4*)(P + (size_t)rc * DM) + lane; const f32x4* p1 = (const f32x4*)(P + (size_t)(RC + rc) * DM) + lane;
        f32x4 v[8]; float s = 0.f;
#pragma unroll
        for (int j = 0; j < 8; ++j) { const int cix = 64 * j + lane; const v2u xw = xr[JS * j]; const f32x4 xi = (f32x4){bflo(xw.x), bfhi(xw.x), bflo(xw.y), bfhi(xw.y)};
            v[j] = xi + ((const f32x4*)gate)[cix] * (p0[64 * j] + p1[64 * j]); s += (v[j].x * v[j].x + v[j].y * v[j].y) + (v[j].z * v[j].z + v[j].w * v[j].w); }
        s = wave_sum(s, lane);
        if (lane == 0) RSTD[r] = rsqrtf(s * (1.f / DM) + EPS);
        v2u* o8 = (v2u*)(H + blk_off(r, 0, 8)) + lane;
#pragma unroll
        for (int j = 0; j < 8; ++j) { const int cix = 64 * j + lane; v2u xo; xo.x = pk2(v[j].x, v[j].y); xo.y = pk2(v[j].z, v[j].w); xr[JS * j] = xo;
            const f32x4 y = v[j] * ((const f32x4*)w)[cix] * (((const f32x4*)sc)[cix] + 1.f); v2u o; o.x = pk2(y.x, y.y); o.y = pk2(y.z, y.w); o8[JS * j] = o; }
    }
}
__device__ __forceinline__ void rstd_phase(Frame& F, int nrows) {
    const float* SSP = WSP(float, WS_SSP); float* RSTD = WSP(float, WS_RSTD);
    for (int r = F.bid * NTHR + F.tid; r < nrows; r += F.G * NTHR) { const f32x4* sp = (const f32x4*)(SSP + (size_t)r * 32); float s = 0.f;
#pragma unroll
        for (int j = 0; j < 8; ++j) { const f32x4 v = sp[j]; s += (v.x + v.y) + (v.z + v.w); }
        RSTD[r] = rsqrtf(s * (1.f / DM) + EPS); }
}
__device__ __forceinline__ void transpose_item(const float* W, int K, int N, bf16* WT, int ldt, LAS float* scr, int item, int lane) {
    const int nblk = (N + 31) / 32, kb = item / nblk, nb = item % nblk, k0 = 64 * kb, n0 = 32 * nb;
    const int nr = min(n0 + (lane & 31), N - 1);
#pragma unroll 8
    for (int i = 0; i < 32; ++i) { const int kk = 2 * i + (lane >> 5); scr[kk * 33 + (lane & 31)] = W[(size_t)(k0 + kk) * N + nr]; }
    LDS_WAIT(); asm volatile("" ::: "memory");
    const int cch = lane & 7;
#pragma unroll
    for (int j = 0; j < 4; ++j) { const int n = (lane >> 3) + 8 * j; const LAS float* s = scr + (8 * cch) * 33 + n;
        v4u o; o.x = pk2(s[0 * 33], s[1 * 33]); o.y = pk2(s[2 * 33], s[3 * 33]); o.z = pk2(s[4 * 33], s[5 * 33]); o.w = pk2(s[6 * 33], s[7 * 33]);
        if (n0 + n < N) *(v4u*)(WT + (size_t)(n0 + n) * ldt + k0 + 8 * cch) = o; }
    LDS_WAIT(); asm volatile("" ::: "memory");
}
__device__ __forceinline__ void norm_row(const float* xrow, bf16* orow, const float* w, const float* shift, const float* scale, int lane) {
    const f32x4* xr = (const f32x4*)xrow + lane;
    f32x4 v[8]; float s = 0.f;
#pragma unroll
    for (int j = 0; j < 8; ++j) { v[j] = xr[64 * j]; s += (v[j].x * v[j].x + v[j].y * v[j].y) + (v[j].z * v[j].z + v[j].w * v[j].w); }
    const float rstd = rsqrtf(wave_sum(s, lane) * (1.f / DM) + EPS);
    v2u* o8 = (v2u*)orow + lane;
#pragma unroll
    for (int j = 0; j < 8; ++j) { const int cix = 64 * j + lane; const f32x4 wv = ((const f32x4*)w)[cix], sh = ((const f32x4*)shift)[cix], sc = ((const f32x4*)scale)[cix];
        const f32x4 y = v[j] * rstd * wv * (sc + 1.f) + sh; v2u o; o.x = pk2(y.x, y.y); o.y = pk2(y.z, y.w); o8[64 * j] = o; }
}
__device__ __forceinline__ void norm_phase(Frame& F, const float* X, bf16* H, const float* w, const float* mods  , int ishift, int iscale, int nrows) {
    const int gw = F.bid * NWAVES + F.wave, NGW = F.G * NWAVES;
    for (int r = gw; r < nrows; r += NGW) { const float* mp = mods + (size_t)mod_row(r) * NMOD;
        norm_row(X + (size_t)r * DM, H + (size_t)r * DM, w, mp + ishift * DM, mp + iscale * DM, F.lane); }
}
constexpr int CV_1 = 32 * 256, CV_2 = 128 * 64, CV_OUT = 32 * 64, CV_G = 8 * 16, CV_OWN = CV_1 + CV_2 + CV_OUT + CV_G, CV_IN = 32 * 131, CV_Q = 6 * 24, CV_KV = 2 * 32, CV_NEXT = CV_IN + CV_Q + CV_KV;
__device__ __forceinline__ void convert_item(Frame& F, const Args& A, int lo, int ln, int it, LAS float* scr) {
    int r = it;
    if (r < CV_OWN) { if (lo < 0) return;
        if (r < CV_1) { transpose_item(KIN(I_W1) + (size_t)lo * DM * DFF, DM, DFF, WSP(bf16, WS_W1), DM, scr, r, F.lane); return; } r -= CV_1;
        if (r < CV_2) { transpose_item(KIN(I_W2) + (size_t)lo * DFF * DM, DFF, DM, WSP(bf16, WS_W2), DFF, scr, r, F.lane); return; } r -= CV_2;
        if (r < CV_OUT) { transpose_item(KIN(I_WOUT) + (size_t)lo * DM * DM, DM, DM, WSP(bf16, WS_WOUT), DM, scr, r, F.lane); return; } r -= CV_OUT;
        transpose_item(KIN(I_S5GLUW) + (size_t)lo * 512 * 512, 512, 512, WSP(bf16, WS_WGLU), 512, scr, r, F.lane); return; }
    r -= CV_OWN; if (ln >= DEPTH) return;
    if (r < CV_IN) { transpose_item(KIN(I_WIN) + (size_t)ln * DM * NZ, DM, NZ, WSP(bf16, WS_WIN), DM, scr, r, F.lane); return; } r -= CV_IN;
    if (r < CV_Q) { transpose_item(KIN(I_WQUP) + (size_t)ln * 384 * 768, 384, 768, WSP(bf16, WS_WQUP), 384, scr, r, F.lane); return; } r -= CV_Q;
    transpose_item(KIN(I_WKVUP) + (size_t)ln * 128 * 1024, 128, 1024, WSP(bf16, WS_WKVUP), 256, scr, r, F.lane);
}
__device__ __forceinline__ void convert_misc(Frame& F, const Args& A, int ln, int t0, int nt) {
    if (ln >= DEPTH) return;
    { v4u* p = WSP(v4u, WS_WKVUP); const v4u z4 = zero_v4u(); for (int i = t0; i < 1024 * 16; i += nt) { const int n = i >> 4, c8 = i & 15; p[(size_t)n * 32 + 16 + c8] = z4; } }
    { float* cst = WSP(float, WS_LRUC); const float* ba = KIN(I_LBA) + (size_t)ln * 1024; const float* bx = KIN(I_LBX) + (size_t)ln * 1024; const float* lam = KIN(I_LLAM) + (size_t)ln * 1024;
      for (int i = t0; i < 1024; i += nt) { cst[i] = ba[i]; cst[1024 + i] = bx[i]; cst[2048 + i] = softplusf_(-lam[i]); } }
    { const float* wa = KIN(I_LWA) + (size_t)ln * 2 * 4 * 128 * 128; const float* wx = KIN(I_LWX) + (size_t)ln * 2 * 4 * 128 * 128; v4u* p = WSP(v4u, WS_WLRU);
      for (int i = t0; i < 2048 * 64; i += nt) { const int cidx = i >> 6, k8 = (i & 63) * 8; const int pn = cidx >> 8, type = (cidx >> 7) & 1, j = cidx & 127, d = pn >> 2, nb = pn & 3;
          v4u o = zero_v4u();
          if ((k8 >> 7) == nb) { const float* src = (type ? wx : wa) + ((size_t)(d * 4 + nb) * 128 + (k8 & 127)) * 128 + j;
              o.x = pk2(src[0 * 128], src[1 * 128]); o.y = pk2(src[2 * 128], src[3 * 128]); o.z = pk2(src[4 * 128], src[5 * 128]); o.w = pk2(src[6 * 128], src[7 * 128]); }
          p[i] = o; } }
}
__device__ __forceinline__ void convert_weights(Frame& F, const Args& A, int lo, int ln) {
    LAS float* scr = (LAS float*)(F.lds + RING_OFF + F.wave * 16384);
    for (int it = F.bid * NWAVES + F.wave; it < CV_OWN + CV_NEXT; it += F.G * NWAVES) convert_item(F, A, lo, ln, it, scr);
    convert_misc(F, A, ln, F.bid * NTHR + F.tid, F.G * NTHR);
}
constexpr int CV_UNITS = (CV_OWN + CV_NEXT + 63) / 64 + 1;
__device__ __forceinline__ void convert_unit(Frame& F, const Args& A, int lo, int ln, int cu) {
    if (cu == CV_UNITS - 1) { convert_misc(F, A, ln, F.tid, NTHR); return; }
    LAS float* scr = (LAS float*)(F.lds + RING_OFF + F.wave * 16384);
    for (int j = 0; j < 8; ++j) { const int it = cu * 64 + j * 8 + F.wave; if (it < CV_OWN + CV_NEXT) convert_item(F, A, lo, ln, it, scr); }
}
__device__ __forceinline__ void prep_phase(Frame& F, const Args& A, int l) {
    const bf16* Z = WSP(bf16, WS_Z); bf16* XS = WSP(bf16, WS_XS); bf16* AQ = WSP(bf16, WS_AQ); bf16* AKV = WSP(bf16, WS_AKV);
    const float* cw = KIN(I_LCW) + (size_t)l * 4 * 512; const float* cb = KIN(I_LCB) + (size_t)l * 512;
    const float* qan = KIN(I_QAN) + (size_t)l * 384; const float* kvan = KIN(I_KVAN) + (size_t)l * 128;
    for (size_t i = (size_t)F.bid * NTHR + F.tid; i < (size_t)RT * 64; i += (size_t)F.G * NTHR) {
        const int r = (int)(i >> 6), c8 = (int)(i & 63) * 8;
        int t, len; if (r < RL) { t = r & (SEQ - 1); len = SEQ; } else { t = (r - RL) & (CTXL - 1); len = CTXL; }
        float acc[8];
#pragma unroll
        for (int j = 0; j < 8; ++j) acc[j] = cb[c8 + j];
#pragma unroll
        for (int tap = 0; tap < 4; ++tap) { const int tt = t + tap - 2;
            if (tt >= 0 && tt < len) { const v4u w = *(const v4u*)(Z + (size_t)(r + tap - 2) * LDZ + ZLX + c8); float f[8]; unpack8(w, f);
#pragma unroll
                for (int j = 0; j < 8; ++j) acc[j] += f[j] * cw[tap * 512 + c8 + j]; } }
        *(v4u*)(XS + (size_t)r * 512 + c8) = pack8(acc);
    }
    const int gw = F.bid * NWAVES + F.wave, NGW = F.G * NWAVES;
    for (int r = gw; r < RT; r += NGW) {
        const bool isq = F.lane < 48; const int e0 = isq ? F.lane * 8 : (F.lane - 48) * 8;
        const v4u w = *(const v4u*)(Z + (size_t)r * LDZ + (isq ? ZCQ : ZCKV) + e0); float f[8]; unpack8(w, f);
        float ss = 0.f;
#pragma unroll
        for (int j = 0; j < 8; ++j) ss += f[j] * f[j];
        const float sq = wave_sum(isq ? ss : 0.f, F.lane), skv = wave_sum(isq ? 0.f : ss, F.lane);
        const float rstd = isq ? rsqrtf(sq * (1.f / 384.f) + EPS) : rsqrtf(skv * (1.f / 128.f) + EPS);
        const float* nw = isq ? qan + e0 : kvan + e0;
#pragma unroll
        for (int j = 0; j < 8; ++j) f[j] = f[j] * rstd * nw[j];
        if (isq) *(v4u*)(AQ + (size_t)r * 384 + e0) = pack8(f);
        else { *(v4u*)(AKV + (size_t)r * 256 + e0) = pack8(f); *(v4u*)(AKV + (size_t)r * 256 + 128 + e0) = zero_v4u(); }
    }
}
constexpr float ATTN_SCALE_LOG2E = 0.07216878364870322f * 1.4426950408889634f;
__device__ __forceinline__ void rope8(float (&f)[8], int li, int t, int lane, const float* rope) {
    const bool second = (li & 2) != 0;
    const int pos = (li < 20) ? (t >> 6) : (t & 63);
    const f32x4* tp = (const f32x4*)(rope + (size_t)(pos * 16 + 8 * (li & 1)) * 2);
    const f32x4 t0 = tp[0], t1 = tp[1], t2 = tp[2], t3 = tp[3];
    const float cs[8] = {t0.x, t0.z, t1.x, t1.z, t2.x, t2.z, t3.x, t3.z}, sn[8] = {t0.y, t0.w, t1.y, t1.w, t2.y, t2.w, t3.y, t3.w};
    float o[8];
#pragma unroll
    for (int j = 0; j < 8; ++j) { const float other = shx(f[j], 2, lane); o[j] = second ? (f[j] * cs[j] + other * sn[j]) : (f[j] * cs[j] - other * sn[j]); }
#pragma unroll
    for (int j = 0; j < 8; ++j) f[j] = o[j];
}
__device__ __forceinline__ void mla_finish(Frame& F, const Args& A, int l, bool need_ctx, int wg0, int nwg) {
    const bf16* Z = WSP(bf16, WS_Z); const bf16* KVRAW = WSP(bf16, WS_KVRAW); bf16* K = WSP(bf16, WS_K);
    const float* kn = KIN(I_KN) + (size_t)l * 192; const float* rope = WSP(float, WS_ROPE);
    const int gw = (F.bid - wg0) * NWAVES + F.wave, NGW = nwg * NWAVES;
    const int li = F.lane & 31, hh = F.lane >> 5; const bool act = li < 24;
    float knw[8];
#pragma unroll
    for (int j = 0; j < 8; ++j) knw[j] = act ? kn[8 * li + j] : 0.f;
    for (int r = gw; r < RT; r += NGW) {
        const bool lat = r < RL; const int t = r & (SEQ - 1);
        v4u wk[2];
#pragma unroll
        for (int it = 0; it < 2; ++it) { const int h = it * 2 + hh;
            wk[it] = li < 16 ? *(const v4u*)(KVRAW + (size_t)r * 1024 + h * 256 + 8 * li) : (li < 24 ? *(const v4u*)(Z + (size_t)r * LDZ + ZKR + 8 * (li - 16)) : zero_v4u()); }
        int b, key; if (lat) { b = r >> 11; key = CTXL + t; } else { b = (r - RL) >> 8; key = (r - RL) & (CTXL - 1); }
#pragma unroll
        for (int it = 0; it < 2; ++it) { const int h = it * 2 + hh;
            float g[8]; unpack8(wk[it], g);
            float sk = 0.f;
#pragma unroll
            for (int j = 0; j < 8; ++j) sk += g[j] * g[j];
#pragma unroll
            for (int o = 1; o < 32; o <<= 1) sk += shx(sk, o, F.lane);
            const float rk = rsqrtf(sk * (1.f / 192.f) + EPS);
#pragma unroll
            for (int j = 0; j < 8; ++j) g[j] = g[j] * rk * knw[j];
            if (lat) { if (li >= 16 && li < 24) rope8(g, li, t, F.lane, rope); }
            if (act) *(v4u*)(K + ((size_t)b * TOK + key) * 768 + h * 192 + 8 * li) = pack8(g);
        }
    }
}
template <bool FINAL> __device__ __forceinline__ void lru_chunk(Frame& F, int wunit) {
    const bf16* LOGA = WSP(bf16, WS_LOGA); const bf16* GB = WSP(bf16, WS_GB); bf16* LH = WSP(bf16, WS_LH); float* SUM = WSP(float, WS_LSUM);
    const int b = wunit / 72, d = (wunit / 36) & 1, c = wunit % 36, c8 = 8 * F.lane, step = d ? -1 : 1;
    const int r0 = row_scan(b, d, 64 * c);
    float* sp = SUM + ((size_t)((b * 2 + d) * 36) * 2) * 512 + c8;
    float h[8], P[8];
#pragma unroll
    for (int j = 0; j < 8; ++j) { h[j] = 0.f; P[j] = 0.f; }
    if (FINAL) {
        for (int cc = 0; cc < c; ++cc) { const f32x4 p0 = *(const f32x4*)(sp + (size_t)cc * 1024), p1 = *(const f32x4*)(sp + (size_t)cc * 1024 + 4), e0 = *(const f32x4*)(sp + (size_t)cc * 1024 + 512), e1 = *(const f32x4*)(sp + (size_t)cc * 1024 + 516);
#pragma unroll
            for (int j = 0; j < 4; ++j) { h[j] = __expf(p0[j]) * h[j] + e0[j]; h[4 + j] = __expf(p1[j]) * h[4 + j] + e1[j]; } }
    }
    const bf16* lap = LOGA + d * 512 + c8; const bf16* gbp = GB + d * 512 + c8; bf16* lhp = LH + (size_t)d * RT * 512 + c8;
    for (int t0 = 0; t0 < 64; t0 += 8) {
        v4u la[8], gb[8];
#pragma unroll
        for (int j = 0; j < 8; ++j) { const size_t row = (size_t)(r0 + step * (t0 + j)); la[j] = *(const v4u*)(lap + row * 1024); gb[j] = *(const v4u*)(gbp + row * 1024); }
#pragma unroll
        for (int j = 0; j < 8; ++j) { float a[8], g[8]; unpack8(la[j], a); unpack8(gb[j], g);
#pragma unroll
            for (int e = 0; e < 8; ++e) { h[e] = __expf(a[e]) * h[e] + g[e]; if (!FINAL) P[e] += a[e]; }
            if (FINAL) *(v4u*)(lhp + (size_t)(r0 + step * (t0 + j)) * 512) = pack8(h); }
    }
    if (!FINAL) { float* o = sp + (size_t)c * 1024;
        *(f32x4*)(o) = (f32x4){P[0], P[1], P[2], P[3]}; *(f32x4*)(o + 4) = (f32x4){P[4], P[5], P[6], P[7]};
        *(f32x4*)(o + 512) = (f32x4){h[0], h[1], h[2], h[3]}; *(f32x4*)(o + 516) = (f32x4){h[4], h[5], h[6], h[7]}; }
}
template <bool DO_S5, bool DO_REST> __device__ __forceinline__ void finish_phase(Frame& F, const Args& A, int l, int nrows) {
    const bf16* Z = WSP(bf16, WS_Z); bf16* Y = WSP(bf16, WS_Y); bf16* A5 = WSP(bf16, WS_A5);
    const bf16* YS = WSP(bf16, WS_YS); const bf16* MH = WSP(bf16, WS_MH); const bf16* LH = WSP(bf16, WS_LH);
    const float* s5d = KIN(I_S5D) + (size_t)l * 512; const float* on = KIN(I_MLON) + (size_t)l * 512;
    const int gw = F.bid * NWAVES + F.wave, NGW = F.G * NWAVES; const int c8 = F.lane * 8;
    for (int r = gw; r < nrows; r += NGW) {
        float a[8], b[8], o[8];
        if (DO_S5) { unpack8(*(const v4u*)(YS + (size_t)r * 512 + c8), a); unpack8(*(const v4u*)(YS + ((size_t)RT + r) * 512 + c8), b); unpack8(*(const v4u*)(Z + (size_t)r * LDZ + ZU + c8), o);
#pragma unroll
          for (int j = 0; j < 8; ++j) a[j] = gelu_tanh(a[j] + b[j] + s5d[c8 + j] * o[j]);
          *(v4u*)(A5 + (size_t)r * 512 + c8) = pack8(a); }
        if (DO_REST) { unpack8(*(const v4u*)(LH + (size_t)r * 512 + c8), a); unpack8(*(const v4u*)(LH + ((size_t)RT + r) * 512 + c8), b); unpack8(*(const v4u*)(Z + (size_t)r * LDZ + ZLG + c8), o);
#pragma unroll
          for (int j = 0; j < 8; ++j) a[j] = (a[j] + b[j]) * gelu_tanh(o[j]);
          *(v4u*)(Y + (size_t)r * DM + 1536 + c8) = pack8(a); }
        if (DO_REST) { unpack8(*(const v4u*)(MH + (size_t)r * 512 + c8), a); unpack8(*(const v4u*)(MH + ((size_t)RT + r) * 512 + c8), b); unpack8(*(const v4u*)(Z + (size_t)r * LDZ + ZMO + c8), o);
          float ss = 0.f;
#pragma unroll
          for (int j = 0; j < 8; ++j) { a[j] += b[j]; ss += a[j] * a[j]; }
#pragma unroll
          for (int s = 1; s < 16; s <<= 1) ss += shx(ss, s, F.lane);
          const float rstd = rsqrtf(ss * (1.f / 128.f) + EPS);
#pragma unroll
          for (int j = 0; j < 8; ++j) a[j] = a[j] * rstd * on[c8 + j] * sigmoidf_(o[j]);
          *(v4u*)(Y + (size_t)r * DM + 512 + c8) = pack8(a); }
    }
}
#define MFMA16(a, b, c) __builtin_amdgcn_mfma_f32_16x16x32_bf16((a), (b), (c), 0, 0, 0)
#define MFMA32(a, b, c) __builtin_amdgcn_mfma_f32_32x32x16_bf16((a), (b), (c), 0, 0, 0)
__device__ __forceinline__ bf16x8 ldsfrag(const LAS bf16* p) { return *(const LAS bf16x8*)p; }

__device__ __forceinline__ void s5_scan(Frame& F, int l, int unit, int d) {
    const bf16* Z = WSP(bf16, WS_Z); bf16* YS = WSP(bf16, WS_YS);
    const float* S5A = WSP(float, WS_S5A); const bf16* BB = WSP(bf16, WS_S5BB); const bf16* CM = WSP(bf16, WS_S5CM);
    LAS bf16* Hs = (LAS bf16*)(F.lds + RING_OFF + F.wave * 8704);
    const int lane = F.lane, j = lane & 31, hl = lane >> 5, i16 = lane & 15, q4 = lane >> 4;
    const int hb = (j >> 2) & 1, tt = (j & 3) + 4 * (j >> 3);
    bf16* A5 = WSP(bf16, WS_A5); const float* s5d = KIN(I_S5D) + (size_t)l * 512;
    {
        const int bp = unit & 7, g = unit >> 3, b0 = 2 * bp, ldg = (l * 2 + d) * 32 + g;
        bf16x8 Bf[4], Cf[4];
#pragma unroll
        for (int t = 0; t < 4; ++t) { Bf[t] = *(const bf16x8*)(BB + ((size_t)ldg * 128 + t * 32 + j) * 16 + 8 * hl); Cf[t] = *(const bf16x8*)(CM + ((size_t)ldg * 16 + i16) * 128 + 32 * t + 8 * q4); }
        const float ar0 = S5A[((size_t)ldg * 64 + j) * 2], ai0 = S5A[((size_t)ldg * 64 + j) * 2 + 1], ar1 = S5A[((size_t)ldg * 64 + j + 32) * 2], ai1 = S5A[((size_t)ldg * 64 + j + 32) * 2 + 1];
        float hr0 = 0.f, hi0 = 0.f, hr1 = 0.f, hi1 = 0.f;
        const bf16* zu = Z + ZU + g * 16 + 8 * hl;
        bf16x8 a0 = *(const bf16x8*)(zu + (size_t)row_scan(b0 + hb, d, tt) * LDZ);
        bf16x8 a1 = *(const bf16x8*)(zu + (size_t)row_scan(b0 + hb, d, 16 + tt) * LDZ);
        for (int blk = 0; blk < TOK / 16; ++blk) {
            const int p0 = blk * 16, pn = min(blk + 2, TOK / 16 - 1) * 16;
            if (blk == CTXL / 32 || blk == CTXL / 16 + SEQ / 32) { asm volatile("s_waitcnt vmcnt(0)" ::: "memory"); __syncthreads(); }
            const bool fin = (blk >= CTXL / 32 && blk < CTXL / 16) || blk >= CTXL / 16 + SEQ / 32;
            const bf16x8 a2 = *(const bf16x8*)(zu + (size_t)row_scan(b0 + hb, d, pn + tt) * LDZ);
            f32x16 acc[4];
#pragma unroll
            for (int t = 0; t < 4; ++t) { f32x16 z;
#pragma unroll
                for (int e = 0; e < 16; ++e) z[e] = 0.f;
                acc[t] = MFMA32(a0, Bf[t], z); }
            LAS unsigned* hrow = (LAS unsigned*)(Hs + hl * (16 * 136)) + j;
#pragma unroll
            for (int r = 0; r < 16; ++r) {
                const float nr0 = ar0 * hr0 - ai0 * hi0 + acc[0][r], ni0 = ar0 * hi0 + ai0 * hr0 + acc[1][r];
                const float nr1 = ar1 * hr1 - ai1 * hi1 + acc[2][r], ni1 = ar1 * hi1 + ai1 * hr1 + acc[3][r];
                hr0 = nr0; hi0 = ni0; hr1 = nr1; hi1 = ni1;
                hrow[r * 68] = pk2(nr0, ni0); hrow[r * 68 + 32] = pk2(nr1, ni1);
            }
            asm volatile("s_waitcnt lgkmcnt(0)" ::: "memory");
#pragma unroll
            for (int h2 = 0; h2 < 2; ++h2) {
                f32x4 y = (f32x4){0.f, 0.f, 0.f, 0.f};
#pragma unroll
                for (int ks = 0; ks < 4; ++ks) y = MFMA16(Cf[ks], ldsfrag(Hs + h2 * (16 * 136) + i16 * 136 + 32 * ks + 8 * q4), y);
                { const int rr = row_scan(b0 + h2, d, p0 + i16);
                  if (!fin) { v2u o; o.x = pk2(y[0], y[1]); o.y = pk2(y[2], y[3]); *(v2u*)(YS + ((size_t)d * RT + rr) * 512 + g * 16 + 4 * q4) = o; }
                  else { const v2u yf = *(const v2u*)(YS + ((size_t)(1 - d) * RT + rr) * 512 + g * 16 + 4 * q4), uw = *(const v2u*)(Z + (size_t)rr * LDZ + ZU + g * 16 + 4 * q4); const f32x4 dv = *(const f32x4*)(s5d + g * 16 + 4 * q4);
                      const float a0 = gelu_tanh(y[0] + bflo(yf.x) + dv[0] * bflo(uw.x)), a1 = gelu_tanh(y[1] + bfhi(yf.x) + dv[1] * bfhi(uw.x));
                      const float a2 = gelu_tanh(y[2] + bflo(yf.y) + dv[2] * bflo(uw.y)), a3 = gelu_tanh(y[3] + bfhi(yf.y) + dv[3] * bfhi(uw.y));
                      v2u o; o.x = pk2(a0, a1); o.y = pk2(a2, a3); *(v2u*)(A5 + (size_t)rr * 512 + g * 16 + 4 * q4) = o; } }
            }
            asm volatile("s_waitcnt lgkmcnt(0)" ::: "memory");
            a0 = a1; a1 = a2;
        }
    }
}

constexpr int ML_QS = 0, ML_KS = 17408, ML_VS = 34816, ML_KW = 53248, ML_CT = 71680, ML_SP = 108544, ML_FL = 118784;
constexpr int ML_P = 144, ML_SPP = 80;
typedef short v4i16_t __attribute__((ext_vector_type(4)));
__device__ __forceinline__ v2u tr16(const LAS bf16* p) { return __builtin_bit_cast(v2u, __builtin_amdgcn_ds_read_tr16_b64_v4i16((LAS v4i16_t*)p)); }
__device__ __forceinline__ bf16x8 trfrag(const LAS bf16* base, int pitch, int k0, int n0) {
    const v2u lo = tr16(base + k0 * pitch + n0), hi = tr16(base + (k0 + 4) * pitch + n0);
    const v4u w = (v4u){lo.x, lo.y, hi.x, hi.y}; return __builtin_bit_cast(bf16x8, w);
}
__device__ __forceinline__ void mlstm_chain(Frame& F, const Args& A, int l, int unit) {
    const bf16* Z = WSP(bf16, WS_Z); bf16* MH = WSP(bf16, WS_MH);
    const int b = unit >> 3, head = (unit >> 1) & 3, dir = unit & 1;
    LAS bf16* Qs = (LAS bf16*)(F.lds + ML_QS); LAS bf16* Ks = (LAS bf16*)(F.lds + ML_KS); LAS bf16* Vs = (LAS bf16*)(F.lds + ML_VS);
    LAS bf16* Kw = (LAS bf16*)(F.lds + ML_KW); LAS bf16* Ct = (LAS bf16*)(F.lds + ML_CT); LAS bf16* Sp = (LAS bf16*)(F.lds + ML_SP);
    LAS float* bcum = (LAS float*)(F.lds + ML_FL); LAS float* lis = bcum + 64; LAS float* den = bcum + 128; LAS float* nq = bcum + 192; LAS float* nvec = bcum + 256; LAS float* nadd = bcum + 384;
    int lane_l = F.lane; asm volatile("" : "+v"(lane_l));
    const int lane = lane_l, w = F.wave, tid = w * 64 + lane, i16 = lane & 15, q4 = lane >> 4;
    const float igb = KIN(I_MLIG)[(l * 2 + dir) * 4 + head], fgb = KIN(I_MLFG)[(l * 2 + dir) * 4 + head];
    const float kscale = 0.08838834764831845f;
    f32x4 C[8];
#pragma unroll
    for (int e = 0; e < 8; ++e) C[e] = (f32x4){0.f, 0.f, 0.f, 0.f};
    __syncthreads();
    if (tid < 128) { nvec[tid] = 0.f; nadd[tid] = 0.f; }
    float gb[5], gl[5];
#pragma unroll
    for (int j = 0; j < 5; ++j) { const int cc = 8 * j + w; gb[j] = 0.f; gl[j] = 0.f;
        if (cc < TOK / 64) { const bf16* zr = Z + (size_t)row_scan(b, dir, 64 * cc + lane) * LDZ + ZMG + dir * 8 + head; gl[j] = bf2f(zr[0]) + igb; gb[j] = logsigmoidf_(bf2f(zr[4]) + fgb); } }
#pragma unroll
    for (int o = 1; o < 64; o <<= 1) {
#pragma unroll
        for (int j = 0; j < 5; ++j) { const float t = shup(gb[j], o, lane); if (lane >= o) gb[j] += t; } }
    const int trq = (8 * q4 + (i16 >> 2)), trc = 4 * (i16 & 3);
    const LAS bf16* vs_tr = Vs + trq * ML_P + trc; const LAS bf16* kw_tr = Kw + trq * ML_P + trc; const LAS bf16* ct_tr = Ct + trq * ML_P + trc; const LAS bf16* sp_tr = Sp + trq * ML_SPP + trc;
    v4u qreg[2], kreg[2], vreg[2];
    auto load_chunk = [&](int c) {
#pragma unroll
        for (int i = 0; i < 2; ++i) { const int idx = tid + 512 * i, s = idx >> 4, c8 = (idx & 15) * 8; const bf16* zr = Z + (size_t)row_scan(b, dir, 64 * c + s) * LDZ + head * 128 + c8;
            qreg[i] = *(const v4u*)(zr + ZMQ); kreg[i] = *(const v4u*)(zr + ZMK); vreg[i] = *(const v4u*)(zr + ZMV); }
    };
    load_chunk(0);
    float eBprev = 1.f;
    for (int c = 0; c < TOK / 64; ++c) {
        __syncthreads();
        if (w == (c & 7)) { float bv = gb[0], lv = gl[0];
#pragma unroll
            for (int j = 1; j < 5; ++j) if ((c >> 3) == j) { bv = gb[j]; lv = gl[j]; }
            bcum[lane] = bv; lis[lane] = lv; }
        if (tid < 128) { nvec[tid] = eBprev * nvec[tid] + nadd[tid]; nadd[tid] = 0.f; }
#pragma unroll
        for (int i = 0; i < 2; ++i) { const int idx = tid + 512 * i, s = idx >> 4, c8 = (idx & 15) * 8;
            *(LAS v4u*)(Qs + s * 136 + c8) = qreg[i];
            *(LAS v4u*)(Vs + s * ML_P + c8) = vreg[i]; }
#pragma unroll
        for (int et = 0; et < 8; ++et) { v2u cw; cw.x = pk2(C[et][0], C[et][1]); cw.y = pk2(C[et][2], C[et][3]); *(LAS v2u*)(Ct + (16 * et + i16) * ML_P + 16 * w + 4 * q4) = cw; }
        float kf[2][8];
#pragma unroll
        for (int i = 0; i < 2; ++i) { const int idx = tid + 512 * i, s = idx >> 4, c8 = (idx & 15) * 8;
            unpack8(kreg[i], kf[i]);
#pragma unroll
            for (int jj = 0; jj < 8; ++jj) kf[i][jj] *= kscale;
            *(LAS v4u*)(Ks + s * 136 + c8) = pack8(kf[i]); }
        if (c + 1 < TOK / 64) load_chunk(c + 1);
        __syncthreads();
        const float Btot = bcum[63];
#pragma unroll
        for (int i = 0; i < 2; ++i) { const int idx = tid + 512 * i, s = idx >> 4, c8 = (idx & 15) * 8; const float ws = __expf(Btot - bcum[s] + lis[s]);
#pragma unroll
            for (int jj = 0; jj < 8; ++jj) kf[i][jj] *= ws;
            *(LAS v4u*)(Kw + s * ML_P + c8) = pack8(kf[i]); }
#pragma unroll
        for (int ti = 0; ti < 2; ++ti) { const int idx = 2 * w + ti, tt = idx >> 2, st = idx & 3; const int srow = 16 * st + i16;
            f32x4 acc = (f32x4){0.f, 0.f, 0.f, 0.f};
            if (st <= tt) {
#pragma unroll
                for (int ks = 0; ks < 4; ++ks) acc = MFMA16(ldsfrag(Qs + (16 * tt + i16) * 136 + 32 * ks + 8 * q4), ldsfrag(Ks + srow * 136 + 32 * ks + 8 * q4), acc); }
            const float bs = bcum[srow], ls = lis[srow]; const f32x4 bt = *(const LAS f32x4*)(bcum + 16 * tt + 4 * q4); float v[4];
#pragma unroll
            for (int r = 0; r < 4; ++r) { const int t = 16 * tt + 4 * q4 + r; v[r] = (srow <= t && st <= tt) ? acc[r] * __expf(bt[r] - bs + ls) : 0.f; }
            v2u sw; sw.x = pk2(v[0], v[1]); sw.y = pk2(v[2], v[3]); *(LAS v2u*)(Sp + srow * ML_SPP + 16 * tt + 4 * q4) = sw; }
        __syncthreads();
        bf16x8 vfr[2], cfr[4], nfr[4];
        const bf16x8 onesf = __builtin_bit_cast(bf16x8, (v4u){0x3f803f80u, 0x3f803f80u, 0x3f803f80u, 0x3f803f80u});
#pragma unroll
        for (int ks = 0; ks < 2; ++ks) vfr[ks] = trfrag(vs_tr, ML_P, 32 * ks, 16 * w);
#pragma unroll
        for (int ks = 0; ks < 4; ++ks) { cfr[ks] = trfrag(ct_tr, ML_P, 32 * ks, 16 * w);
            const f32x4 n0 = *(const LAS f32x4*)(nvec + 32 * ks + 8 * q4), n1 = *(const LAS f32x4*)(nvec + 32 * ks + 8 * q4 + 4);
            const float nf[8] = {n0.x, n0.y, n0.z, n0.w, n1.x, n1.y, n1.z, n1.w}; nfr[ks] = __builtin_bit_cast(bf16x8, pack8(nf)); }
#pragma unroll 2
        for (int tt = 0; tt < 4; ++tt) {
            f32x4 a1 = (f32x4){0.f, 0.f, 0.f, 0.f}, a2 = (f32x4){0.f, 0.f, 0.f, 0.f}, ad = (f32x4){0.f, 0.f, 0.f, 0.f}, an = (f32x4){0.f, 0.f, 0.f, 0.f};
#pragma unroll
            for (int ks = 0; ks < 2; ++ks) { const bf16x8 sf = trfrag(sp_tr, ML_SPP, 32 * ks, 16 * tt); a1 = MFMA16(vfr[ks], sf, a1); ad = MFMA16(onesf, sf, ad); }
#pragma unroll
            for (int ks = 0; ks < 4; ++ks) { const bf16x8 qf = ldsfrag(Qs + (16 * tt + i16) * 136 + 32 * ks + 8 * q4); a2 = MFMA16(cfr[ks], qf, a2); an = MFMA16(nfr[ks], qf, an); }
            const int rr = row_scan(b, dir, 64 * c + 16 * tt + i16);
            { const float eb = __expf(bcum[16 * tt + i16]), dn = ad[0] + eb * an[0], inv = __builtin_amdgcn_rcpf(fmaxf(fabsf(dn), 1.f));
              v2u o; o.x = pk2((a1[0] + eb * a2[0]) * inv, (a1[1] + eb * a2[1]) * inv); o.y = pk2((a1[2] + eb * a2[2]) * inv, (a1[3] + eb * a2[3]) * inv);
              *(v2u*)(MH + ((size_t)dir * RT + rr) * 512 + head * 128 + 16 * w + 4 * q4) = o; }
        }
        const float eB = __expf(Btot);
#pragma unroll
        for (int et = 0; et < 8; ++et) { f32x4 acc = C[et] * eB;
#pragma unroll
            for (int ks = 0; ks < 2; ++ks) acc = MFMA16(vfr[ks], trfrag(kw_tr, ML_P, 32 * ks, 16 * et), acc);
            C[et] = acc; __builtin_amdgcn_sched_barrier(0); }
        { const int e = tid & 127, part = tid >> 7; float s = 0.f;
#pragma unroll
          for (int ss = 0; ss < 16; ++ss) s += bf2f(Kw[(16 * part + ss) * ML_P + e]);
          __hip_atomic_fetch_add(nadd + e, s, __ATOMIC_RELAXED, __HIP_MEMORY_SCOPE_WORKGROUP); }
        eBprev = eB;
    }
    __syncthreads();
}

constexpr int AT_K = 0, AT_V = 25600, AT_VP = 144, AT_BUF = 44032;
__device__ __forceinline__ void attn_unit(Frame& F, int b, int h, int qrow0, int nkt, const float* qn  ) {
    const bf16* Q = WSP(bf16, WS_QRAW); const bf16* K = WSP(bf16, WS_K); const bf16* KVRAW = WSP(bf16, WS_KVRAW); bf16* Y = WSP(bf16, WS_Y);
    LAS bf16* Kl = (LAS bf16*)(F.lds + AT_K); LAS bf16* Vl = (LAS bf16*)(F.lds + AT_V);
    int lane_l = F.lane; asm volatile("" : "+v"(lane_l));
    const int lane = lane_l, w = F.wave, tid = w * 64 + lane, i16 = lane & 15, q4 = lane >> 4;
    bf16x8 qf[2][6];
    const bf16* Qb = Q + (size_t)qrow0 * 768 + h * 192;
    const unsigned qoff = (unsigned)((32 * w + i16) * 768 + 8 * q4);
#pragma unroll
    for (int qt = 0; qt < 2; ++qt)
#pragma unroll
        for (int ks = 0; ks < 6; ++ks) qf[qt][ks] = *(const bf16x8*)(Qb + (qoff + (unsigned)(16 * qt * 768 + 32 * ks)));
    { const float* rope = WSP(float, WS_ROPE); const bool lat = qrow0 < RL;
#pragma unroll
      for (int qt = 0; qt < 2; ++qt) {
          float f[6][8]; float ss = 0.f;
#pragma unroll
          for (int ks = 0; ks < 6; ++ks) { unpack8(__builtin_bit_cast(v4u, qf[qt][ks]), f[ks]);
#pragma unroll
              for (int j = 0; j < 8; ++j) ss += f[ks][j] * f[ks][j]; }
          ss += shx(ss, 16, lane); ss += shx(ss, 32, lane);
          const float rs = rsqrtf(ss * (1.f / 192.f) + EPS);
#pragma unroll
          for (int ks = 0; ks < 6; ++ks) { const f32x4 n0 = *(const f32x4*)(qn + 32 * ks + 8 * q4), n1 = *(const f32x4*)(qn + 32 * ks + 8 * q4 + 4);
#pragma unroll
              for (int j = 0; j < 4; ++j) { f[ks][j] *= rs * n0[j]; f[ks][4 + j] *= rs * n1[j]; } }
          if (lat) { const int t = (qrow0 + 32 * w + 16 * qt + i16) & (SEQ - 1); const bool second = (q4 & 2) != 0;
#pragma unroll
              for (int part = 0; part < 2; ++part) {
                  const int pos = part ? (t & 63) : (t >> 6); const f32x4* tp = (const f32x4*)(rope + (size_t)(pos * 16 + 8 * (q4 & 1)) * 2);
                  const f32x4 t0 = tp[0], t1 = tp[1], t2 = tp[2], t3 = tp[3];
                  const float cs[8] = {t0.x, t0.z, t1.x, t1.z, t2.x, t2.z, t3.x, t3.z}, sn[8] = {t0.y, t0.w, t1.y, t1.w, t2.y, t2.w, t3.y, t3.w};
#pragma unroll
                  for (int j = 0; j < 8; ++j) { const float me = f[4 + part][j], other = shx(me, 32, lane); f[4 + part][j] = second ? (me * cs[j] + other * sn[j]) : (me * cs[j] - other * sn[j]); } } }
#pragma unroll
          for (int ks = 0; ks < 6; ++ks) {
#pragma unroll
              for (int j = 0; j < 8; ++j) f[ks][j] *= ATTN_SCALE_LOG2E;
              qf[qt][ks] = __builtin_bit_cast(bf16x8, pack8(f[ks])); }
      } }
    f32x4 O[2][8];
#pragma unroll
    for (int qt = 0; qt < 2; ++qt)
#pragma unroll
        for (int dt = 0; dt < 8; ++dt) O[qt][dt] = (f32x4){0.f, 0.f, 0.f, 0.f};
    float mrun[2] = {-1e30f, -1e30f}, lsum[2] = {0.f, 0.f};
    const bf16* kbase = K + (size_t)b * TOK * 768 + h * 192;
    v4u kr[3], vr[2];
    unsigned koff[3], voff[2];
#pragma unroll
    for (int i = 0; i < 3; ++i) { const int idx = tid + 512 * i, r = idx / 24, cc = idx % 24; koff[i] = (unsigned)(r * 768 + 8 * cc); }
#pragma unroll
    for (int i = 0; i < 2; ++i) { const int idx = tid + 512 * i, r = idx >> 4, cc = idx & 15; voff[i] = (unsigned)(r * 1024 + 8 * cc); }
    auto load_tile = [&](int kt) {
        const bf16* kb = kbase + (size_t)kt * (64 * 768); const bf16* vb = KVRAW + (size_t)row_key(b, 64 * kt) * 1024 + h * 256 + 128;
#pragma unroll
        for (int i = 0; i < 3; ++i) kr[i] = *(const v4u*)(kb + koff[i]);
#pragma unroll
        for (int i = 0; i < 2; ++i) vr[i] = *(const v4u*)(vb + voff[i]);
    };
    const LAS bf16* vtr0 = Vl + (4 * q4 + (i16 >> 2)) * AT_VP + 4 * (i16 & 3);
    int kwo[3], vwo[2];
#pragma unroll
    for (int i = 0; i < 3; ++i) { const int idx = tid + 512 * i, r = idx / 24, cc = idx % 24; kwo[i] = r * 200 + 8 * cc; }
#pragma unroll
    for (int i = 0; i < 2; ++i) { const int idx = tid + 512 * i, r = idx >> 4, cc = idx & 15; vwo[i] = r * AT_VP + 8 * cc; }
    load_tile(0);
    __syncthreads();
#pragma unroll
    for (int i = 0; i < 3; ++i) *(LAS v4u*)(Kl + kwo[i]) = kr[i];
#pragma unroll
    for (int i = 0; i < 2; ++i) *(LAS v4u*)(Vl + vwo[i]) = vr[i];
    __syncthreads();
    for (int kt = 0; kt < nkt; ++kt) {
        const int bo = (kt & 1) * (AT_BUF / 2);
        const LAS bf16* Kc = Kl + bo; const LAS bf16* vtrc = vtr0 + bo;
        if (kt + 1 < nkt) load_tile(kt + 1);
        f32x4 s[2][4];
#pragma unroll
        for (int k4 = 0; k4 < 4; ++k4) {
            f32x4 s0 = (f32x4){0.f, 0.f, 0.f, 0.f}, s1 = (f32x4){0.f, 0.f, 0.f, 0.f};
#pragma unroll
            for (int ks = 0; ks < 6; ++ks) { const bf16x8 kf = ldsfrag(Kc + (16 * k4 + i16) * 200 + 32 * ks + 8 * q4); s0 = MFMA16(kf, qf[0][ks], s0); s1 = MFMA16(kf, qf[1][ks], s1); }
            s[0][k4] = s0; s[1][k4] = s1;
        }
        bf16x8 pf[2][2];
#pragma unroll
        for (int qt = 0; qt < 2; ++qt) {
            float tm = -1e30f;
#pragma unroll
            for (int k4 = 0; k4 < 4; ++k4)
#pragma unroll
                for (int r = 0; r < 4; ++r) tm = fmaxf(tm, s[qt][k4][r]);
            tm = fmaxf(tm, shx(tm, 16, lane)); tm = fmaxf(tm, shx(tm, 32, lane));
            const float mn = fmaxf(mrun[qt], tm), alpha = __builtin_amdgcn_exp2f(mrun[qt] - mn);
            mrun[qt] = mn;
            float ps = 0.f; float p[4][4];
#pragma unroll
            for (int k4 = 0; k4 < 4; ++k4)
#pragma unroll
                for (int r = 0; r < 4; ++r) { p[k4][r] = __builtin_amdgcn_exp2f(s[qt][k4][r] - mn); ps += p[k4][r]; }
            lsum[qt] = lsum[qt] * alpha + ps;
#pragma unroll
            for (int dt = 0; dt < 8; ++dt) O[qt][dt] = O[qt][dt] * alpha;
#pragma unroll
            for (int kk = 0; kk < 2; ++kk) { v4u pw; pw.x = pk2(p[2 * kk][0], p[2 * kk][1]); pw.y = pk2(p[2 * kk][2], p[2 * kk][3]); pw.z = pk2(p[2 * kk + 1][0], p[2 * kk + 1][1]); pw.w = pk2(p[2 * kk + 1][2], p[2 * kk + 1][3]);
                pf[qt][kk] = __builtin_bit_cast(bf16x8, pw); }
        }
#pragma unroll
        for (int dt = 0; dt < 8; ++dt)
#pragma unroll
            for (int kk = 0; kk < 2; ++kk) {
                const v2u lo = tr16(vtrc + (32 * kk) * AT_VP + 16 * dt), hi = tr16(vtrc + (32 * kk + 16) * AT_VP + 16 * dt);
                const v4u vw = (v4u){lo.x, lo.y, hi.x, hi.y}; const bf16x8 vf = __builtin_bit_cast(bf16x8, vw);
                O[0][dt] = MFMA16(vf, pf[0][kk], O[0][dt]); O[1][dt] = MFMA16(vf, pf[1][kk], O[1][dt]);
            }
        if (kt + 1 < nkt) { const int bn = ((kt + 1) & 1) * (AT_BUF / 2);
#pragma unroll
            for (int i = 0; i < 3; ++i) *(LAS v4u*)(Kl + bn + kwo[i]) = kr[i];
#pragma unroll
            for (int i = 0; i < 2; ++i) *(LAS v4u*)(Vl + bn + vwo[i]) = vr[i]; }
        __syncthreads();
    }
#pragma unroll
    for (int qt = 0; qt < 2; ++qt) {
        float lt = lsum[qt]; lt += shx(lt, 16, lane); lt += shx(lt, 32, lane);
        const float inv = 1.f / lt;
        bf16* Yb = Y + (size_t)qrow0 * DM + 1024 + h * 128; const unsigned yoff = (unsigned)((32 * w + 16 * qt + i16) * DM + 4 * q4);
#pragma unroll
        for (int dt = 0; dt < 8; ++dt) { const f32x4 o = O[qt][dt] * inv; v2u ow; ow.x = pk2(o[0], o[1]); ow.y = pk2(o[2], o[3]); *(v2u*)(Yb + (yoff + (unsigned)(16 * dt))) = ow; }
    }
    __syncthreads();
}
template <class E_> __device__ __forceinline__ void probe_redirect(E_&, float*) {}
__device__ __forceinline__ void probe_redirect(pg8::EpiRes& e, float* dummy) { e.xout = dummy; }

__global__ void __launch_bounds__(NTHR, 2) trunk_fwd(Args A) {
    extern __shared__ __attribute__((aligned(16))) unsigned char lds[];
    Frame F;
    F.lds = (LAS unsigned char*)lds;
    F.MISC = (volatile LAS unsigned*)(F.lds + MISC_OFF);
    F.tid = threadIdx.x; F.lane = F.tid & 63; F.wave = __builtin_amdgcn_readfirstlane(F.tid >> 6);
    F.G = gridDim.x; F.bid = blockIdx.x;
    F.ws = A.ws; F.out = A.out; F.kp = (const __attribute__((address_space(4))) char*)__builtin_amdgcn_kernarg_segment_ptr();
    unsigned char* const ws0 = A.ws; const __attribute__((address_space(4))) char* const kp0 = F.kp;
    F.ctl = (gu32*)(A.ws + WS_CTL);
    for (int u = F.tid; u < (LDS_BYTES - LDSCTL_OFF) / 4; u += NTHR) ((LAS unsigned*)(F.lds + LDSCTL_OFF))[u] = 0u;
    __syncthreads();
    XcdBarrier bar = xcd_barrier_post((unsigned*)(F.ctl + CW_BAR), F.MISC + 8);
    const int lo = A.lo, hi = A.hi, wave0 = F.wave;
    int st = 0;
#define RELAUNDER() do { int w_s = wave0; asm volatile("" : "+s"(w_s)); F.wave = w_s; { unsigned m_ = ~0u; asm volatile("" : "+v"(m_)); F.lane = (int)__builtin_amdgcn_mbcnt_hi(m_, __builtin_amdgcn_mbcnt_lo(m_, 0u)); } F.tid = w_s * 64 + F.lane; int b_ = blockIdx.x, g_ = gridDim.x; asm volatile("" : "+s"(b_), "+s"(g_)); F.bid = b_; F.G = g_; GAS unsigned char* w_ = (GAS unsigned char*)ws0; asm volatile("" : "+s"(w_)); F.ws = (unsigned char*)w_; const __attribute__((address_space(4))) char* k_ = kp0; asm volatile("" : "+s"(k_)); F.kp = k_; } while (0)
#define STEP_BEGIN if (st >= lo && st < hi) { asm volatile("; STEP_MARK_BEGIN %0" :: "n"(__LINE__)); RELAUNDER();
#define STEP_END   asm volatile("; STEP_MARK_END %0" :: "n"(__LINE__)); if (st + 1 < hi) { xcd_barrier(bar); if (PROBE_DUP == 11) xcd_barrier(bar); } } ++st;
#define PROBE_REDIRECT(e) probe_redirect(e, WSP(float, WS_Z))
#define GEMM_STAGGER() do { if (STAG_GROUPS > 1) { const int sg_ = (F.bid >> 3) % STAG_GROUPS; for (int i_ = 0; i_ < sg_; ++i_) __builtin_amdgcn_s_sleep(STAG_SLEEP); } } while (0)
#define GEMM_RUN(EPI) { if (PROBE_DUP == 8) { auto E2_ = E; PROBE_REDIRECT(E2_); pg8::gemm_phase<decltype(E2_), pg8::StaticOrder, GEMM_ALIGN, GEMM_SP2>(ring, g, S, E2_, F.tid); RELAUNDER(); } \
    if (PROBE_DUP == 1) { pg8::EpiNull EN_; pg8::gemm_phase<pg8::EpiNull, pg8::StaticOrder, GEMM_ALIGN, GEMM_SP2>(ring, g, S, EN_, F.tid); RELAUNDER(); } \
    pg8::gemm_phase<pg8::EPI, pg8::StaticOrder, GEMM_ALIGN, GEMM_SP2>(ring, g, S, E, F.tid); }
#define GEMM_RUN_NSP(EPI, NSPV) { pg8::gemm_phase<pg8::EPI, pg8::StaticOrder, GEMM_ALIGN, GEMM_SP2, NSPV>(ring, g, S, E, F.tid); }
#define MODS_L (WSP(float, WS_MODS) + (size_t)l * 17 * NMOD)
    LAS unsigned char* ring = F.lds + RING_OFF;

    STEP_BEGIN
        for (int rep = 0; rep < (PROBE_DUP == 7 ? 2 : 1); ++rep)
        p0a_prologue(F, KIN(I_C), KIN(I_CCTX), KIN(I_ADAW), KIN(I_ADAB), KIN(I_S5LRE), KIN(I_S5LIM), KIN(I_S5LDT), KIN(I_S5BRE), KIN(I_S5BIM), KIN(I_S5CRE), KIN(I_S5CIM));
    STEP_END
    STEP_BEGIN
        for (int rep = 0; rep < (PROBE_DUP == 24 ? 2 : 1); ++rep) { p0c_shw(F, KIN(I_WIN), KIN(I_W1)); RELAUNDER(); }
    STEP_END

    for (int l = 0; l < DEPTH; ++l) {
        const bool need_ctx = l < DEPTH - 1;
        const int nrows = need_ctx ? RT : RL;
        STEP_BEGIN
            for (int rep = 0; rep < ((PROBE_DUP == 4 || PROBE_DUP == 20) ? 2 : 1); ++rep) {
            convert_weights(F, A, l, l);
            RELAUNDER();
            if (l == 0) norm0_phase(F, KIN(I_X), KIN(I_CTX), KIN(I_N1W), WSP(float, WS_MODS));
            else { rstd_phase(F, RL); RELAUNDER(); if (rep == 0) ctxfix_phase(F, MODS_L - 17 * NMOD + 16 * NMOD + 5 * DM, KIN(I_N1W) + (size_t)l * DM, MODS_L + 16 * NMOD + 1 * DM); }
            RELAUNDER(); }
        STEP_END
        STEP_BEGIN
            pg8::Gemm g{WSP(bf16, WS_H), WSP(bf16, WS_WIN), RT, LDZ, DM}; g.ablk = 1; pg8::StaticOrder S; S.init(RT, LDZ, F.G, F.bid);
            for (int rep = 0; rep < (PROBE_DUP == 14 ? 2 : 1); ++rep) {
            pg8::EpiStoreN E{WSP(bf16, WS_Z), LDZ, WSP(float, WS_RSTD), WSP(float, WS_SHW) + (size_t)l * 17 * (LDZ + DFF), LDZ + DFF};
            GEMM_STAGGER(); GEMM_RUN(EpiStoreN)
            RELAUNDER(); }
        STEP_END
        STEP_BEGIN
            for (int rep = 0; rep < ((PROBE_DUP == 4 || PROBE_DUP == 21) ? 2 : 1); ++rep) { prep_phase(F, A, l); RELAUNDER(); }
        STEP_END
        STEP_BEGIN
            for (int rep = 0; rep < (PROBE_DUP == 12 ? 2 : 1); ++rep) {
            { const pg8::GrpDesc gl{WSP(bf16, WS_XS), WSP(bf16, WS_WLRU), RT, 2048, 128, 512, 4}, gk{WSP(bf16, WS_AKV), WSP(bf16, WS_WKVUP), RT, 1024, 256, 256, 0},
                                 gq{WSP(bf16, WS_AQ), WSP(bf16, WS_WQUP), need_ctx ? RT : RL, 768, 384, 384, 0};
              const pg8::EpiLru el{WSP(bf16, WS_XS), WSP(bf16, WS_LOGA), WSP(bf16, WS_GB), WSP(float, WS_LRUC)};
              const pg8::EpiStoreBf16 ek{WSP(bf16, WS_KVRAW), 1024}, eq{WSP(bf16, WS_QRAW), 768};
              pg8::gemm_group3(ring, gl, gk, gq, el, ek, eq, F.G, F.bid, F.tid); }
            RELAUNDER(); }
        STEP_END
        STEP_BEGIN
            for (int rep = 0; rep < (PROBE_DUP == 3 ? 2 : 1); ++rep) {
            const int s5wg = (S5_IN_L4 && F.G >= 256) ? 64 : 0;
            if (F.bid < s5wg) s5_scan(F, l, F.bid * 4 + (F.wave >> 1), F.wave & 1);
            else {
            for (int wu = (F.bid - s5wg) * NWAVES + F.wave; wu < NB * 2 * 36; wu += (F.G - s5wg) * NWAVES) lru_chunk<false>(F, wu);
            RELAUNDER();
            mla_finish(F, A, l, need_ctx, s5wg, F.G - s5wg); }
            RELAUNDER(); }
        STEP_END
        STEP_BEGIN
            const int nattn = 704 + (need_ctx ? 64 : 0), nunits = nattn + 144;
            volatile LAS unsigned* slot = F.MISC + 16;
            for (int rep = 0; rep < ((PROBE_DUP == 2 || PROBE_DUP == 5 || PROBE_DUP == 6 || PROBE_DUP == 9) ? 2 : 1); ++rep) {
            gu32* qh = F.ctl + CW_QUEUE + 64 * (l + 4 * rep);
            const int ubase = (rep == 1 && PROBE_DUP == 6) ? 192 : (rep == 1 && PROBE_DUP == 9) ? 128 : 0;
            const int ulim = (rep == 1 && PROBE_DUP == 5) ? 128 : (rep == 1 && PROBE_DUP == 9) ? 192 : nunits;
            for (;;) {
                __syncthreads();
                if (F.tid == 0) slot[0] = __hip_atomic_fetch_add(qh, 1u, __ATOMIC_RELAXED, __HIP_MEMORY_SCOPE_AGENT);
                __syncthreads();
                const int u = ubase + __builtin_amdgcn_readfirstlane((int)slot[0]);
                if (u >= ulim) break;
                if (u < 128) mlstm_chain(F, A, l, u);
                else if (u < 192) s5_scan(F, l, (u - 128) * 4 + (F.wave >> 1), F.wave & 1);
                else if (u >= nattn) lru_chunk<true>(F, (u - nattn) * 8 + F.wave);
                else { int ab, ah, aq, an; const int ua = u - 192;
                    if (ua < 512) { ab = ua >> 5; ah = (ua >> 3) & 3; aq = (ua >> 5) * SEQ + 256 * (ua & 7); an = TOK / 64; }
                    else { const int uc = ua - 512; ab = uc >> 2; ah = uc & 3; aq = RL + (uc >> 2) * CTXL; an = CTXL / 64; }
                    attn_unit(F, ab, ah, aq, an, KIN(I_QN) + (size_t)l * 192); }
                RELAUNDER();
            }
            }
        STEP_END
        STEP_BEGIN
            pg8::Gemm g{WSP(bf16, WS_A5), WSP(bf16, WS_WGLU), nrows, 512, 512}; pg8::StaticOrder S; S.init(nrows, 512, F.G, F.bid);
            for (int rep = 0; rep < (PROBE_DUP == 13 ? 2 : 1); ++rep) {
            pg8::EpiGlu E{WSP(bf16, WS_A5), WSP(bf16, WS_Y), DM, KIN(I_S5GLUB) + (size_t)l * 512};
            GEMM_RUN(EpiGlu)
            RELAUNDER();
            finish_phase<false, true>(F, A, l, nrows);
            RELAUNDER(); }
        STEP_END
        STEP_BEGIN
            pg8::Gemm g{WSP(bf16, WS_Y), WSP(bf16, WS_WOUT), nrows, DM, DM}; pg8::StaticOrder S; S.init(nrows, DM, F.G, F.bid);
            if (l == 0) {
                pg8::EpiResNF E{KIN(I_X), KIN(I_CTX) - (size_t)RL * DM, WSP(bf16, WS_X), MODS_L + 2 * DM, 0, WSP(bf16, WS_H), KIN(I_N2W) + (size_t)l * DM, MODS_L + 4 * DM, WSP(float, WS_SSP)};
                GEMM_RUN(EpiResNF)
            } else {
                pg8::EpiResN E{WSP(bf16, WS_X), WSP(bf16, WS_X), WSP(bf16, WS_X), MODS_L + 2 * DM, 0, WSP(bf16, WS_H), KIN(I_N2W) + (size_t)l * DM, MODS_L + 4 * DM, WSP(float, WS_SSP)};
                GEMM_RUN(EpiResN)
            }
        STEP_END
        STEP_BEGIN
            for (int rep = 0; rep < (PROBE_DUP == 23 ? 2 : 1); ++rep) { rstd_phase(F, nrows); RELAUNDER(); }
        STEP_END
        { const int nch = (nrows + MLP_CHUNK - 1) / MLP_CHUNK;
          for (int c = 0; c <= nch; ++c) {
            STEP_BEGIN
                const int g1first = (MLP_ALT && c >= 1 && c < nch) ? ((F.bid >> 3) & 1) : 0;
                for (int ord = 0; ord < 2; ++ord) { const int which = ord ^ g1first;
                if (which == 0) {
                if (c >= 1) { const int r0 = (c - 1) * MLP_CHUNK, m = min(MLP_CHUNK, nrows - r0); const bf16* hid = WSP(bf16, WS_Z) + (size_t)((c - 1) & 1) * MLP_CHUNK * DFF;
                    if (m >= 8192) {
                        if (need_ctx) {
                            pg8::Gemm g{hid, WSP(bf16, WS_W2), m, DM, DFF}; g.ablk = 1; pg8::StaticOrder S; S.init(m, DM, F.G, F.bid);
                            pg8::EpiResN E{WSP(bf16, WS_X), WSP(bf16, WS_X), WSP(bf16, WS_X), MODS_L + 5 * DM, r0,
                                           WSP(bf16, WS_H), KIN(I_N1W) + (size_t)(l + 1) * DM, MODS_L + 17 * NMOD + 1 * DM, WSP(float, WS_SSP)};
                            GEMM_RUN(EpiResN)
                        } else {
                            pg8::Gemm g{hid, WSP(bf16, WS_W2), m, DM, DFF}; g.ablk = 1; pg8::StaticOrder S; S.init(m, DM, F.G, F.bid);
                            pg8::EpiResOut E{WSP(bf16, WS_X), F.out, MODS_L + 5 * DM, r0};
                            GEMM_RUN(EpiResOut)
                        }
                    } else {
                        pg8::Gemm g{hid, WSP(bf16, WS_W2), m, 2 * DM, DFF / 2, DFF, DM / 256}; g.ablk = 1; pg8::StaticOrder S; S.init(m, 2 * DM, F.G, F.bid);
                        pg8::EpiPart E{WSP(float, WS_LOGA), DM / 256, RC};
                        GEMM_RUN_NSP(EpiPart, 8)
                    }
                    RELAUNDER(); }
                } else {
                if (c < nch) { const int r0 = c * MLP_CHUNK, m = min(MLP_CHUNK, nrows - r0);
                    pg8::Gemm g{WSP(bf16, WS_H) + (size_t)r0 * DM, WSP(bf16, WS_W1), m, DFF, DM}; g.ablk = 1; pg8::StaticOrder S; S.init(m, DFF, F.G, F.bid);
                    pg8::EpiRelu2N E{WSP(bf16, WS_Z) + (size_t)(c & 1) * MLP_CHUNK * DFF, DFF, WSP(float, WS_RSTD), WSP(float, WS_SHW) + (size_t)l * 17 * (LDZ + DFF) + LDZ, LDZ + DFF, r0};
                    if (PROBE_DUP == 25) { GEMM_RUN(EpiRelu2N) RELAUNDER(); }
                    GEMM_RUN(EpiRelu2N) }
                }
                RELAUNDER(); }
            STEP_END
          } }
    }
#undef STEP_BEGIN
#undef STEP_END
}

extern "C" void kernel_launch(void* const* d_in, const int* in_sizes, int n_in, void* d_out, int out_size, void* d_ws, size_t ws_size, hipStream_t stream) {
    static int grid = 0;
    if (grid == 0) {
        if (n_in != N_IN || in_sizes[0] != RL * DM || out_size != RL * DM || ws_size < WS_END) {
            fprintf(stderr, "kernel_launch: shape/workspace mismatch: n_in %d in0 %d out %d ws %zu (need %zu); nothing launched\n", n_in, n_in > 0 ? in_sizes[0] : -1, out_size, ws_size, (size_t)WS_END); grid = -1; return; }
        int dev = 0, cus = 0, per_cu = 0;
        if (hipGetDevice(&dev) != hipSuccess || hipDeviceGetAttribute(&cus, hipDeviceAttributeMultiprocessorCount, dev) != hipSuccess) { grid = -1; return; }
        if (hipFuncSetAttribute((const void*)trunk_fwd, hipFuncAttributeMaxDynamicSharedMemorySize, LDS_BYTES) != hipSuccess) { fprintf(stderr, "kernel_launch: hipFuncSetAttribute failed\n"); grid = -1; return; }
        if (hipOccupancyMaxActiveBlocksPerMultiprocessor(&per_cu, (const void*)trunk_fwd, NTHR, LDS_BYTES) != hipSuccess || per_cu < 1)
            fprintf(stderr, "kernel_launch: note: occupancy query reports %d workgroups per CU\n", per_cu);
        (void)hipGetLastError();
        grid = cus;
    }
    if (grid < 0) return;
    if (hipMemsetAsync((char*)d_ws + WS_CTL, 0, CTL_ZERO_BYTES, stream) != hipSuccess) return;
    Args a{};
    for (int i = 0; i < N_IN; ++i) a.in[i] = (const float*)d_in[i];
    a.out = (float*)d_out; a.ws = (unsigned char*)d_ws;
#ifndef MK_SPLIT
    a.lo = 0; a.hi = 1 << 20;
    hipLaunchKernelGGL(trunk_fwd, dim3(grid), dim3(NTHR), LDS_BYTES, stream, a);
#else
    for (int s = 0; s < MK_SPLIT; ++s) { a.lo = s; a.hi = s + 1; hipLaunchKernelGGL(trunk_fwd, dim3(grid), dim3(NTHR), LDS_BYTES, stream, a); }
#endif
}
```

```cpp
#include <hip/hip_runtime.h>
#include <cstdio>
#include <cstdint>
#ifndef GEMM_ALIGN
#define GEMM_ALIGN true
#endif
#ifndef GEMM_SP2
#define GEMM_SP2 true
#endif
#ifndef MLP_CHUNK
#define MLP_CHUNK 8192
#endif
#ifndef STAG_GROUPS
#define STAG_GROUPS 1
#define STAG_SLEEP 64
#endif
#ifndef EPI_NT
#define EPI_NT 0
#endif
#ifndef S5_IN_L4
#define S5_IN_L4 0
#endif
#ifndef MLP_ALT
#define MLP_ALT 0
#endif
#ifndef WOUT_STAG_GROUPS
#define WOUT_STAG_GROUPS 1
#define WOUT_STAG_STEPS 4
#endif
#ifndef PROBE_DUP
#define PROBE_DUP 0
#endif

constexpr int DM = 2048, NB = 16, SEQ = 2048, CTXL = 256, DEPTH = 4, DFF = 8192;
constexpr int RL = NB * SEQ;
constexpr int RC = NB * CTXL;
constexpr int RT = RL + RC;
constexpr int TOK = SEQ + CTXL;
constexpr int NZ = 4176, LDZ = 4352;
constexpr int ZU = 0, ZMQ = 512, ZMK = 1024, ZMV = 1536, ZMO = 2048, ZMG = 2560, ZCQ = 2576, ZCKV = 2960, ZKR = 3088, ZLX = 3152, ZLG = 3664;
constexpr int NMOD = 6 * DM;
constexpr float EPS = 1e-6f;
constexpr int NWAVES = 8, NTHR = 512;

enum { I_X = 0, I_C, I_CTX, I_CCTX, I_ADAW, I_ADAB, I_N1W, I_N2W, I_WIN, I_WOUT, I_S5LRE, I_S5LIM, I_S5LDT, I_S5BRE, I_S5BIM, I_S5CRE, I_S5CIM, I_S5D, I_S5GLUW, I_S5GLUB,
       I_MLIG, I_MLFG, I_MLON, I_QAN, I_WQUP, I_KVAN, I_WKVUP, I_QN, I_KN, I_LCW, I_LCB, I_LWA, I_LBA, I_LWX, I_LBX, I_LLAM, I_W1, I_W2, N_IN };

constexpr size_t MiB = 1u << 20;
#ifndef WS_SKEW
#define WS_SKEW 1
#endif
#ifndef BLK_LAYOUT
#define BLK_LAYOUT 1
#endif
__host__ __device__ __forceinline__ size_t blk_off(int row, int col, int nct) { return BLK_LAYOUT ? (((size_t)((row >> 8) * nct + (col >> 8))) << 16) + (size_t)((row & 255) * 256 + (col & 255)) : (size_t)row * (size_t)(256 * nct) + col; }
constexpr size_t WS_CTL = 0, CTL_ZERO_BYTES = 1 * MiB;
constexpr size_t WS_MODS = 1 * MiB;
constexpr size_t WS_S5A = 5 * MiB;
constexpr size_t WS_S5BB = 5 * MiB + 512 * 1024;
constexpr size_t WS_S5CM = 6 * MiB + 512 * 1024;
constexpr size_t WS_LRUC = 7 * MiB + 512 * 1024;
constexpr size_t WS_ROPE = 7 * MiB + 640 * 1024;
constexpr size_t WS_W = 8 * MiB;
constexpr size_t WS_WIN = WS_W;
constexpr size_t WS_WOUT = WS_WIN + 17 * MiB;
constexpr size_t WS_W1 = WS_WOUT + 8 * MiB;
constexpr size_t WS_W2 = WS_W1 + 32 * MiB;
constexpr size_t WS_WGLU = WS_W2 + 32 * MiB;
constexpr size_t WS_WQUP = WS_WGLU + 1 * MiB;
constexpr size_t WS_WKVUP = WS_WQUP + 1 * MiB;
constexpr size_t WS_WLRU = WS_WKVUP + 1 * MiB;
constexpr size_t WS_X = WS_WLRU + 2 * MiB;
constexpr size_t WS_H = WS_X + 288 * MiB + WS_SKEW * 129 * 256;
constexpr size_t WS_Z = WS_H + 144 * MiB + WS_SKEW * 67 * 256;
constexpr size_t WS_Y = WS_Z + 306 * MiB + WS_SKEW * 201 * 256;
constexpr size_t WS_HID = WS_Y + 144 * MiB + WS_SKEW * 37 * 256;
constexpr size_t WS_T = WS_HID + 128 * MiB + WS_SKEW * 93 * 256;
constexpr size_t WS_XS = WS_H;
constexpr size_t WS_AQ = WS_H + 36 * MiB;
constexpr size_t WS_AKV = WS_H + 63 * MiB;
constexpr size_t WS_Q = WS_H;
constexpr size_t WS_K = WS_H + 54 * MiB;
constexpr size_t WS_VT = WS_H + 108 * MiB;
constexpr size_t WS_QRAW = WS_HID;
constexpr size_t WS_KVRAW = WS_HID + 54 * MiB;
constexpr size_t WS_LOGA = WS_T;
constexpr size_t WS_GB = WS_T + 72 * MiB;
constexpr size_t WS_YS = WS_T + 144 * MiB;
constexpr size_t WS_A5 = WS_X + 144 * MiB;
constexpr size_t WS_MH = WS_T + 216 * MiB;
constexpr size_t WS_LH = WS_T + 288 * MiB;
constexpr size_t WS_MODP = WS_Z;
constexpr size_t WS_LSUM = WS_T + 360 * MiB;
constexpr size_t WS_SHW = WS_T + 368 * MiB;
constexpr size_t WS_SSP = WS_T + 372 * MiB;
constexpr size_t WS_RSTD = WS_T + 377 * MiB;
constexpr size_t WS_END = WS_T + 378 * MiB;
static_assert(WS_END <= (size_t)1536 * MiB, "d_ws map exceeds 4 x largest input tensor");

constexpr int CW_TMO = 0, CW_CODE = 1;
constexpr int CW_BAR = 4096;
constexpr int CW_QUEUE = 8192;

constexpr int RING_OFF = 0, RING_BYTES = 131072;
constexpr int LDSCTL_OFF = RING_BYTES, MISC_OFF = LDSCTL_OFF + 320;
constexpr int LDS_BYTES = 147456;

#define GAS __attribute__((address_space(1)))
#define LAS __attribute__((address_space(3)))
typedef unsigned short bf16;
typedef unsigned v4u __attribute__((ext_vector_type(4)));
typedef unsigned v2u __attribute__((ext_vector_type(2)));
typedef float f32x4 __attribute__((ext_vector_type(4)));
typedef float f32x16 __attribute__((ext_vector_type(16)));
typedef short bf16x8 __attribute__((ext_vector_type(8)));
typedef short bf16x4 __attribute__((ext_vector_type(4)));
typedef GAS unsigned gu32;
#define RLX_AGENT __ATOMIC_RELAXED, __HIP_MEMORY_SCOPE_AGENT
#define LDS_WAIT() asm volatile("s_waitcnt lgkmcnt(0)" ::: "memory")
#define VM_WAIT() asm volatile("s_waitcnt vmcnt(0)" ::: "memory")
__device__ __forceinline__ unsigned f2bf(float f) { unsigned u = __builtin_bit_cast(unsigned, f); return (u + 0x7fffu + ((u >> 16) & 1u)) >> 16; }
typedef __bf16 bf16x2_t __attribute__((ext_vector_type(2)));
typedef float f32x2_t __attribute__((ext_vector_type(2)));
__device__ __forceinline__ unsigned pk2(float lo, float hi) { const f32x2_t v = {lo, hi}; const bf16x2_t b = __builtin_convertvector(v, bf16x2_t); return __builtin_bit_cast(unsigned, b); }
__device__ __forceinline__ float bf2f(unsigned b) { return __builtin_bit_cast(float, b << 16); }
__device__ __forceinline__ float bflo(unsigned w) { return __builtin_bit_cast(float, w << 16); }
__device__ __forceinline__ float bfhi(unsigned w) { return __builtin_bit_cast(float, w & 0xffff0000u); }
__device__ __forceinline__ void unpack8(const v4u w, float (&f)[8]) { f[0] = bflo(w.x); f[1] = bfhi(w.x); f[2] = bflo(w.y); f[3] = bfhi(w.y); f[4] = bflo(w.z); f[5] = bfhi(w.z); f[6] = bflo(w.w); f[7] = bfhi(w.w); }
__device__ __forceinline__ v4u pack8(const float (&f)[8]) { v4u w; w.x = pk2(f[0], f[1]); w.y = pk2(f[2], f[3]); w.z = pk2(f[4], f[5]); w.w = pk2(f[6], f[7]); return w; }
__device__ __forceinline__ float sigmoidf_(float x) { return __builtin_amdgcn_rcpf(1.f + __expf(-x)); }
__device__ __forceinline__ float gelu_tanh(float x) { const float u = 0.7978845608028654f * (x + 0.044715f * x * x * x); const float t = 1.f - 2.f * __builtin_amdgcn_rcpf(1.f + __expf(2.f * u)); return 0.5f * x * (1.f + t); }
__device__ __forceinline__ float softplusf_(float x) { return fmaxf(x, 0.f) + log1pf(__expf(-fabsf(x))); }
__device__ __forceinline__ float logsigmoidf_(float x) { return fminf(x, 0.f) - log1pf(__expf(-fabsf(x))); }
__device__ __forceinline__ float shx(float v, int mask, int lane) { return __builtin_bit_cast(float, __builtin_amdgcn_ds_bpermute((lane ^ mask) << 2, __builtin_bit_cast(int, v))); }
__device__ __forceinline__ float shup(float v, int delta, int lane) { return __builtin_bit_cast(float, __builtin_amdgcn_ds_bpermute(((lane - delta) & 63) << 2, __builtin_bit_cast(int, v))); }
__device__ __forceinline__ float wave_sum(float v, int lane) {
#pragma unroll
    for (int o = 1; o < 64; o <<= 1) v += shx(v, o, lane);
    return v;
}
__device__ __forceinline__ v4u zero_v4u() { unsigned z = 0u; asm volatile("" : "+v"(z)); return (v4u){z, z, z, z}; }
__device__ __forceinline__ int row_scan(int b, int dir, int p) {
    if (p < CTXL) { const int t = dir ? (CTXL - 1 - p) : p; return RL + b * CTXL + t; }
    const int q = p - CTXL; const int t = dir ? (SEQ - 1 - q) : q; return b * SEQ + t;
}
__device__ __forceinline__ int row_key(int b, int key) { return key < CTXL ? RL + b * CTXL + key : b * SEQ + (key - CTXL); }
__device__ __forceinline__ int mod_row(int r) { return r < RL ? (r >> 11) : NB; }
namespace pg8 {
#define PG8_LAS __attribute__((address_space(3)))
typedef unsigned short bf16_t;
typedef short bf16x8 __attribute__((ext_vector_type(8)));
typedef float f32x4 __attribute__((ext_vector_type(4)));
typedef unsigned u32x4 __attribute__((ext_vector_type(4)));
constexpr int BM = 256, BK = 64, HALF = 128, HTB = HALF * BK * 2  , STAGE_BYTES = 8 * HTB, NXCD = 8, WGM = 8;

__host__ __device__ __forceinline__ int lds_byte(int r, int c) { const int st = (r >> 4) * 2 + (c >> 5), rr = r & 15, cc = c & 31, ob = rr * 64 + cc * 2; return st * 1024 + (ob ^ (((ob >> 9) & 1) << 5)); }
__host__ __device__ __forceinline__ void stage_rc(int b, int& R, int& C) { const int st = b / 1024, sb = b % 1024, swz = sb ^ (((sb >> 9) & 1) << 5); R = (st >> 1) * 16 + swz / 64; C = (st & 1) * 32 + (swz % 64) / 2; }
__host__ __device__ __forceinline__ int perm32(int rho) { const int n = rho >> 4, i = rho & 15; return 8 * (i >> 2) + 4 * n + (i & 3); }

struct Unit { int pm, pn; };
struct Gemm { const bf16_t* A; const bf16_t* Bt; int M, N, K; int ld = 0, nsplit = 0, ablk = 0; };

struct StaticOrder {
    int nM, nN, nwg, G, c;
    __host__ __device__ void init(int M, int N, int G_, int c_) { nM = M / BM; nN = N / BM; nwg = nM * nN; G = G_; c = c_; }
    __host__ __device__ bool next(int i, Unit& u) const {
        const long L = (long)i * G + c; if (L >= nwg) return false;
        int wgid = (int)L; { const int q = nwg / NXCD, r = nwg % NXCD, xcd = wgid % NXCD, off = wgid / NXCD; wgid = (xcd < r ? xcd * (q + 1) : r * (q + 1) + (xcd - r) * q) + off; }
        const int nig = WGM * nN, gid = wgid / nig, fm = gid * WGM, gsz = (nM - fm) < WGM ? (nM - fm) : WGM;
        u.pm = fm + ((wgid % nig) % gsz); u.pn = (wgid % nig) / gsz; return true;
    }
    __device__ __forceinline__ void a_ready(const Unit&) const {}
    __device__ __forceinline__ void done(const Unit&) const {}
};

__device__ __forceinline__ unsigned cvt_pk_bf16(float lo, float hi) { unsigned r; asm volatile("v_cvt_pk_bf16_f32 %0, %1, %2" : "=v"(r) : "v"(lo), "v"(hi)); return r; }
typedef float f32x2 __attribute__((ext_vector_type(2)));
__device__ __forceinline__ float bf_lo(unsigned w) { return __builtin_bit_cast(float, w << 16); }
__device__ __forceinline__ float bf_hi(unsigned w) { return __builtin_bit_cast(float, w & 0xffff0000u); }
template <class T> __device__ __forceinline__ void st_stream(T* p, const T v) { if (EPI_NT) __builtin_nontemporal_store(v, p); else *p = v; }
struct EpiStoreBf16 {
    static constexpr bool PERM = true, AFTER_DRAIN = false;
    bf16_t* O; int ldc;
    __device__ __forceinline__ void operator()(const f32x4 (&acc)[2][2][4][2], const Unit& u, int wr, int wc, int fr, int fq) const {
        const int row0 = u.pm * BM + wr * 64 + fr, col0 = u.pn * BM + wc * 32 + 8 * fq;
#pragma unroll
        for (int ai = 0; ai < 2; ++ai)
#pragma unroll
            for (int m = 0; m < 4; ++m) { bf16_t* rowp = O + (size_t)(row0 + ai * HALF + m * 16) * ldc + col0;
#pragma unroll
                for (int bj = 0; bj < 2; ++bj) { const f32x4 v0 = acc[ai][bj][m][0], v1 = acc[ai][bj][m][1];
                    u32x4 w; w.x = cvt_pk_bf16(v0[0], v0[1]); w.y = cvt_pk_bf16(v0[2], v0[3]); w.z = cvt_pk_bf16(v1[0], v1[1]); w.w = cvt_pk_bf16(v1[2], v1[3]);
                    *(u32x4*)(rowp + bj * HALF) = w; } }
    }
};
struct EpiRelu2 {
    static constexpr bool PERM = true, AFTER_DRAIN = false;
    bf16_t* O; int ldc;
    __device__ __forceinline__ void operator()(const f32x4 (&acc)[2][2][4][2], const Unit& u, int wr, int wc, int fr, int fq) const {
        const int row0 = u.pm * BM + wr * 64 + fr, col0 = u.pn * BM + wc * 32 + 8 * fq;
#pragma unroll
        for (int ai = 0; ai < 2; ++ai)
#pragma unroll
            for (int m = 0; m < 4; ++m) { bf16_t* rowp = O + (size_t)(row0 + ai * HALF + m * 16) * ldc + col0;
#pragma unroll
                for (int bj = 0; bj < 2; ++bj) { f32x4 v0 = acc[ai][bj][m][0], v1 = acc[ai][bj][m][1];
#pragma unroll
                    for (int j = 0; j < 4; ++j) { const float a = fmaxf(v0[j], 0.f), b = fmaxf(v1[j], 0.f); v0[j] = a * a; v1[j] = b * b; }
                    u32x4 w; w.x = cvt_pk_bf16(v0[0], v0[1]); w.y = cvt_pk_bf16(v0[2], v0[3]); w.z = cvt_pk_bf16(v1[0], v1[1]); w.w = cvt_pk_bf16(v1[2], v1[3]);
                    *(u32x4*)(rowp + bj * HALF) = w; } }
    }
};
__device__ __forceinline__ void atomic_add_f32_dev(float* p, float v) { asm volatile("global_atomic_add_f32 %0, %1, off sc1" :: "v"(p), "v"(v) : "memory"); }
template <bool ATOMIC = false> struct EpiResT {
    static constexpr bool PERM = true, AFTER_DRAIN = false;
    const float* xin; float* xout; const float* gate; int row_base;
    __device__ __forceinline__ void operator()(const f32x4 (&acc)[2][2][4][2], const Unit& u, int wr, int wc, int fr, int fq) const {
        const int row0 = row_base + u.pm * BM + wr * 64 + fr, col0 = u.pn * BM + wc * 32 + 8 * fq;
        const int mrow = row0 < 32768 ? (row0 >> 11) : 16;
        const float* gp = gate + (size_t)mrow * 12288 + col0;
        f32x4 gv[2][2];
#pragma unroll
        for (int bj = 0; bj < 2; ++bj)
#pragma unroll
            for (int n = 0; n < 2; ++n) gv[bj][n] = *(const f32x4*)(gp + bj * HALF + n * 4);
#pragma unroll
        for (int ai = 0; ai < 2; ++ai) {
            f32x4 xv[4][2][2];
#pragma unroll
            for (int m = 0; m < 4; ++m) { const size_t off = (size_t)(row0 + ai * HALF + m * 16) * 2048 + col0;
#pragma unroll
                for (int bj = 0; bj < 2; ++bj)
#pragma unroll
                    for (int n = 0; n < 2; ++n) xv[m][bj][n] = *(const f32x4*)(xin + off + bj * HALF + n * 4); }
#pragma unroll
            for (int m = 0; m < 4; ++m) { const size_t off = (size_t)(row0 + ai * HALF + m * 16) * 2048 + col0;
#pragma unroll
                for (int bj = 0; bj < 2; ++bj)
#pragma unroll
                    for (int n = 0; n < 2; ++n) *(f32x4*)(xout + off + bj * HALF + n * 4) = xv[m][bj][n] + gv[bj][n] * acc[ai][bj][m][n]; }
            asm volatile("" ::: "memory");
        }
    }
};
typedef EpiResT<false> EpiRes;
__device__ __forceinline__ float sigm(float x) { return __builtin_amdgcn_rcpf(1.f + __expf(-x)); }
struct EpiGlu {
    static constexpr bool PERM = true, AFTER_DRAIN = false;
    const bf16_t* A5; bf16_t* Y; int ldy; const float* bias;
    __device__ __forceinline__ void operator()(const f32x4 (&acc)[2][2][4][2], const Unit& u, int wr, int wc, int fr, int fq) const {
        const int row0 = u.pm * BM + wr * 64 + fr, col0 = u.pn * BM + wc * 32 + 8 * fq;
        f32x4 bv[2][2];
#pragma unroll
        for (int bj = 0; bj < 2; ++bj)
#pragma unroll
            for (int n = 0; n < 2; ++n) bv[bj][n] = *(const f32x4*)(bias + col0 + bj * HALF + 4 * n);
#pragma unroll
        for (int ai = 0; ai < 2; ++ai)
#pragma unroll
            for (int m = 0; m < 4; ++m) { const int row = row0 + ai * HALF + m * 16;
#pragma unroll
                for (int bj = 0; bj < 2; ++bj) { const u32x4 aw = *(const u32x4*)(A5 + (size_t)row * 512 + col0 + bj * HALF);
                    const f32x4 v0 = acc[ai][bj][m][0] + bv[bj][0], v1 = acc[ai][bj][m][1] + bv[bj][1];
                    const float a0 = bf_lo(aw.x), a1 = bf_hi(aw.x), a2 = bf_lo(aw.y), a3 = bf_hi(aw.y), a4 = bf_lo(aw.z), a5 = bf_hi(aw.z), a6 = bf_lo(aw.w), a7 = bf_hi(aw.w);
                    u32x4 w; w.x = cvt_pk_bf16(a0 * sigm(v0[0]), a1 * sigm(v0[1])); w.y = cvt_pk_bf16(a2 * sigm(v0[2]), a3 * sigm(v0[3]));
                    w.z = cvt_pk_bf16(a4 * sigm(v1[0]), a5 * sigm(v1[1])); w.w = cvt_pk_bf16(a6 * sigm(v1[2]), a7 * sigm(v1[3]));
                    *(u32x4*)(Y + (size_t)row * ldy + col0 + bj * HALF) = w; } }
    }
};
struct EpiLru {
    static constexpr bool PERM = true, AFTER_DRAIN = false;
    const bf16_t* XS; bf16_t* LOGA; bf16_t* GB; const float* cst;
    __device__ __forceinline__ void operator()(const f32x4 (&acc)[2][2][4][2], const Unit& u, int wr, int wc, int fr, int fq) const {
        const int row0 = u.pm * BM + wr * 64 + fr, d = u.pn >> 2, nb = u.pn & 3, ch0 = nb * 128 + wc * 32 + 8 * fq;
        const float* cp = cst + d * 512 + ch0;
#pragma unroll
        for (int ai = 0; ai < 2; ++ai)
#pragma unroll
            for (int m = 0; m < 4; ++m) { const int row = row0 + ai * HALF + m * 16;
                const u32x4 xw = *(const u32x4*)(XS + (size_t)row * 512 + ch0);
                const float xs[8] = {bf_lo(xw.x), bf_hi(xw.x), bf_lo(xw.y), bf_hi(xw.y), bf_lo(xw.z), bf_hi(xw.z), bf_lo(xw.w), bf_hi(xw.w)};
#pragma unroll
                for (int n = 0; n < 2; ++n) { const f32x4 bav = *(const f32x4*)(cp + 4 * n), bxv = *(const f32x4*)(cp + 1024 + 4 * n), spv = *(const f32x4*)(cp + 2048 + 4 * n);
                    float la[4], gb[4];
#pragma unroll
                    for (int i = 0; i < 4; ++i) { const float r = sigm(acc[ai][0][m][n][i] + bav[i]), ig = sigm(acc[ai][1][m][n][i] + bxv[i]); const float l = -8.f * r * spv[i];
                        la[i] = l; const float x2 = 2.f * l;
                        const float em = -x2 * (1.f + 0.5f * x2 * (1.f + (1.f / 3.f) * x2 * (1.f + 0.25f * x2 * (1.f + 0.2f * x2 * (1.f + (1.f / 6.f) * x2)))));
                        gb[i] = __builtin_amdgcn_sqrtf(fmaxf(x2 > -0.25f ? em : 1.f - __expf(x2), 0.f)) * (ig * xs[4 * n + i]); }
                    typedef unsigned u32x2 __attribute__((ext_vector_type(2)));
                    u32x2 w1, w2; w1.x = cvt_pk_bf16(la[0], la[1]); w1.y = cvt_pk_bf16(la[2], la[3]); w2.x = cvt_pk_bf16(gb[0], gb[1]); w2.y = cvt_pk_bf16(gb[2], gb[3]);
                    *(u32x2*)(LOGA + (size_t)row * 1024 + d * 512 + ch0 + 4 * n) = w1; *(u32x2*)(GB + (size_t)row * 1024 + d * 512 + ch0 + 4 * n) = w2; }
                asm volatile("" ::: "memory"); }
    }
};
struct EpiNull {
    static constexpr bool PERM = false, AFTER_DRAIN = false;
    __device__ __forceinline__ void operator()(const f32x4 (&acc)[2][2][4][2], const Unit& u, int wr, int wc, int fr, int fq) const {
#pragma unroll
        for (int ai = 0; ai < 2; ++ai)
#pragma unroll
            for (int bj = 0; bj < 2; ++bj)
#pragma unroll
                for (int m = 0; m < 4; ++m)
#pragma unroll
                    for (int n = 0; n < 2; ++n) asm volatile("" :: "v"(acc[ai][bj][m][n]));
    }
};

template <bool XIN_F32> struct EpiResNT {
    static constexpr bool PERM = true, AFTER_DRAIN = false;
    const void* xin; const void* xin_ctx; bf16_t* xout; const float* gate; int row_base;
    bf16_t* H; const float* nw; const float* nscale; float* SSP;
    __device__ __forceinline__ void operator()(const f32x4 (&acc)[2][2][4][2], const Unit& u, int wr, int wc, int fr, int fq) const {
        const int row0 = row_base + u.pm * BM + wr * 64 + fr, col0 = u.pn * BM + wc * 32 + 8 * fq, lane = fq * 16 + fr;
        const int mrow = row0 < 32768 ? (row0 >> 11) : 16;
        const float* gp = gate + (size_t)mrow * 12288 + col0; const float* sp = nscale + (size_t)mrow * 12288 + col0; const void* xb = row0 < 32768 ? xin : xin_ctx;
        f32x4 gv[2][2], hs[2][2];
#pragma unroll
        for (int bj = 0; bj < 2; ++bj)
#pragma unroll
            for (int n = 0; n < 2; ++n) { gv[bj][n] = *(const f32x4*)(gp + bj * HALF + n * 4); hs[bj][n] = *(const f32x4*)(nw + col0 + bj * HALF + n * 4) * (*(const f32x4*)(sp + bj * HALF + n * 4) + 1.f); }
        constexpr int NB_ = XIN_F32 ? 4 : 2, MB_ = XIN_F32 ? 2 : 4;
#pragma unroll
        for (int am = 0; am < NB_; ++am) {
            const int ai = XIN_F32 ? (am >> 1) : am, mb = XIN_F32 ? 2 * (am & 1) : 0;
            f32x4 xv[XIN_F32 ? 2 : 1][2][2]; u32x4 xw[XIN_F32 ? 1 : 4][2];
#pragma unroll
            for (int mm = 0; mm < MB_; ++mm) { const int rowl = row0 + ai * HALF + (mb + mm) * 16; const size_t off = (size_t)rowl * 2048 + col0;
#pragma unroll
                for (int bj = 0; bj < 2; ++bj) {
                    if constexpr (XIN_F32) {
#pragma unroll
                        for (int n = 0; n < 2; ++n) xv[mm][bj][n] = *(const f32x4*)((const float*)xb + off + bj * HALF + n * 4); }
                    else xw[mm][bj] = *(const u32x4*)((const bf16_t*)xb + blk_off(rowl, col0, 8) + bj * HALF); } }
#pragma unroll
            for (int mm = 0; mm < MB_; ++mm) { const int m = mb + mm; const int row = row0 + ai * HALF + m * 16; const size_t off = blk_off(row, col0, 8); float ss = 0.f;
#pragma unroll
                for (int bj = 0; bj < 2; ++bj) { u32x4 w, xo;
#pragma unroll
                    for (int n = 0; n < 2; ++n) { f32x4 xi;
                        if constexpr (XIN_F32) xi = xv[mm][bj][n]; else xi = (f32x4){bf_lo(xw[mm][bj][2 * n]), bf_hi(xw[mm][bj][2 * n]), bf_lo(xw[mm][bj][2 * n + 1]), bf_hi(xw[mm][bj][2 * n + 1])};
                        const f32x4 xn = xi + gv[bj][n] * acc[ai][bj][m][n];
                        xo[2 * n] = cvt_pk_bf16(xn[0], xn[1]); xo[2 * n + 1] = cvt_pk_bf16(xn[2], xn[3]);
                        ss += (xn[0] * xn[0] + xn[1] * xn[1]) + (xn[2] * xn[2] + xn[3] * xn[3]);
                        const f32x4 hv = xn * hs[bj][n]; w[2 * n] = cvt_pk_bf16(hv[0], hv[1]); w[2 * n + 1] = cvt_pk_bf16(hv[2], hv[3]); }
                    st_stream((u32x4*)(xout + off + bj * HALF), xo);
                    st_stream((u32x4*)(H + off + bj * HALF), w); }
                ss += __builtin_bit_cast(float, __builtin_amdgcn_ds_bpermute((lane ^ 16) << 2, __builtin_bit_cast(int, ss)));
                ss += __builtin_bit_cast(float, __builtin_amdgcn_ds_bpermute((lane ^ 32) << 2, __builtin_bit_cast(int, ss)));
                if (fq == 0) SSP[(size_t)row * 32 + u.pn * 4 + wc] = ss; }
            asm volatile("" ::: "memory");
        }
    }
};
typedef EpiResNT<true> EpiResNF; typedef EpiResNT<false> EpiResN;
struct EpiResOut {
    static constexpr bool PERM = true, AFTER_DRAIN = false;
    const bf16_t* xin; float* xout; const float* gate; int row_base;
    __device__ __forceinline__ void operator()(const f32x4 (&acc)[2][2][4][2], const Unit& u, int wr, int wc, int fr, int fq) const {
        const int row0 = row_base + u.pm * BM + wr * 64 + fr, col0 = u.pn * BM + wc * 32 + 8 * fq;
        const int mrow = row0 < 32768 ? (row0 >> 11) : 16;
        const float* gp = gate + (size_t)mrow * 12288 + col0;
        f32x4 gv[2][2];
#pragma unroll
        for (int bj = 0; bj < 2; ++bj)
#pragma unroll
            for (int n = 0; n < 2; ++n) gv[bj][n] = *(const f32x4*)(gp + bj * HALF + n * 4);
#pragma unroll
        for (int ai = 0; ai < 2; ++ai) {
            u32x4 xw[4][2];
#pragma unroll
            for (int m = 0; m < 4; ++m) { const size_t off = blk_off(row0 + ai * HALF + m * 16, col0, 8);
#pragma unroll
                for (int bj = 0; bj < 2; ++bj) xw[m][bj] = *(const u32x4*)(xin + off + bj * HALF); }
#pragma unroll
            for (int m = 0; m < 4; ++m) { const size_t off = (size_t)(row0 + ai * HALF + m * 16) * 2048 + col0;
#pragma unroll
                for (int bj = 0; bj < 2; ++bj)
#pragma unroll
                    for (int n = 0; n < 2; ++n) { const f32x4 xi = (f32x4){bf_lo(xw[m][bj][2 * n]), bf_hi(xw[m][bj][2 * n]), bf_lo(xw[m][bj][2 * n + 1]), bf_hi(xw[m][bj][2 * n + 1])};
                        *(f32x4*)(xout + off + bj * HALF + n * 4) = xi + gv[bj][n] * acc[ai][bj][m][n]; } }
            asm volatile("" ::: "memory");
        }
    }
};
struct EpiStoreN {
    static constexpr bool PERM = true, AFTER_DRAIN = false;
    bf16_t* O; int ldc; const float* rstd; const float* shw; int ldshw;
    __device__ __forceinline__ void operator()(const f32x4 (&acc)[2][2][4][2], const Unit& u, int wr, int wc, int fr, int fq) const {
        const int row0 = u.pm * BM + wr * 64 + fr, col0 = u.pn * BM + wc * 32 + 8 * fq;
        const int mrow = row0 < 32768 ? (row0 >> 11) : 16;
        f32x4 sv[2][2];
#pragma unroll
        for (int bj = 0; bj < 2; ++bj)
#pragma unroll
            for (int n = 0; n < 2; ++n) sv[bj][n] = *(const f32x4*)(shw + (size_t)mrow * ldshw + col0 + bj * HALF + 4 * n);
#pragma unroll
        for (int ai = 0; ai < 2; ++ai)
#pragma unroll
            for (int m = 0; m < 4; ++m) { const int row = row0 + ai * HALF + m * 16; const float rs = rstd[row]; bf16_t* rowp = O + (size_t)row * ldc + col0;
#pragma unroll
                for (int bj = 0; bj < 2; ++bj) { const f32x4 v0 = acc[ai][bj][m][0] * rs + sv[bj][0], v1 = acc[ai][bj][m][1] * rs + sv[bj][1];
                    u32x4 w; w.x = cvt_pk_bf16(v0[0], v0[1]); w.y = cvt_pk_bf16(v0[2], v0[3]); w.z = cvt_pk_bf16(v1[0], v1[1]); w.w = cvt_pk_bf16(v1[2], v1[3]);
                    st_stream((u32x4*)(rowp + bj * HALF), w); } }
    }
};
struct EpiRelu2N {
    static constexpr bool PERM = true, AFTER_DRAIN = false;
    bf16_t* O; int ldc; const float* rstd; const float* shw; int ldshw; int row_base;
    __device__ __forceinline__ void operator()(const f32x4 (&acc)[2][2][4][2], const Unit& u, int wr, int wc, int fr, int fq) const {
        const int row0 = u.pm * BM + wr * 64 + fr, col0 = u.pn * BM + wc * 32 + 8 * fq, grow0 = row_base + row0;
        const int mrow = grow0 < 32768 ? (grow0 >> 11) : 16;
        f32x4 sv[2][2];
#pragma unroll
        for (int bj = 0; bj < 2; ++bj)
#pragma unroll
            for (int n = 0; n < 2; ++n) sv[bj][n] = *(const f32x4*)(shw + (size_t)mrow * ldshw + col0 + bj * HALF + 4 * n);
#pragma unroll
        for (int ai = 0; ai < 2; ++ai)
#pragma unroll
            for (int m = 0; m < 4; ++m) { const int row = row0 + ai * HALF + m * 16; const float rs = rstd[row_base + row]; bf16_t* rowp = O + blk_off(row, col0, ldc >> 8);
#pragma unroll
                for (int bj = 0; bj < 2; ++bj) { f32x4 v0 = acc[ai][bj][m][0] * rs + sv[bj][0], v1 = acc[ai][bj][m][1] * rs + sv[bj][1];
#pragma unroll
                    for (int j = 0; j < 4; ++j) { const float a = fmaxf(v0[j], 0.f), b = fmaxf(v1[j], 0.f); v0[j] = a * a; v1[j] = b * b; }
                    u32x4 w; w.x = cvt_pk_bf16(v0[0], v0[1]); w.y = cvt_pk_bf16(v0[2], v0[3]); w.z = cvt_pk_bf16(v1[0], v1[1]); w.w = cvt_pk_bf16(v1[2], v1[3]);
                    *(u32x4*)(rowp + bj * HALF) = w; } }
    }
};

struct EpiPart {
    static constexpr bool PERM = false, AFTER_DRAIN = false, VIRT = true;
    float* P; int ntile; int rows;
    __device__ __forceinline__ void operator()(const f32x4 (&acc)[2][2][4][2], const Unit& u, int wr, int wc, int fr, int fq) const {
        const int slice = u.pn / ntile, pn = u.pn % ntile, ld = 256 * ntile;
        const int row0 = u.pm * BM + wr * 64 + fr, col0 = pn * BM + wc * 32 + 4 * fq; float* base = P + (size_t)slice * rows * ld;
#pragma unroll
        for (int ai = 0; ai < 2; ++ai)
#pragma unroll
            for (int m = 0; m < 4; ++m) { float* rowp = base + (size_t)(row0 + ai * HALF + m * 16) * ld + col0;
#pragma unroll
                for (int bj = 0; bj < 2; ++bj)
#pragma unroll
                    for (int n = 0; n < 2; ++n) *(f32x4*)(rowp + bj * HALF + n * 16) = acc[ai][bj][m][n]; }
    }
};
template <class T, class = void> struct epi_virt { static constexpr bool value = false; };
template <class T> struct epi_virt<T, decltype((void)T::VIRT)> { static constexpr bool value = true; };
template <class Epi, class Sched, bool ALIGN_EPI = false, bool SP2 = false, int NSP = 0>
__device__ __forceinline__ void gemm_phase(PG8_LAS unsigned char* lds, const Gemm g, const Sched& S, const Epi& E, const int tid_in) {
    const int tid = tid_in,
    wid = __builtin_amdgcn_readfirstlane(tid >> 6), lane = tid & 63, wr = wid >> 2, wc = wid & 3, fr = lane & 15, fq = lane >> 4;
    const int K = g.K, nt = K / BK, LD = g.ld ? g.ld : g.K;
    const bool ablk = BLK_LAYOUT && g.ablk; const int LDA = ablk ? 256 : LD;
    unsigned voffA[2], voffB[2];
#pragma unroll
    for (int i = 0; i < 2; ++i) { int R, C; stage_rc(tid * 16 + i * 8192, R, C); const int Rb = Epi::PERM ? ((R & ~31) + perm32(R & 31)) : R;
        voffA[i] = (unsigned)(R * LDA + C) * 2u; voffB[i] = (unsigned)(Rb * LD + C) * 2u; }
    const size_t kstep = (size_t)(BK * 2);
    const size_t hstep = (size_t)HALF * LD * 2;
    const size_t hstepA = (size_t)HALF * LDA * 2;
#define PG8_KOFF(t) (ablk ? (((size_t)((t) >> 2) << 17) + (size_t)(((t) & 3) << 7)) : (size_t)(t) * kstep)
    const size_t tstep = 2 * hstep;
    const unsigned ldsw = (unsigned)wid * 1024u;
    const int aoff = lds_byte(wr * 64 + fr, fq * 8), boff = lds_byte(wc * 32 + fr, fq * 8);
#define PG8_SA(b, h) (((b) * 2 + (h)) * HTB)
#define PG8_SB(b, h) ((4 + (b) * 2 + (h)) * HTB)
#define PG8_STAGE(bufoff, gbase, voff) do { _Pragma("unroll") for (int _i = 0; _i < 2; ++_i) \
        __builtin_amdgcn_global_load_lds((const unsigned*)((const char*)(gbase) + (voff)[_i]), (PG8_LAS unsigned*)(lds + (bufoff) + ldsw + _i * 8192), 16, 0, 0); } while (0)
#define PG8_LDA(dst, b, h) do { _Pragma("unroll") for (int m = 0; m < 4; ++m) _Pragma("unroll") for (int k = 0; k < 2; ++k) dst[m][k] = *(const PG8_LAS bf16x8*)(lds + PG8_SA(b, h) + aoff + m * 2048 + k * 1024); } while (0)
#define PG8_LDB(dst, b, h) do { _Pragma("unroll") for (int n = 0; n < 2; ++n) _Pragma("unroll") for (int k = 0; k < 2; ++k) dst[n][k] = *(const PG8_LAS bf16x8*)(lds + PG8_SB(b, h) + boff + n * 2048 + k * 1024); } while (0)
#define PG8_MMA(ai, bj, At, Bt) do { __builtin_amdgcn_s_setprio(1); _Pragma("unroll") for (int m = 0; m < 4; ++m) _Pragma("unroll") for (int n = 0; n < 2; ++n) _Pragma("unroll") for (int k = 0; k < 2; ++k) \
        acc[ai][bj][m][n] = __builtin_amdgcn_mfma_f32_16x16x32_bf16(Bt[n][k], At[m][k], acc[ai][bj][m][n], 0, 0, 0); __builtin_amdgcn_s_setprio(0); } while (0)
#define PG8_WAIT_V(n) asm volatile("s_waitcnt vmcnt(" #n ")" ::: "memory")
#define PG8_WAIT_L(n) asm volatile("s_waitcnt lgkmcnt(" #n ")" ::: "memory")
#define PG8_BAR __builtin_amdgcn_s_barrier()
#define PG8_SCHED __builtin_amdgcn_sched_barrier(0)
    Unit cur, nxt; int ui = 0;
    if (!S.next(0, cur)) return;
    f32x4 acc[2][2][4][2];
    float zf = 0.f; asm volatile("" : "+v"(zf));
    const f32x4 zero4 = (f32x4){zf, zf, zf, zf};
#pragma unroll
    for (int a = 0; a < 2; ++a)
#pragma unroll
        for (int b = 0; b < 2; ++b)
#pragma unroll
            for (int m = 0; m < 4; ++m)
#pragma unroll
                for (int n = 0; n < 2; ++n) acc[a][b][m][n] = zero4;
    bf16x8 At[4][2], B0[2][2], B1[2][2];
#define PG8_SLICE(u) (NSP > 0 ? (u).pn / NSP : (NSP < 0 ? ((u).pn & (-NSP - 1)) : 0))
#define PG8_PNR(u) (NSP > 0 ? (u).pn % NSP : (u).pn)
#define PG8_ABASE(u) ((const char*)g.A + (size_t)(u).pm * tstep + (size_t)PG8_SLICE(u) * K * (ablk ? 512 : 2))
#define PG8_BBASE(u) ((const char*)g.Bt + (size_t)PG8_PNR(u) * tstep + (size_t)PG8_SLICE(u) * K * 2)
    const char* cA = PG8_ABASE(cur); const char* cB = PG8_BBASE(cur);
    S.a_ready(cur);
    if constexpr (SP2) {
        PG8_STAGE(PG8_SB(0, 0), cB, voffB); PG8_STAGE(PG8_SB(0, 1), cB + hstep, voffB); PG8_STAGE(PG8_SA(0, 0), cA, voffA); PG8_STAGE(PG8_SA(0, 1), cA + hstepA, voffA);
        if (wr == 1) PG8_BAR;
        PG8_WAIT_V(2); PG8_BAR;
        PG8_STAGE(PG8_SB(1, 0), cB + kstep, voffB); PG8_STAGE(PG8_SA(1, 0), cA + kstep, voffA); PG8_STAGE(PG8_SB(1, 1), cB + hstep + kstep, voffB);
        PG8_WAIT_V(6); PG8_BAR;
    } else {
        PG8_STAGE(PG8_SB(0, 0), cB, voffB); PG8_STAGE(PG8_SA(0, 0), cA, voffA); PG8_STAGE(PG8_SB(0, 1), cB + hstep, voffB); PG8_STAGE(PG8_SA(0, 1), cA + hstepA, voffA);
        if (wr == 1) PG8_BAR;
        PG8_WAIT_V(4); PG8_BAR;
        PG8_STAGE(PG8_SB(1, 0), cB + kstep, voffB); PG8_STAGE(PG8_SA(1, 0), cA + kstep, voffA); PG8_STAGE(PG8_SB(1, 1), cB + hstep + kstep, voffB);
        PG8_WAIT_V(6); PG8_BAR;
    }
    for (;;) {
        const bool has_next = S.next(ui + 1, nxt);
        const char* nA = has_next ? PG8_ABASE(nxt) : cA; const char* nB = has_next ? PG8_BBASE(nxt) : cB;
        for (int t = 0; t < nt; t += 2) {
            const bool last = (t == nt - 2);
            const char* a1 = cA + PG8_KOFF(t) + kstep;
            const char* a2 = last ? nA : cA + PG8_KOFF(t + 2); const char* b2 = last ? nB : cB + (size_t)(t + 2) * kstep;
            const char* a3 = a2 + kstep; const char* b3 = b2 + kstep;
            if (last && has_next) S.a_ready(nxt);
            if constexpr (SP2) {
            PG8_LDB(B0, 0, 0); PG8_LDB(B1, 0, 1); PG8_SCHED; PG8_LDA(At, 0, 0); PG8_STAGE(PG8_SA(1, 1), a1 + hstepA, voffA);
            PG8_WAIT_V(8); PG8_WAIT_L(0); PG8_BAR; PG8_MMA(0, 0, At, B0); PG8_MMA(0, 1, At, B1); PG8_BAR; PG8_SCHED;
            PG8_LDA(At, 0, 1); PG8_STAGE(PG8_SB(0, 0), b2, voffB); PG8_STAGE(PG8_SB(0, 1), b2 + hstep, voffB); PG8_STAGE(PG8_SA(0, 0), a2, voffA);
            PG8_WAIT_V(8); PG8_WAIT_L(0); PG8_BAR; PG8_MMA(1, 0, At, B0); PG8_MMA(1, 1, At, B1); PG8_BAR; PG8_SCHED;
            PG8_LDB(B0, 1, 0); PG8_LDB(B1, 1, 1); PG8_SCHED; PG8_LDA(At, 1, 0); PG8_STAGE(PG8_SA(0, 1), a2 + hstepA, voffA);
            PG8_WAIT_V(8); PG8_WAIT_L(0); PG8_BAR; PG8_MMA(0, 0, At, B0); PG8_MMA(0, 1, At, B1); PG8_BAR; PG8_SCHED;
            PG8_LDA(At, 1, 1); PG8_STAGE(PG8_SB(1, 0), b3, voffB); PG8_STAGE(PG8_SB(1, 1), b3 + hstep, voffB); PG8_STAGE(PG8_SA(1, 0), a3, voffA);
            PG8_WAIT_V(8); PG8_WAIT_L(0); PG8_BAR; PG8_MMA(1, 0, At, B0); PG8_MMA(1, 1, At, B1); PG8_BAR; PG8_SCHED;
            } else {
            PG8_LDB(B0, 0, 0); PG8_SCHED; PG8_LDA(At, 0, 0); PG8_STAGE(PG8_SA(1, 1), a1 + hstepA, voffA);
            PG8_WAIT_L(8); PG8_BAR; PG8_WAIT_L(0); PG8_MMA(0, 0, At, B0); PG8_BAR; PG8_SCHED;
            PG8_LDB(B1, 0, 1); PG8_STAGE(PG8_SB(0, 0), b2, voffB);
            PG8_BAR; PG8_WAIT_L(0); PG8_MMA(0, 1, At, B1); PG8_BAR;
            PG8_LDA(At, 0, 1); PG8_STAGE(PG8_SA(0, 0), a2, voffA);
            PG8_BAR; PG8_WAIT_L(0); PG8_MMA(1, 0, At, B0); PG8_BAR; PG8_SCHED;
            PG8_STAGE(PG8_SB(0, 1), b2 + hstep, voffB);
            PG8_WAIT_V(6); PG8_BAR; PG8_MMA(1, 1, At, B1); PG8_BAR;
            PG8_LDB(B0, 1, 0); PG8_SCHED; PG8_LDA(At, 1, 0); PG8_STAGE(PG8_SA(0, 1), a2 + hstepA, voffA);
            PG8_WAIT_L(8); PG8_BAR; PG8_WAIT_L(0); PG8_MMA(0, 0, At, B0); PG8_BAR; PG8_SCHED;
            PG8_LDB(B1, 1, 1); PG8_STAGE(PG8_SB(1, 0), b3, voffB);
            PG8_BAR; PG8_WAIT_L(0); PG8_MMA(0, 1, At, B1); PG8_BAR;
            PG8_LDA(At, 1, 1); PG8_STAGE(PG8_SA(1, 0), a3, voffA);
            PG8_BAR; PG8_WAIT_L(0); PG8_MMA(1, 0, At, B0); PG8_BAR; PG8_SCHED;
            PG8_STAGE(PG8_SB(1, 1), b3 + hstep, voffB);
            PG8_WAIT_V(6); PG8_BAR; PG8_MMA(1, 1, At, B1); PG8_BAR;
            }
        }
        if constexpr (ALIGN_EPI) { if (wr == 0) PG8_BAR; }
        if constexpr (!Epi::AFTER_DRAIN) { if constexpr (epi_virt<Epi>::value) E(acc, cur, wr, wc, fr, fq); else { const Unit eu{cur.pm, PG8_PNR(cur)}; E(acc, eu, wr, wc, fr, fq); } S.done(cur); }
        if (!has_next) break;
#pragma unroll
        for (int a = 0; a < 2; ++a)
#pragma unroll
            for (int b = 0; b < 2; ++b)
#pragma unroll
                for (int m = 0; m < 4; ++m)
#pragma unroll
                    for (int n = 0; n < 2; ++n) acc[a][b][m][n] = zero4;
        cur = nxt; cA = nA; cB = nB; ++ui;
        if constexpr (ALIGN_EPI) { if (wr == 1) PG8_BAR; }
    }
    PG8_WAIT_V(0);
    if constexpr (!ALIGN_EPI) { if (wr == 0) PG8_BAR; }
    PG8_BAR;
    if constexpr (Epi::AFTER_DRAIN) { E.fused(acc, cur, wr, wc, fr, fq, lds, wid, lane); S.done(cur); }
#undef PG8_SLICE
#undef PG8_PNR
#undef PG8_KOFF
#undef PG8_ABASE
#undef PG8_BBASE
#undef PG8_SA
#undef PG8_SB
#undef PG8_STAGE
#undef PG8_LDA
#undef PG8_LDB
#undef PG8_MMA
#undef PG8_WAIT_V
#undef PG8_WAIT_L
#undef PG8_BAR
#undef PG8_SCHED
}
}
namespace pg8 {
struct GrpDesc { const bf16_t* A; const bf16_t* Bt; int M, N, K, ld, bdiag; };
struct GUnit { int pm, pn, grp; };
__device__ __forceinline__ bool static_map(long L, int nM, int nN, Unit& u) {
    const int nwg = nM * nN; if (L >= nwg) return false;
    int wgid = (int)L; { const int q = nwg / NXCD, r = nwg % NXCD, xcd = wgid % NXCD, off = wgid / NXCD; wgid = (xcd < r ? xcd * (q + 1) : r * (q + 1) + (xcd - r) * q) + off; }
    const int nig = WGM * nN, gid = wgid / nig, fm = gid * WGM, gsz = (nM - fm) < WGM ? (nM - fm) : WGM;
    u.pm = fm + ((wgid % nig) % gsz); u.pn = (wgid % nig) / gsz; return true;
}
template <class E0, class E1, class E2>
__device__ __forceinline__ void gemm_group3(PG8_LAS unsigned char* lds, const GrpDesc g0, const GrpDesc g1, const GrpDesc g2, const E0& e0, const E1& e1, const E2& e2, const int Gn, const int c, const int tid_in) {
    static_assert(E0::PERM && E1::PERM && E2::PERM, "gemm_group3: the three epilogues must share the permuted weight staging");
    const int tid = tid_in, wid = __builtin_amdgcn_readfirstlane(tid >> 6), lane = tid & 63, wr = wid >> 2, wc = wid & 3, fr = lane & 15, fq = lane >> 4;
    const int n0 = (g0.M / BM) * (g0.N / BM), n1 = (g1.M / BM) * (g1.N / BM), n2 = (g2.M / BM) * (g2.N / BM);
    int sR[2], sRb[2], sC[2];
#pragma unroll
    for (int i = 0; i < 2; ++i) { int R, C; stage_rc(tid * 16 + i * 8192, R, C); sR[i] = R; sRb[i] = (R & ~31) + perm32(R & 31); sC[i] = C; }
    const size_t kstep = (size_t)(BK * 2);
    const unsigned ldsw = (unsigned)wid * 1024u;
    const int aoff = lds_byte(wr * 64 + fr, fq * 8), boff = lds_byte(wc * 32 + fr, fq * 8);
#define PG8_SA(b, h) (((b) * 2 + (h)) * HTB)
#define PG8_SB(b, h) ((4 + (b) * 2 + (h)) * HTB)
#define PG8_STAGE(bufoff, gbase, voff) do { _Pragma("unroll") for (int _i = 0; _i < 2; ++_i) \
        __builtin_amdgcn_global_load_lds((const unsigned*)((const char*)(gbase) + (voff)[_i]), (PG8_LAS unsigned*)(lds + (bufoff) + ldsw + _i * 8192), 16, 0, 0); } while (0)
#define PG8_LDA(dst, b, h) do { _Pragma("unroll") for (int m = 0; m < 4; ++m) _Pragma("unroll") for (int k = 0; k < 2; ++k) dst[m][k] = *(const PG8_LAS bf16x8*)(lds + PG8_SA(b, h) + aoff + m * 2048 + k * 1024); } while (0)
#define PG8_LDB(dst, b, h) do { _Pragma("unroll") for (int n = 0; n < 2; ++n) _Pragma("unroll") for (int k = 0; k < 2; ++k) dst[n][k] = *(const PG8_LAS bf16x8*)(lds + PG8_SB(b, h) + boff + n * 2048 + k * 1024); } while (0)
#define PG8_MMA(ai, bj, At, Bt) do { __builtin_amdgcn_s_setprio(1); _Pragma("unroll") for (int m = 0; m < 4; ++m) _Pragma("unroll") for (int n = 0; n < 2; ++n) _Pragma("unroll") for (int k = 0; k < 2; ++k) \
        acc[ai][bj][m][n] = __builtin_amdgcn_mfma_f32_16x16x32_bf16(Bt[n][k], At[m][k], acc[ai][bj][m][n], 0, 0, 0); __builtin_amdgcn_s_setprio(0); } while (0)
#define PG8_WAIT_V(n) asm volatile("s_waitcnt vmcnt(" #n ")" ::: "memory")
#define PG8_WAIT_L(n) asm volatile("s_waitcnt lgkmcnt(" #n ")" ::: "memory")
#define PG8_BAR __builtin_amdgcn_s_barrier()
#define PG8_SCHED __builtin_amdgcn_sched_barrier(0)
#define PG8_GETUNIT(L, u, ok) do { Unit t_; const long L_ = (L); ok = true; \
        if (L_ < n0) { static_map(L_, g0.M / BM, g0.N / BM, t_); u.grp = 0; } else if (L_ < n0 + n1) { static_map(L_ - n0, g1.M / BM, g1.N / BM, t_); u.grp = 1; } \
        else if (L_ < n0 + n1 + n2) { static_map(L_ - n0 - n1, g2.M / BM, g2.N / BM, t_); u.grp = 2; } else { ok = false; t_.pm = 0; t_.pn = 0; u.grp = 0; } u.pm = t_.pm; u.pn = t_.pn; } while (0)
#define PG8_GSEL(u, f) ((u).grp == 0 ? g0.f : ((u).grp == 1 ? g1.f : g2.f))
#define PG8_SETUNIT(u, pA, pB, ntv, ldv) do { const int ld_ = PG8_GSEL(u, ld), K_ = PG8_GSEL(u, K), bd_ = PG8_GSEL(u, bdiag); const int sl_ = bd_ ? ((u).pn & (bd_ - 1)) : 0; \
        pA = (const char*)PG8_GSEL(u, A) + (size_t)(u).pm * (size_t)(2 * HALF) * ld_ * 2 + (size_t)sl_ * K_ * 2; pB = (const char*)PG8_GSEL(u, Bt) + (size_t)(u).pn * (size_t)(2 * HALF) * ld_ * 2 + (size_t)sl_ * K_ * 2; ntv = K_ / BK; ldv = ld_; } while (0)
#define PG8_SETVOFF(vA, vB, ldv) do { _Pragma("unroll") for (int i = 0; i < 2; ++i) { vA[i] = (unsigned)(sR[i] * (ldv) + sC[i]) * 2u; vB[i] = (unsigned)(sRb[i] * (ldv) + sC[i]) * 2u; } } while (0)
    GUnit cur, nxt; int ui = 0; bool ok;
    PG8_GETUNIT((long)c, cur, ok);
    if (!ok) return;
    f32x4 acc[2][2][4][2];
    float zf = 0.f; asm volatile("" : "+v"(zf));
    const f32x4 zero4 = (f32x4){zf, zf, zf, zf};
#pragma unroll
    for (int a = 0; a < 2; ++a)
#pragma unroll
        for (int b = 0; b < 2; ++b)
#pragma unroll
            for (int m = 0; m < 4; ++m)
#pragma unroll
                for (int n = 0; n < 2; ++n) acc[a][b][m][n] = zero4;
    bf16x8 At[4][2], B0[2][2], B1[2][2];
    const char* cA; const char* cB; int nt, ldc_; PG8_SETUNIT(cur, cA, cB, nt, ldc_);
    unsigned voffA[2], voffB[2]; PG8_SETVOFF(voffA, voffB, ldc_);
    size_t hstep = (size_t)HALF * ldc_ * 2;
    PG8_STAGE(PG8_SB(0, 0), cB, voffB); PG8_STAGE(PG8_SB(0, 1), cB + hstep, voffB); PG8_STAGE(PG8_SA(0, 0), cA, voffA); PG8_STAGE(PG8_SA(0, 1), cA + hstep, voffA);
    if (wr == 1) PG8_BAR;
    PG8_WAIT_V(2); PG8_BAR;
    PG8_STAGE(PG8_SB(1, 0), cB + kstep, voffB); PG8_STAGE(PG8_SA(1, 0), cA + kstep, voffA); PG8_STAGE(PG8_SB(1, 1), cB + hstep + kstep, voffB);
    PG8_WAIT_V(6); PG8_BAR;
    for (;;) {
        bool has_next; PG8_GETUNIT((long)(ui + 1) * Gn + c, nxt, has_next);
        const char* nA = cA; const char* nB = cB; int ntn = nt, ldn = ldc_;
        if (has_next) PG8_SETUNIT(nxt, nA, nB, ntn, ldn);
        unsigned voffAn[2], voffBn[2]; PG8_SETVOFF(voffAn, voffBn, ldn);
        const size_t hstepn = (size_t)HALF * ldn * 2;
        for (int t = 0; t < nt; t += 2) {
            const bool last = (t == nt - 2);
            const char* a1 = cA + (size_t)(t + 1) * kstep;
            const char* a2 = last ? nA : cA + (size_t)(t + 2) * kstep; const char* b2 = last ? nB : cB + (size_t)(t + 2) * kstep;
            const char* a3 = a2 + kstep; const char* b3 = b2 + kstep;
            unsigned vA2[2], vB2[2];
#pragma unroll
            for (int i = 0; i < 2; ++i) { vA2[i] = last ? voffAn[i] : voffA[i]; vB2[i] = last ? voffBn[i] : voffB[i]; }
            const size_t h2 = last ? hstepn : hstep;
            PG8_LDB(B0, 0, 0); PG8_LDB(B1, 0, 1); PG8_SCHED; PG8_LDA(At, 0, 0); PG8_STAGE(PG8_SA(1, 1), a1 + hstep, voffA);
            PG8_WAIT_V(8); PG8_WAIT_L(0); PG8_BAR; PG8_MMA(0, 0, At, B0); PG8_MMA(0, 1, At, B1); PG8_BAR; PG8_SCHED;
            PG8_LDA(At, 0, 1); PG8_STAGE(PG8_SB(0, 0), b2, vB2); PG8_STAGE(PG8_SB(0, 1), b2 + h2, vB2); PG8_STAGE(PG8_SA(0, 0), a2, vA2);
            PG8_WAIT_V(8); PG8_WAIT_L(0); PG8_BAR; PG8_MMA(1, 0, At, B0); PG8_MMA(1, 1, At, B1); PG8_BAR; PG8_SCHED;
            PG8_LDB(B0, 1, 0); PG8_LDB(B1, 1, 1); PG8_SCHED; PG8_LDA(At, 1, 0); PG8_STAGE(PG8_SA(0, 1), a2 + h2, vA2);
            PG8_WAIT_V(8); PG8_WAIT_L(0); PG8_BAR; PG8_MMA(0, 0, At, B0); PG8_MMA(0, 1, At, B1); PG8_BAR; PG8_SCHED;
            PG8_LDA(At, 1, 1); PG8_STAGE(PG8_SB(1, 0), b3, vB2); PG8_STAGE(PG8_SB(1, 1), b3 + h2, vB2); PG8_STAGE(PG8_SA(1, 0), a3, vA2);
            PG8_WAIT_V(8); PG8_WAIT_L(0); PG8_BAR; PG8_MMA(1, 0, At, B0); PG8_MMA(1, 1, At, B1); PG8_BAR; PG8_SCHED;
        }
        if (wr == 0) PG8_BAR;
        { const Unit eu{cur.pm, cur.pn};
          if (cur.grp == 0) e0(acc, eu, wr, wc, fr, fq); else if (cur.grp == 1) e1(acc, eu, wr, wc, fr, fq); else e2(acc, eu, wr, wc, fr, fq); }
        if (!has_next) break;
#pragma unroll
        for (int a = 0; a < 2; ++a)
#pragma unroll
            for (int b = 0; b < 2; ++b)
#pragma unroll
                for (int m = 0; m < 4; ++m)
#pragma unroll
                    for (int n = 0; n < 2; ++n) acc[a][b][m][n] = zero4;
        cur = nxt; cA = nA; cB = nB; nt = ntn; ldc_ = ldn; hstep = hstepn;
#pragma unroll
        for (int i = 0; i < 2; ++i) { voffA[i] = voffAn[i]; voffB[i] = voffBn[i]; }
        ++ui;
        if (wr == 1) PG8_BAR;
    }
    PG8_WAIT_V(0);
    PG8_BAR;
#undef PG8_GETUNIT
#undef PG8_GSEL
#undef PG8_SETUNIT
#undef PG8_SETVOFF
#undef PG8_SA
#undef PG8_SB
#undef PG8_STAGE
#undef PG8_LDA
#undef PG8_LDB
#undef PG8_MMA
#undef PG8_WAIT_V
#undef PG8_WAIT_L
#undef PG8_BAR
#undef PG8_SCHED
}
}
#define XB_TMO      128
#define XB_XCNT(j)  (256  + 64 * (j))
#define XB_XSUB(j)  (1280 + 64 * (j))
#define XB_XGEN(j)  (2304 + 64 * (j))
#define XB_TOP      3328
#define XB_TOPGEN   3392
#define XCD_BAR_WORDS 3456
#define XB_SPIN_CAP (1u << 18)

__device__ __forceinline__ unsigned xb_ld(unsigned* p)              { return __hip_atomic_load(p, __ATOMIC_RELAXED, __HIP_MEMORY_SCOPE_AGENT); }
__device__ __forceinline__ unsigned xb_add(unsigned* p, unsigned v) { return __hip_atomic_fetch_add(p, v, __ATOMIC_RELAXED, __HIP_MEMORY_SCOPE_AGENT); }
__device__ __forceinline__ unsigned xb_xcc_id() { return (unsigned)__builtin_amdgcn_s_getreg((3 << 11) | 20) & 0xFu; }
#define XB_SPIN(cond, bar) do { unsigned _sp = 0; while (cond) { __builtin_amdgcn_s_sleep(1); \
    if ((++_sp & 255u) == 0u) { if (xb_ld(&(bar)[XB_TMO])) break; if (_sp > XB_SPIN_CAP) { atomicAdd(&(bar)[XB_TMO], 1u); break; } } } } while (0)

struct XcdBarrier {
    unsigned* bar; unsigned x;
    volatile LAS unsigned* st;
};

__device__ __forceinline__ XcdBarrier xcd_barrier_post(unsigned* bar, volatile LAS unsigned* st) {
    XcdBarrier b; b.bar = bar; b.x = xb_xcc_id(); b.st = st;
    if (threadIdx.x == 0) (void)xb_add(&bar[XB_XCNT(b.x)], 1u);
    return b;
}
__device__ __forceinline__ void xcd_barrier_complete(unsigned* bar, unsigned x, unsigned& nloc, unsigned& nx) {
    const unsigned G = gridDim.x * gridDim.y * gridDim.z;
    unsigned sum, cnt, mine, sp = 0u;
    for (;;) {
        sum = 0u; cnt = 0u; mine = 0u;
#pragma unroll
        for (unsigned j = 0; j < 16; ++j) { const unsigned c = xb_ld(&bar[XB_XCNT(j)]); sum += c; cnt += (c > 0u) ? 1u : 0u; mine = (j == x) ? c : mine; }
        if (sum == G) break;
        __builtin_amdgcn_s_sleep(1);
        if ((++sp & 255u) == 0u) { if (xb_ld(&bar[XB_TMO])) break; if (sp > XB_SPIN_CAP) { atomicAdd(&bar[XB_TMO], 1u); break; } }
    }
    nloc = mine > 0u ? mine : 1u; nx = cnt > 0u ? cnt : 1u;
}

__device__ __forceinline__ void xcd_barrier(const XcdBarrier& b) {
    asm volatile("s_waitcnt vmcnt(0)" ::: "memory");
    __syncthreads();
    if (threadIdx.x == 0) {
        unsigned* bar = b.bar;
        __builtin_amdgcn_s_waitcnt(0);
        unsigned nloc = b.st[0], nx = b.st[1];
        if (nloc == 0u) { xcd_barrier_complete(bar, b.x, nloc, nx); b.st[0] = nloc; b.st[1] = nx; }
        const unsigned old = xb_add(&bar[XB_XSUB(b.x)], 1u);
        const unsigned gen = old / nloc;
        if (old + 1u == (gen + 1u) * nloc) {
            __builtin_amdgcn_fence(__ATOMIC_RELEASE, "agent");
            asm volatile("s_waitcnt vmcnt(0)" ::: "memory");
            const unsigned og = xb_add(&bar[XB_TOP], 1u);
            const unsigned tg = og / nx;
            if (og + 1u == (tg + 1u) * nx) xb_add(&bar[XB_TOPGEN], 1u);
            else XB_SPIN(xb_ld(&bar[XB_TOPGEN]) == tg, bar);
            __builtin_amdgcn_fence(__ATOMIC_ACQUIRE, "agent");
            xb_add(&bar[XB_XGEN(b.x)], 1u);
            asm volatile("s_waitcnt vmcnt(0)" ::: "memory");
        } else {
            XB_SPIN(xb_ld(&bar[XB_XGEN(b.x)]) == gen, bar);
            __builtin_amdgcn_fence(__ATOMIC_ACQUIRE, "agent");
            asm volatile("s_waitcnt vmcnt(0)" ::: "memory");
        }
    }
    __syncthreads();
}
struct Args { const float* in[N_IN]; float* out; unsigned char* ws; int lo, hi; };
static_assert(sizeof(Args) == (N_IN + 2) * 8 + 8, "Args has no holes");
struct Frame {
    LAS unsigned char* lds;
    volatile LAS unsigned* MISC;
    gu32* ctl;
    int tid, lane, wave, G, bid;
    unsigned char* ws;
    const __attribute__((address_space(4))) char* kp;
    float* out;
};
#define WSP(T, off) ((T*)(F.ws + (off)))
typedef const GAS float* gcfptr_t;
#define KIN(i) ((const float*)(*(const __attribute__((address_space(4))) gcfptr_t*)(F.kp + 8 * (i))))

template <class LhsFn> __device__ __forceinline__ void skinny17_task(Frame& F, LhsFn lhs, const float* W, int N, int n0, float* out, int ldo, const float* bias) {
    LAS float* sh = (LAS float*)(F.lds + RING_OFF);
    const int lane = F.lane, bi = lane & 31, hk = lane >> 5, col = n0 + 32 * F.wave + bi, cc = min(col, N - 1);
    f32x16 acc;
#pragma unroll
    for (int e = 0; e < 16; ++e) acc[e] = 0.f;
    for (int kh = 0; kh < 2; ++kh) {
        __syncthreads();
        for (int idx = F.tid; idx < 17 * 1024; idx += NTHR) { const int b = idx >> 10, kk = idx & 1023; sh[b * 1025 + kk] = lhs(b, kh * 1024 + kk); }
        __syncthreads();
        const float* wp = W + (size_t)(kh * 1024 + hk) * N + cc; const LAS float* ap = sh + (bi < 17 ? bi : 0) * 1025 + hk;
#pragma unroll 8
        for (int ks = 0; ks < 512; ++ks) { const float bv = wp[(size_t)(2 * ks) * N]; float av = ap[2 * ks]; av = bi < 17 ? av : 0.f;
            acc = __builtin_amdgcn_mfma_f32_32x32x2f32(av, bv, acc, 0, 0, 0); }
    }
    if (col < N) { const float bz = bias ? bias[col] : 0.f;
#pragma unroll
        for (int r = 0; r < 16; ++r) { const int b = (r & 3) + 8 * (r >> 2) + 4 * hk; if (b < 17) out[(size_t)b * ldo + col] = acc[r] + bz; } }
}
__device__ __forceinline__ void p0a_prologue(Frame& F, const float* c, const float* cctx, const float* adaw, const float* adab,
                                             const float* lre, const float* lim, const float* ldt, const float* bre, const float* bim, const float* cre, const float* cim) {
    for (int t = F.bid; t < DEPTH * 48; t += F.G) { const int l = t / 48, n0 = (t % 48) * 256;
        skinny17_task(F, [&](int b, int k) { const float v = b < NB ? c[b * DM + k] : cctx[k]; return v / (1.f + __expf(-v)); },
                      adaw + (size_t)l * DM * NMOD, NMOD, n0, WSP(float, WS_MODS) + (size_t)l * 17 * NMOD, NMOD, adab + (size_t)l * NMOD); }
    __syncthreads();
    { float* RT_ = WSP(float, WS_ROPE);
      for (int i = F.bid * NTHR + F.tid; i < 1024; i += F.G * NTHR) { const int pos = i >> 4, fi = i & 15; const float inv = exp2f(-(float)fi * (13.287712379549449f / 16.f));
          float sn, cs; sincosf((float)pos * inv, &sn, &cs); RT_[2 * i] = cs; RT_[2 * i + 1] = sn; } }
    {
        float* S5A = WSP(float, WS_S5A); bf16* BB = WSP(bf16, WS_S5BB); bf16* CM = WSP(bf16, WS_S5CM);
        for (int i = F.bid * NTHR + F.tid; i < DEPTH * 2 * 32 * 64; i += F.G * NTHR) {
            const int p = i & 63, ldg = i >> 6;
            const float lr = fminf(lre[i], -1e-4f), li = lim[i], dt = __expf(ldt[ldg]);
            const float mag = expf(lr * dt), ar = mag * cosf(li * dt), ai = mag * sinf(li * dt);
            const float den = lr * lr + li * li, fr = ((ar - 1.f) * lr + ai * li) / den, fi = (ai * lr - (ar - 1.f) * li) / den;
            S5A[(size_t)i * 2] = ar; S5A[(size_t)i * 2 + 1] = ai;
            const int kre = (p & 31) + 64 * (p >> 5), kim = kre + 32;
            const int hre = 2 * (p & 31) + 64 * (p >> 5), him = hre + 1;
#pragma unroll
            for (int cc = 0; cc < 16; ++cc) { const float br = bre[(size_t)i * 16 + cc], bi = bim[(size_t)i * 16 + cc];
                BB[((size_t)ldg * 128 + kre) * 16 + cc] = (bf16)f2bf(fr * br - fi * bi); BB[((size_t)ldg * 128 + kim) * 16 + cc] = (bf16)f2bf(fr * bi + fi * br);
                CM[((size_t)ldg * 16 + cc) * 128 + hre] = (bf16)f2bf(cre[((size_t)ldg * 16 + cc) * 64 + p]); CM[((size_t)ldg * 16 + cc) * 128 + him] = (bf16)f2bf(-cim[((size_t)ldg * 16 + cc) * 64 + p]); }
        }
    }
}
__device__ __forceinline__ void p0c_shw(Frame& F, const float* win_all, const float* w1_all) {
    const float* MODS = WSP(float, WS_MODS); float* SHW = WSP(float, WS_SHW);
    for (int t = F.bid; t < DEPTH * 49; t += F.G) { const int l = t / 49, g = t % 49; const bool is1 = g >= 17; const int ish = is1 ? 3 : 0;
        const float* mp = MODS + (size_t)l * 17 * NMOD + ish * DM;
        skinny17_task(F, [&](int b, int k) { return mp[(size_t)b * NMOD + k]; },
                      is1 ? w1_all + (size_t)l * DM * DFF : win_all + (size_t)l * DM * NZ, is1 ? DFF : NZ, (is1 ? g - 17 : g) * 256,
                      SHW + (size_t)l * 17 * (LDZ + DFF) + (is1 ? LDZ : 0), LDZ + DFF, nullptr); }
    __syncthreads();
}
__device__ __forceinline__ void norm0_phase(Frame& F, const float* x, const float* ctx, const float* w, const float* mods  ) {
    bf16* H = WSP(bf16, WS_H); float* RSTD = WSP(float, WS_RSTD);
    const int gw = F.bid * NWAVES + F.wave, NGW = F.G * NWAVES, lane = F.lane;
    for (int r = gw; r < RT; r += NGW) {
        const float* xrow = r < RL ? x + (size_t)r * DM : ctx + (size_t)(r - RL) * DM; const float* sc = mods + (size_t)mod_row(r) * NMOD + 1 * DM;
        const f32x4* xr = (const f32x4*)xrow + lane; f32x4 v[8]; float s = 0.f;
#pragma unroll
        for (int j = 0; j < 8; ++j) { v[j] = xr[64 * j]; s += (v[j].x * v[j].x + v[j].y * v[j].y) + (v[j].z * v[j].z + v[j].w * v[j].w); }
        s = wave_sum(s, lane);
        if (lane == 0) RSTD[r] = rsqrtf(s * (1.f / DM) + EPS);
        v2u* o8 = (v2u*)(H + blk_off(r, 0, 8)) + lane; constexpr int JS = BLK_LAYOUT ? 16384 : 64;
#pragma unroll
        for (int j = 0; j < 8; ++j) { const int cix = 64 * j + lane; const f32x4 y = v[j] * ((const f32x4*)w)[cix] * (((const f32x4*)sc)[cix] + 1.f); v2u o; o.x = pk2(y.x, y.y); o.y = pk2(y.z, y.w); o8[JS * j] = o; }
    }
}
__device__ __forceinline__ void ctxfix_phase(Frame& F, const float* gate  , const float* w, const float* sc  ) {
    bf16* X = WSP(bf16, WS_X); const float* P = WSP(float, WS_LOGA); bf16* H = WSP(bf16, WS_H); float* RSTD = WSP(float, WS_RSTD);
    const int gw = F.bid * NWAVES + F.wave, NGW = F.G * NWAVES, lane = F.lane;
    for (int rc = gw; rc < RC; rc += NGW) { const int r = RL + rc;
        v2u* xr = (v2u*)(X + blk_off(r, 0, 8)) + lane; constexpr int JS = BLK_LAYOUT ? 16384 : 64; const f32x4* p0 = (const f32x4*)(P + (size_t)rc * DM) + lane; const f32x4* p1 = (const f32x4*)(P + (size_t)(RC + rc) * DM) + lane;
        f32x4 v[8]; float s = 0.f;
#pragma unroll
        for (int j = 0; j < 8; ++j) { const int cix = 64 * j + lane; const v2u xw = xr[JS * j]; const f32x4 xi = (f32x4){bflo(xw.x), bfhi(xw.x), bflo(xw.y), bfhi(xw.y)};
            v[j] = xi + ((const f32x4*)gate)[cix] * (p0[64 * j] + p1[64 * j]); s += (v[j].x * v[j].x + v[j].y * v[j].y) + (v[j].z * v[j].z + v[j].w * v[j].w); }
        s = wave_sum(s, lane);
        if (lane == 0) RSTD[r] = rsqrtf(s * (1.f / DM) + EPS);
        v2u* o8 = (v2u*)(H + blk_off(r, 0, 8)) + lane;
#pragma unroll
        for (int j = 0; j < 8; ++j) { const int cix = 64 * j + lane; v2u xo; xo.x = pk2(v[j].x, v[j].y); xo.y = pk2(v[j].z, v[j].w); xr[JS * j] = xo;
            const f32x4 y = v[j] * ((const f32x4*)w)[cix] * (((const f32x4*)sc)[cix] + 1.f); v2u o; o.x = pk2(y.x, y.y); o.y = pk2(y.z, y.w); o8[JS * j] = o; }
    }
}
__device__ __forceinline__ void rstd_phase(Frame& F, int nrows) {
    const float* SSP = WSP(float, WS_SSP); float* RSTD = WSP(float, WS_RSTD);
    for (int r = F.bid * NTHR + F.tid; r < nrows; r += F.G * NTHR) { const f32x4* sp = (const f32x4*)(SSP + (size_t)r * 32); float s = 0.f;
#pragma unroll
        for (int j = 0; j < 8; ++j) { const f32x4 v = sp[j]; s += (v.x + v.y) + (v.z + v.w); }
        RSTD[r] = rsqrtf(s * (1.f / DM) + EPS); }
}
__device__ __forceinline__ void transpose_item(const float* W, int K, int N, bf16* WT, int ldt, LAS float* scr, int item, int lane) {
    const int nblk = (N + 31) / 32, kb = item / nblk, nb = item % nblk, k0 = 64 * kb, n0 = 32 * nb;
    const int nr = min(n0 + (lane & 31), N - 1);
#pragma unroll 8
    for (int i = 0; i < 32; ++i) { const int kk = 2 * i + (lane >> 5); scr[kk * 33 + (lane & 31)] = W[(size_t)(k0 + kk) * N + nr]; }
    LDS_WAIT(); asm volatile("" ::: "memory");
    const int cch = lane & 7;
#pragma unroll
    for (int j = 0; j < 4; ++j) { const int n = (lane >> 3) + 8 * j; const LAS float* s = scr + (8 * cch) * 33 + n;
        v4u o; o.x = pk2(s[0 * 33], s[1 * 33]); o.y = pk2(s[2 * 33], s[3 * 33]); o.z = pk2(s[4 * 33], s[5 * 33]); o.w = pk2(s[6 * 33], s[7 * 33]);
        if (n0 + n < N) *(v4u*)(WT + (size_t)(n0 + n) * ldt + k0 + 8 * cch) = o; }
    LDS_WAIT(); asm volatile("" ::: "memory");
}
__device__ __forceinline__ void norm_row(const float* xrow, bf16* orow, const float* w, const float* shift, const float* scale, int lane) {
    const f32x4* xr = (const f32x4*)xrow + lane;
    f32x4 v[8]; float s = 0.f;
#pragma unroll
    for (int j = 0; j < 8; ++j) { v[j] = xr[64 * j]; s += (v[j].x * v[j].x + v[j].y * v[j].y) + (v[j].z * v[j].z + v[j].w * v[j].w); }
    const float rstd = rsqrtf(wave_sum(s, lane) * (1.f / DM) + EPS);
    v2u* o8 = (v2u*)orow + lane;
#pragma unroll
    for (int j = 0; j < 8; ++j) { const int cix = 64 * j + lane; const f32x4 wv = ((const f32x4*)w)[cix], sh = ((const f32x4*)shift)[cix], sc = ((const f32x4*)scale)[cix];
        const f32x4 y = v[j] * rstd * wv * (sc + 1.f) + sh; v2u o; o.x = pk2(y.x, y.y); o.y = pk2(y.z, y.w); o8[64 * j] = o; }
}
__device__ __forceinline__ void norm_phase(Frame& F, const float* X, bf16* H, const float* w, const float* mods  , int ishift, int iscale, int nrows) {
    const int gw = F.bid * NWAVES + F.wave, NGW = F.G * NWAVES;
    for (int r = gw; r < nrows; r += NGW) { const float* mp = mods + (size_t)mod_row(r) * NMOD;
        norm_row(X + (size_t)r * DM, H + (size_t)r * DM, w, mp + ishift * DM, mp + iscale * DM, F.lane); }
}
constexpr int CV_1 = 32 * 256, CV_2 = 128 * 64, CV_OUT = 32 * 64, CV_G = 8 * 16, CV_OWN = CV_1 + CV_2 + CV_OUT + CV_G, CV_IN = 32 * 131, CV_Q = 6 * 24, CV_KV = 2 * 32, CV_NEXT = CV_IN + CV_Q + CV_KV;
__device__ __forceinline__ void convert_item(Frame& F, const Args& A, int lo, int ln, int it, LAS float* scr) {
    int r = it;
    if (r < CV_OWN) { if (lo < 0) return;
        if (r < CV_1) { transpose_item(KIN(I_W1) + (size_t)lo * DM * DFF, DM, DFF, WSP(bf16, WS_W1), DM, scr, r, F.lane); return; } r -= CV_1;
        if (r < CV_2) { transpose_item(KIN(I_W2) + (size_t)lo * DFF * DM, DFF, DM, WSP(bf16, WS_W2), DFF, scr, r, F.lane); return; } r -= CV_2;
        if (r < CV_OUT) { transpose_item(KIN(I_WOUT) + (size_t)lo * DM * DM, DM, DM, WSP(bf16, WS_WOUT), DM, scr, r, F.lane); return; } r -= CV_OUT;
        transpose_item(KIN(I_S5GLUW) + (size_t)lo * 512 * 512, 512, 512, WSP(bf16, WS_WGLU), 512, scr, r, F.lane); return; }
    r -= CV_OWN; if (ln >= DEPTH) return;
    if (r < CV_IN) { transpose_item(KIN(I_WIN) + (size_t)ln * DM * NZ, DM, NZ, WSP(bf16, WS_WIN), DM, scr, r, F.lane); return; } r -= CV_IN;
    if (r < CV_Q) { transpose_item(KIN(I_WQUP) + (size_t)ln * 384 * 768, 384, 768, WSP(bf16, WS_WQUP), 384, scr, r, F.lane); return; } r -= CV_Q;
    transpose_item(KIN(I_WKVUP) + (size_t)ln * 128 * 1024, 128, 1024, WSP(bf16, WS_WKVUP), 256, scr, r, F.lane);
}
__device__ __forceinline__ void convert_misc(Frame& F, const Args& A, int ln, int t0, int nt) {
    if (ln >= DEPTH) return;
    { v4u* p = WSP(v4u, WS_WKVUP); const v4u z4 = zero_v4u(); for (int i = t0; i < 1024 * 16; i += nt) { const int n = i >> 4, c8 = i & 15; p[(size_t)n * 32 + 16 + c8] = z4; } }
    { float* cst = WSP(float, WS_LRUC); const float* ba = KIN(I_LBA) + (size_t)ln * 1024; const float* bx = KIN(I_LBX) + (size_t)ln * 1024; const float* lam = KIN(I_LLAM) + (size_t)ln * 1024;
      for (int i = t0; i < 1024; i += nt) { cst[i] = ba[i]; cst[1024 + i] = bx[i]; cst[2048 + i] = softplusf_(-lam[i]); } }
    { const float* wa = KIN(I_LWA) + (size_t)ln * 2 * 4 * 128 * 128; const float* wx = KIN(I_LWX) + (size_t)ln * 2 * 4 * 128 * 128; v4u* p = WSP(v4u, WS_WLRU);
      for (int i = t0; i < 2048 * 64; i += nt) { const int cidx = i >> 6, k8 = (i & 63) * 8; const int pn = cidx >> 8, type = (cidx >> 7) & 1, j = cidx & 127, d = pn >> 2, nb = pn & 3;
          v4u o = zero_v4u();
          if ((k8 >> 7) == nb) { const float* src = (type ? wx : wa) + ((size_t)(d * 4 + nb) * 128 + (k8 & 127)) * 128 + j;
              o.x = pk2(src[0 * 128], src[1 * 128]); o.y = pk2(src[2 * 128], src[3 * 128]); o.z = pk2(src[4 * 128], src[5 * 128]); o.w = pk2(src[6 * 128], src[7 * 128]); }
          p[i] = o; } }
}
__device__ __forceinline__ void convert_weights(Frame& F, const Args& A, int lo, int ln) {
    LAS float* scr = (LAS float*)(F.lds + RING_OFF + F.wave * 16384);
    for (int it = F.bid * NWAVES + F.wave; it < CV_OWN + CV_NEXT; it += F.G * NWAVES) convert_item(F, A, lo, ln, it, scr);
    convert_misc(F, A, ln, F.bid * NTHR + F.tid, F.G * NTHR);
}
constexpr int CV_UNITS = (CV_OWN + CV_NEXT + 63) / 64 + 1;
__device__ __forceinline__ void convert_unit(Frame& F, const Args& A, int lo, int ln, int cu) {
    if (cu == CV_UNITS - 1) { convert_misc(F, A, ln, F.tid, NTHR); return; }
    LAS float* scr = (LAS float*)(F.lds + RING_OFF + F.wave * 16384);
    for (int j = 0; j < 8; ++j) { const int it = cu * 64 + j * 8 + F.wave; if (it < CV_OWN + CV_NEXT) convert_item(F, A, lo, ln, it, scr); }
}
__device__ __forceinline__ void prep_phase(Frame& F, const Args& A, int l) {
    const bf16* Z = WSP(bf16, WS_Z); bf16* XS = WSP(bf16, WS_XS); bf16* AQ = WSP(bf16, WS_AQ); bf16* AKV = WSP(bf16, WS_AKV);
    const float* cw = KIN(I_LCW) + (size_t)l * 4 * 512; const float* cb = KIN(I_LCB) + (size_t)l * 512;
    const float* qan = KIN(I_QAN) + (size_t)l * 384; const float* kvan = KIN(I_KVAN) + (size_t)l * 128;
    for (size_t i = (size_t)F.bid * NTHR + F.tid; i < (size_t)RT * 64; i += (size_t)F.G * NTHR) {
        const int r = (int)(i >> 6), c8 = (int)(i & 63) * 8;
        int t, len; if (r < RL) { t = r & (SEQ - 1); len = SEQ; } else { t = (r - RL) & (CTXL - 1); len = CTXL; }
        float acc[8];
#pragma unroll
        for (int j = 0; j < 8; ++j) acc[j] = cb[c8 + j];
#pragma unroll
        for (int tap = 0; tap < 4; ++tap) { const int tt = t + tap - 2;
            if (tt >= 0 && tt < len) { const v4u w = *(const v4u*)(Z + (size_t)(r + tap - 2) * LDZ + ZLX + c8); float f[8]; unpack8(w, f);
#pragma unroll
                for (int j = 0; j < 8; ++j) acc[j] += f[j] * cw[tap * 512 + c8 + j]; } }
        *(v4u*)(XS + (size_t)r * 512 + c8) = pack8(acc);
    }
    const int gw = F.bid * NWAVES + F.wave, NGW = F.G * NWAVES;
    for (int r = gw; r < RT; r += NGW) {
        const bool isq = F.lane < 48; const int e0 = isq ? F.lane * 8 : (F.lane - 48) * 8;
        const v4u w = *(const v4u*)(Z + (size_t)r * LDZ + (isq ? ZCQ : ZCKV) + e0); float f[8]; unpack8(w, f);
        float ss = 0.f;
#pragma unroll
        for (int j = 0; j < 8; ++j) ss += f[j] * f[j];
        const float sq = wave_sum(isq ? ss : 0.f, F.lane), skv = wave_sum(isq ? 0.f : ss, F.lane);
        const float rstd = isq ? rsqrtf(sq * (1.f / 384.f) + EPS) : rsqrtf(skv * (1.f / 128.f) + EPS);
        const float* nw = isq ? qan + e0 : kvan + e0;
#pragma unroll
        for (int j = 0; j < 8; ++j) f[j] = f[j] * rstd * nw[j];
        if (isq) *(v4u*)(AQ + (size_t)r * 384 + e0) = pack8(f);
        else { *(v4u*)(AKV + (size_t)r * 256 + e0) = pack8(f); *(v4u*)(AKV + (size_t)r * 256 + 128 + e0) = zero_v4u(); }
    }
}
constexpr float ATTN_SCALE_LOG2E = 0.07216878364870322f * 1.4426950408889634f;
__device__ __forceinline__ void rope8(float (&f)[8], int li, int t, int lane, const float* rope) {
    const bool second = (li & 2) != 0;
    const int pos = (li < 20) ? (t >> 6) : (t & 63);
    const f32x4* tp = (const f32x4*)(rope + (size_t)(pos * 16 + 8 * (li & 1)) * 2);
    const f32x4 t0 = tp[0], t1 = tp[1], t2 = tp[2], t3 = tp[3];
    const float cs[8] = {t0.x, t0.z, t1.x, t1.z, t2.x, t2.z, t3.x, t3.z}, sn[8] = {t0.y, t0.w, t1.y, t1.w, t2.y, t2.w, t3.y, t3.w};
    float o[8];
#pragma unroll
    for (int j = 0; j < 8; ++j) { const float other = shx(f[j], 2, lane); o[j] = second ? (f[j] * cs[j] + other * sn[j]) : (f[j] * cs[j] - other * sn[j]); }
#pragma unroll
    for (int j = 0; j < 8; ++j) f[j] = o[j];
}
__device__ __forceinline__ void mla_finish(Frame& F, const Args& A, int l, bool need_ctx, int wg0, int nwg) {
    const bf16* Z = WSP(bf16, WS_Z); const bf16* KVRAW = WSP(bf16, WS_KVRAW); bf16* K = WSP(bf16, WS_K);
    const float* kn = KIN(I_KN) + (size_t)l * 192; const float* rope = WSP(float, WS_ROPE);
    const int gw = (F.bid - wg0) * NWAVES + F.wave, NGW = nwg * NWAVES;
    const int li = F.lane & 31, hh = F.lane >> 5; const bool act = li < 24;
    float knw[8];
#pragma unroll
    for (int j = 0; j < 8; ++j) knw[j] = act ? kn[8 * li + j] : 0.f;
    for (int r = gw; r < RT; r += NGW) {
        const bool lat = r < RL; const int t = r & (SEQ - 1);
        v4u wk[2];
#pragma unroll
        for (int it = 0; it < 2; ++it) { const int h = it * 2 + hh;
            wk[it] = li < 16 ? *(const v4u*)(KVRAW + (size_t)r * 1024 + h * 256 + 8 * li) : (li < 24 ? *(const v4u*)(Z + (size_t)r * LDZ + ZKR + 8 * (li - 16)) : zero_v4u()); }
        int b, key; if (lat) { b = r >> 11; key = CTXL + t; } else { b = (r - RL) >> 8; key = (r - RL) & (CTXL - 1); }
#pragma unroll
        for (int it = 0; it < 2; ++it) { const int h = it * 2 + hh;
            float g[8]; unpack8(wk[it], g);
            float sk = 0.f;
#pragma unroll
            for (int j = 0; j < 8; ++j) sk += g[j] * g[j];
#pragma unroll
            for (int o = 1; o < 32; o <<= 1) sk += shx(sk, o, F.lane);
            const float rk = rsqrtf(sk * (1.f / 192.f) + EPS);
#pragma unroll
            for (int j = 0; j < 8; ++j) g[j] = g[j] * rk * knw[j];
            if (lat) { if (li >= 16 && li < 24) rope8(g, li, t, F.lane, rope); }
            if (act) *(v4u*)(K + ((size_t)b * TOK + key) * 768 + h * 192 + 8 * li) = pack8(g);
        }
    }
}
template <bool FINAL> __device__ __forceinline__ void lru_chunk(Frame& F, int wunit) {
    const bf16* LOGA = WSP(bf16, WS_LOGA); const bf16* GB = WSP(bf16, WS_GB); bf16* LH = WSP(bf16, WS_LH); float* SUM = WSP(float, WS_LSUM);
    const int b = wunit / 72, d = (wunit / 36) & 1, c = wunit % 36, c8 = 8 * F.lane, step = d ? -1 : 1;
    const int r0 = row_scan(b, d, 64 * c);
    float* sp = SUM + ((size_t)((b * 2 + d) * 36) * 2) * 512 + c8;
    float h[8], P[8];
#pragma unroll
    for (int j = 0; j < 8; ++j) { h[j] = 0.f; P[j] = 0.f; }
    if (FINAL) {
        for (int cc = 0; cc < c; ++cc) { const f32x4 p0 = *(const f32x4*)(sp + (size_t)cc * 1024), p1 = *(const f32x4*)(sp + (size_t)cc * 1024 + 4), e0 = *(const f32x4*)(sp + (size_t)cc * 1024 + 512), e1 = *(const f32x4*)(sp + (size_t)cc * 1024 + 516);
#pragma unroll
            for (int j = 0; j < 4; ++j) { h[j] = __expf(p0[j]) * h[j] + e0[j]; h[4 + j] = __expf(p1[j]) * h[4 + j] + e1[j]; } }
    }
    const bf16* lap = LOGA + d * 512 + c8; const bf16* gbp = GB + d * 512 + c8; bf16* lhp = LH + (size_t)d * RT * 512 + c8;
    for (int t0 = 0; t0 < 64; t0 += 8) {
        v4u la[8], gb[8];
#pragma unroll
        for (int j = 0; j < 8; ++j) { const size_t row = (size_t)(r0 + step * (t0 + j)); la[j] = *(const v4u*)(lap + row * 1024); gb[j] = *(const v4u*)(gbp + row * 1024); }
#pragma unroll
        for (int j = 0; j < 8; ++j) { float a[8], g[8]; unpack8(la[j], a); unpack8(gb[j], g);
#pragma unroll
            for (int e = 0; e < 8; ++e) { h[e] = __expf(a[e]) * h[e] + g[e]; if (!FINAL) P[e] += a[e]; }
            if (FINAL) *(v4u*)(lhp + (size_t)(r0 + step * (t0 + j)) * 512) = pack8(h); }
    }
    if (!FINAL) { float* o = sp + (size_t)c * 1024;
        *(f32x4*)(o) = (f32x4){P[0], P[1], P[2], P[3]}; *(f32x4*)(o + 4) = (f32x4){P[4], P[5], P[6], P[7]};
        *(f32x4*)(o + 512) = (f32x4){h[0], h[1], h[2], h[3]}; *(f32x4*)(o + 516) = (f32x4){h[4], h[5], h[6], h[7]}; }
}
template <bool DO_S5, bool DO_REST> __device__ __forceinline__ void finish_phase(Frame& F, const Args& A, int l, int nrows) {
    const bf16* Z = WSP(bf16, WS_Z); bf16* Y = WSP(bf16, WS_Y); bf16* A5 = WSP(bf16, WS_A5);
    const bf16* YS = WSP(bf16, WS_YS); const bf16* MH = WSP(bf16, WS_MH); const bf16* LH = WSP(bf16, WS_LH);
    const float* s5d = KIN(I_S5D) + (size_t)l * 512; const float* on = KIN(I_MLON) + (size_t)l * 512;
    const int gw = F.bid * NWAVES + F.wave, NGW = F.G * NWAVES; const int c8 = F.lane * 8;
    for (int r = gw; r < nrows; r += NGW) {
        float a[8], b[8], o[8];
        if (DO_S5) { unpack8(*(const v4u*)(YS + (size_t)r * 512 + c8), a); unpack8(*(const v4u*)(YS + ((size_t)RT + r) * 512 + c8), b); unpack8(*(const v4u*)(Z + (size_t)r * LDZ + ZU + c8), o);
#pragma unroll
          for (int j = 0; j < 8; ++j) a[j] = gelu_tanh(a[j] + b[j] + s5d[c8 + j] * o[j]);
          *(v4u*)(A5 + (size_t)r * 512 + c8) = pack8(a); }
        if (DO_REST) { unpack8(*(const v4u*)(LH + (size_t)r * 512 + c8), a); unpack8(*(const v4u*)(LH + ((size_t)RT + r) * 512 + c8), b); unpack8(*(const v4u*)(Z + (size_t)r * LDZ + ZLG + c8), o);
#pragma unroll
          for (int j = 0; j < 8; ++j) a[j] = (a[j] + b[j]) * gelu_tanh(o[j]);
          *(v4u*)(Y + (size_t)r * DM + 1536 + c8) = pack8(a); }
        if (DO_REST) { unpack8(*(const v4u*)(MH + (size_t)r * 512 + c8), a); unpack8(*(const v4u*)(MH + ((size_t)RT + r) * 512 + c8), b); unpack8(*(const v4u*)(Z + (size_t)r * LDZ + ZMO + c8), o);
          float ss = 0.f;
#pragma unroll
          for (int j = 0; j < 8; ++j) { a[j] += b[j]; ss += a[j] * a[j]; }
#pragma unroll
          for (int s = 1; s < 16; s <<= 1) ss += shx(ss, s, F.lane);
          const float rstd = rsqrtf(ss * (1.f / 128.f) + EPS);
#pragma unroll
          for (int j = 0; j < 8; ++j) a[j] = a[j] * rstd * on[c8 + j] * sigmoidf_(o[j]);
          *(v4u*)(Y + (size_t)r * DM + 512 + c8) = pack8(a); }
    }
}
#define MFMA16(a, b, c) __builtin_amdgcn_mfma_f32_16x16x32_bf16((a), (b), (c), 0, 0, 0)
#define MFMA32(a, b, c) __builtin_amdgcn_mfma_f32_32x32x16_bf16((a), (b), (c), 0, 0, 0)
__device__ __forceinline__ bf16x8 ldsfrag(const LAS bf16* p) { return *(const LAS bf16x8*)p; }

__device__ __forceinline__ void s5_scan(Frame& F, int l, int unit, int d) {
    const bf16* Z = WSP(bf16, WS_Z); bf16* YS = WSP(bf16, WS_YS);
    const float* S5A = WSP(float, WS_S5A); const bf16* BB = WSP(bf16, WS_S5BB); const bf16* CM = WSP(bf16, WS_S5CM);
    LAS bf16* Hs = (LAS bf16*)(F.lds + RING_OFF + F.wave * 8704);
    const int lane = F.lane, j = lane & 31, hl = lane >> 5, i16 = lane & 15, q4 = lane >> 4;
    const int hb = (j >> 2) & 1, tt = (j & 3) + 4 * (j >> 3);
    bf16* A5 = WSP(bf16, WS_A5); const float* s5d = KIN(I_S5D) + (size_t)l * 512;
    {
        const int bp = unit & 7, g = unit >> 3, b0 = 2 * bp, ldg = (l * 2 + d) * 32 + g;
        bf16x8 Bf[4], Cf[4];
#pragma unroll
        for (int t = 0; t < 4; ++t) { Bf[t] = *(const bf16x8*)(BB + ((size_t)ldg * 128 + t * 32 + j) * 16 + 8 * hl); Cf[t] = *(const bf16x8*)(CM + ((size_t)ldg * 16 + i16) * 128 + 32 * t + 8 * q4); }
        const float ar0 = S5A[((size_t)ldg * 64 + j) * 2], ai0 = S5A[((size_t)ldg * 64 + j) * 2 + 1], ar1 = S5A[((size_t)ldg * 64 + j + 32) * 2], ai1 = S5A[((size_t)ldg * 64 + j + 32) * 2 + 1];
        float hr0 = 0.f, hi0 = 0.f, hr1 = 0.f, hi1 = 0.f;
        const bf16* zu = Z + ZU + g * 16 + 8 * hl;
        bf16x8 a0 = *(const bf16x8*)(zu + (size_t)row_scan(b0 + hb, d, tt) * LDZ);
        bf16x8 a1 = *(const bf16x8*)(zu + (size_t)row_scan(b0 + hb, d, 16 + tt) * LDZ);
        for (int blk = 0; blk < TOK / 16; ++blk) {
            const int p0 = blk * 16, pn = min(blk + 2, TOK / 16 - 1) * 16;
            if (blk == CTXL / 32 || blk == CTXL / 16 + SEQ / 32) { asm volatile("s_waitcnt vmcnt(0)" ::: "memory"); __syncthreads(); }
            const bool fin = (blk >= CTXL / 32 && blk < CTXL / 16) || blk >= CTXL / 16 + SEQ / 32;
            const bf16x8 a2 = *(const bf16x8*)(zu + (size_t)row_scan(b0 + hb, d, pn + tt) * LDZ);
            f32x16 acc[4];
#pragma unroll
            for (int t = 0; t < 4; ++t) { f32x16 z;
#pragma unroll
                for (int e = 0; e < 16; ++e) z[e] = 0.f;
                acc[t] = MFMA32(a0, Bf[t], z); }
            LAS unsigned* hrow = (LAS unsigned*)(Hs + hl * (16 * 136)) + j;
#pragma unroll
            for (int r = 0; r < 16; ++r) {
                const float nr0 = ar0 * hr0 - ai0 * hi0 + acc[0][r], ni0 = ar0 * hi0 + ai0 * hr0 + acc[1][r];
                const float nr1 = ar1 * hr1 - ai1 * hi1 + acc[2][r], ni1 = ar1 * hi1 + ai1 * hr1 + acc[3][r];
                hr0 = nr0; hi0 = ni0; hr1 = nr1; hi1 = ni1;
                hrow[r * 68] = pk2(nr0, ni0); hrow[r * 68 + 32] = pk2(nr1, ni1);
            }
            asm volatile("s_waitcnt lgkmcnt(0)" ::: "memory");
#pragma unroll
            for (int h2 = 0; h2 < 2; ++h2) {
                f32x4 y = (f32x4){0.f, 0.f, 0.f, 0.f};
#pragma unroll
                for (int ks = 0; ks < 4; ++ks) y = MFMA16(Cf[ks], ldsfrag(Hs + h2 * (16 * 136) + i16 * 136 + 32 * ks + 8 * q4), y);
                { const int rr = row_scan(b0 + h2, d, p0 + i16);
                  if (!fin) { v2u o; o.x = pk2(y[0], y[1]); o.y = pk2(y[2], y[3]); *(v2u*)(YS + ((size_t)d * RT + rr) * 512 + g * 16 + 4 * q4) = o; }
                  else { const v2u yf = *(const v2u*)(YS + ((size_t)(1 - d) * RT + rr) * 512 + g * 16 + 4 * q4), uw = *(const v2u*)(Z + (size_t)rr * LDZ + ZU + g * 16 + 4 * q4); const f32x4 dv = *(const f32x4*)(s5d + g * 16 + 4 * q4);
                      const float a0 = gelu_tanh(y[0] + bflo(yf.x) + dv[0] * bflo(uw.x)), a1 = gelu_tanh(y[1] + bfhi(yf.x) + dv[1] * bfhi(uw.x));
                      const float a2 = gelu_tanh(y[2] + bflo(yf.y) + dv[2] * bflo(uw.y)), a3 = gelu_tanh(y[3] + bfhi(yf.y) + dv[3] * bfhi(uw.y));
                      v2u o; o.x = pk2(a0, a1); o.y = pk2(a2, a3); *(v2u*)(A5 + (size_t)rr * 512 + g * 16 + 4 * q4) = o; } }
            }
            asm volatile("s_waitcnt lgkmcnt(0)" ::: "memory");
            a0 = a1; a1 = a2;
        }
    }
}

constexpr int ML_QS = 0, ML_KS = 17408, ML_VS = 34816, ML_KW = 53248, ML_CT = 71680, ML_SP = 108544, ML_FL = 118784;
constexpr int ML_P = 144, ML_SPP = 80;
typedef short v4i16_t __attribute__((ext_vector_type(4)));
__device__ __forceinline__ v2u tr16(const LAS bf16* p) { return __builtin_bit_cast(v2u, __builtin_amdgcn_ds_read_tr16_b64_v4i16((LAS v4i16_t*)p)); }
__device__ __forceinline__ bf16x8 trfrag(const LAS bf16* base, int pitch, int k0, int n0) {
    const v2u lo = tr16(base + k0 * pitch + n0), hi = tr16(base + (k0 + 4) * pitch + n0);
    const v4u w = (v4u){lo.x, lo.y, hi.x, hi.y}; return __builtin_bit_cast(bf16x8, w);
}
__device__ __forceinline__ void mlstm_chain(Frame& F, const Args& A, int l, int unit) {
    const bf16* Z = WSP(bf16, WS_Z); bf16* MH = WSP(bf16, WS_MH);
    const int b = unit >> 3, head = (unit >> 1) & 3, dir = unit & 1;
    LAS bf16* Qs = (LAS bf16*)(F.lds + ML_QS); LAS bf16* Ks = (LAS bf16*)(F.lds + ML_KS); LAS bf16* Vs = (LAS bf16*)(F.lds + ML_VS);
    LAS bf16* Kw = (LAS bf16*)(F.lds + ML_KW); LAS bf16* Ct = (LAS bf16*)(F.lds + ML_CT); LAS bf16* Sp = (LAS bf16*)(F.lds + ML_SP);
    LAS float* bcum = (LAS float*)(F.lds + ML_FL); LAS float* lis = bcum + 64; LAS float* den = bcum + 128; LAS float* nq = bcum + 192; LAS float* nvec = bcum + 256; LAS float* nadd = bcum + 384;
    int lane_l = F.lane; asm volatile("" : "+v"(lane_l));
    const int lane = lane_l, w = F.wave, tid = w * 64 + lane, i16 = lane & 15, q4 = lane >> 4;
    const float igb = KIN(I_MLIG)[(l * 2 + dir) * 4 + head], fgb = KIN(I_MLFG)[(l * 2 + dir) * 4 + head];
    const float kscale = 0.08838834764831845f;
    f32x4 C[8];
#pragma unroll
    for (int e = 0; e < 8; ++e) C[e] = (f32x4){0.f, 0.f, 0.f, 0.f};
    __syncthreads();
    if (tid < 128) nvec[tid] = 0.f;
    nadd[tid] = 0.f;
    float gb[5], gl[5];
#pragma unroll
    for (int j = 0; j < 5; ++j) { const int cc = 8 * j + w; gb[j] = 0.f; gl[j] = 0.f;
        if (cc < TOK / 64) { const bf16* zr = Z + (size_t)row_scan(b, dir, 64 * cc + lane) * LDZ + ZMG + dir * 8 + head; gl[j] = bf2f(zr[0]) + igb; gb[j] = logsigmoidf_(bf2f(zr[4]) + fgb); } }
#pragma unroll
    for (int o = 1; o < 64; o <<= 1) {
#pragma unroll
        for (int j = 0; j < 5; ++j) { const float t = shup(gb[j], o, lane); if (lane >= o) gb[j] += t; } }
    const int trq = (8 * q4 + (i16 >> 2)), trc = 4 * (i16 & 3);
    const LAS bf16* vs_tr = Vs + trq * ML_P + trc; const LAS bf16* kw_tr = Kw + trq * ML_P + trc; const LAS bf16* ct_tr = Ct + trq * ML_P + trc; const LAS bf16* sp_tr = Sp + trq * ML_SPP + trc;
    v4u qreg[2], kreg[2], vreg[2];
    auto load_chunk = [&](int c) {
#pragma unroll
        for (int i = 0; i < 2; ++i) { const int idx = tid + 512 * i, s = idx >> 4, c8 = (idx & 15) * 8; const bf16* zr = Z + (size_t)row_scan(b, dir, 64 * c + s) * LDZ + head * 128 + c8;
            qreg[i] = *(const v4u*)(zr + ZMQ); kreg[i] = *(const v4u*)(zr + ZMK); vreg[i] = *(const v4u*)(zr + ZMV); }
    };
    load_chunk(0);
    float eBprev = 1.f;
    for (int c = 0; c < TOK / 64; ++c) {
        __syncthreads();
        if (w == (c & 7)) { float bv = gb[0], lv = gl[0];
#pragma unroll
            for (int j = 1; j < 5; ++j) if ((c >> 3) == j) { bv = gb[j]; lv = gl[j]; }
            bcum[lane] = bv; lis[lane] = lv; }
        if (tid < 128) nvec[tid] = eBprev * nvec[tid] + ((nadd[tid] + nadd[128 + tid]) + (nadd[256 + tid] + nadd[384 + tid]));
#pragma unroll
        for (int i = 0; i < 2; ++i) { const int idx = tid + 512 * i, s = idx >> 4, c8 = (idx & 15) * 8;
            *(LAS v4u*)(Qs + s * 136 + c8) = qreg[i];
            *(LAS v4u*)(Vs + s * ML_P + c8) = vreg[i]; }
#pragma unroll
        for (int et = 0; et < 8; ++et) { v2u cw; cw.x = pk2(C[et][0], C[et][1]); cw.y = pk2(C[et][2], C[et][3]); *(LAS v2u*)(Ct + (16 * et + i16) * ML_P + 16 * w + 4 * q4) = cw; }
        float kf[2][8];
#pragma unroll
        for (int i = 0; i < 2; ++i) { const int idx = tid + 512 * i, s = idx >> 4, c8 = (idx & 15) * 8;
            unpack8(kreg[i], kf[i]);
#pragma unroll
            for (int jj = 0; jj < 8; ++jj) kf[i][jj] *= kscale;
            *(LAS v4u*)(Ks + s * 136 + c8) = pack8(kf[i]); }
        if (c + 1 < TOK / 64) load_chunk(c + 1);
        __syncthreads();
        const float Btot = bcum[63];
#pragma unroll
        for (int i = 0; i < 2; ++i) { const int idx = tid + 512 * i, s = idx >> 4, c8 = (idx & 15) * 8; const float ws = __expf(Btot - bcum[s] + lis[s]);
#pragma unroll
            for (int jj = 0; jj < 8; ++jj) kf[i][jj] *= ws;
            *(LAS v4u*)(Kw + s * ML_P + c8) = pack8(kf[i]); }
#pragma unroll
        for (int ti = 0; ti < 2; ++ti) { const int idx = 2 * w + ti, tt = idx >> 2, st = idx & 3; const int srow = 16 * st + i16;
            f32x4 acc = (f32x4){0.f, 0.f, 0.f, 0.f};
            if (st <= tt) {
#pragma unroll
                for (int ks = 0; ks < 4; ++ks) acc = MFMA16(ldsfrag(Qs + (16 * tt + i16) * 136 + 32 * ks + 8 * q4), ldsfrag(Ks + srow * 136 + 32 * ks + 8 * q4), acc); }
            const float bs = bcum[srow], ls = lis[srow]; const f32x4 bt = *(const LAS f32x4*)(bcum + 16 * tt + 4 * q4); float v[4];
#pragma unroll
            for (int r = 0; r < 4; ++r) { const int t = 16 * tt + 4 * q4 + r; v[r] = (srow <= t && st <= tt) ? acc[r] * __expf(bt[r] - bs + ls) : 0.f; }
            v2u sw; sw.x = pk2(v[0], v[1]); sw.y = pk2(v[2], v[3]); *(LAS v2u*)(Sp + srow * ML_SPP + 16 * tt + 4 * q4) = sw; }
        __syncthreads();
        bf16x8 vfr[2], cfr[4], nfr[4];
        const bf16x8 onesf = __builtin_bit_cast(bf16x8, (v4u){0x3f803f80u, 0x3f803f80u, 0x3f803f80u, 0x3f803f80u});
#pragma unroll
        for (int ks = 0; ks < 2; ++ks) vfr[ks] = trfrag(vs_tr, ML_P, 32 * ks, 16 * w);
#pragma unroll
        for (int ks = 0; ks < 4; ++ks) { cfr[ks] = trfrag(ct_tr, ML_P, 32 * ks, 16 * w);
            const f32x4 n0 = *(const LAS f32x4*)(nvec + 32 * ks + 8 * q4), n1 = *(const LAS f32x4*)(nvec + 32 * ks + 8 * q4 + 4);
            const float nf[8] = {n0.x, n0.y, n0.z, n0.w, n1.x, n1.y, n1.z, n1.w}; nfr[ks] = __builtin_bit_cast(bf16x8, pack8(nf)); }
#pragma unroll 2
        for (int tt = 0; tt < 4; ++tt) {
            f32x4 a1 = (f32x4){0.f, 0.f, 0.f, 0.f}, a2 = (f32x4){0.f, 0.f, 0.f, 0.f}, ad = (f32x4){0.f, 0.f, 0.f, 0.f}, an = (f32x4){0.f, 0.f, 0.f, 0.f};
#pragma unroll
            for (int ks = 0; ks < 2; ++ks) { const bf16x8 sf = trfrag(sp_tr, ML_SPP, 32 * ks, 16 * tt); a1 = MFMA16(vfr[ks], sf, a1); ad = MFMA16(onesf, sf, ad); }
#pragma unroll
            for (int ks = 0; ks < 4; ++ks) { const bf16x8 qf = ldsfrag(Qs + (16 * tt + i16) * 136 + 32 * ks + 8 * q4); a2 = MFMA16(cfr[ks], qf, a2); an = MFMA16(nfr[ks], qf, an); }
            const int rr = row_scan(b, dir, 64 * c + 16 * tt + i16);
            { const float eb = __expf(bcum[16 * tt + i16]), dn = ad[0] + eb * an[0], inv = __builtin_amdgcn_rcpf(fmaxf(fabsf(dn), 1.f));
              v2u o; o.x = pk2((a1[0] + eb * a2[0]) * inv, (a1[1] + eb * a2[1]) * inv); o.y = pk2((a1[2] + eb * a2[2]) * inv, (a1[3] + eb * a2[3]) * inv);
              *(v2u*)(MH + ((size_t)dir * RT + rr) * 512 + head * 128 + 16 * w + 4 * q4) = o; }
        }
        const float eB = __expf(Btot);
#pragma unroll
        for (int et = 0; et < 8; ++et) { f32x4 acc = C[et] * eB;
#pragma unroll
            for (int ks = 0; ks < 2; ++ks) acc = MFMA16(vfr[ks], trfrag(kw_tr, ML_P, 32 * ks, 16 * et), acc);
            C[et] = acc; if (et & 1) __builtin_amdgcn_sched_barrier(0); }
        { const int e = tid & 127, part = tid >> 7; float s = 0.f;
#pragma unroll
          for (int ss = 0; ss < 16; ++ss) s += bf2f(Kw[(16 * part + ss) * ML_P + e]);
          nadd[tid] = s; }
        eBprev = eB;
    }
    __syncthreads();
}

constexpr int AT_K = 0, AT_V = 25600, AT_VP = 144, AT_BUF = 44032;
__device__ __forceinline__ void attn_unit(Frame& F, int b, int h, int qrow0, int nkt, const float* qn  ) {
    const bf16* Q = WSP(bf16, WS_QRAW); const bf16* K = WSP(bf16, WS_K); const bf16* KVRAW = WSP(bf16, WS_KVRAW); bf16* Y = WSP(bf16, WS_Y);
    LAS bf16* Kl = (LAS bf16*)(F.lds + AT_K); LAS bf16* Vl = (LAS bf16*)(F.lds + AT_V);
    int lane_l = F.lane; asm volatile("" : "+v"(lane_l));
    const int lane = lane_l, w = F.wave, tid = w * 64 + lane, i16 = lane & 15, q4 = lane >> 4;
    bf16x8 qf[2][6];
    const bf16* Qb = Q + (size_t)qrow0 * 768 + h * 192;
    const unsigned qoff = (unsigned)((32 * w + i16) * 768 + 8 * q4);
#pragma unroll
    for (int qt = 0; qt < 2; ++qt)
#pragma unroll
        for (int ks = 0; ks < 6; ++ks) qf[qt][ks] = *(const bf16x8*)(Qb + (qoff + (unsigned)(16 * qt * 768 + 32 * ks)));
    { const float* rope = WSP(float, WS_ROPE); const bool lat = qrow0 < RL;
#pragma unroll
      for (int qt = 0; qt < 2; ++qt) {
          float f[6][8]; float ss = 0.f;
#pragma unroll
          for (int ks = 0; ks < 6; ++ks) { unpack8(__builtin_bit_cast(v4u, qf[qt][ks]), f[ks]);
#pragma unroll
              for (int j = 0; j < 8; ++j) ss += f[ks][j] * f[ks][j]; }
          ss += shx(ss, 16, lane); ss += shx(ss, 32, lane);
          const float rs = rsqrtf(ss * (1.f / 192.f) + EPS);
#pragma unroll
          for (int ks = 0; ks < 6; ++ks) { const f32x4 n0 = *(const f32x4*)(qn + 32 * ks + 8 * q4), n1 = *(const f32x4*)(qn + 32 * ks + 8 * q4 + 4);
#pragma unroll
              for (int j = 0; j < 4; ++j) { f[ks][j] *= rs * n0[j]; f[ks][4 + j] *= rs * n1[j]; } }
          if (lat) { const int t = (qrow0 + 32 * w + 16 * qt + i16) & (SEQ - 1); const bool second = (q4 & 2) != 0;
#pragma unroll
              for (int part = 0; part < 2; ++part) {
                  const int pos = part ? (t & 63) : (t >> 6); const f32x4* tp = (const f32x4*)(rope + (size_t)(pos * 16 + 8 * (q4 & 1)) * 2);
                  const f32x4 t0 = tp[0], t1 = tp[1], t2 = tp[2], t3 = tp[3];
                  const float cs[8] = {t0.x, t0.z, t1.x, t1.z, t2.x, t2.z, t3.x, t3.z}, sn[8] = {t0.y, t0.w, t1.y, t1.w, t2.y, t2.w, t3.y, t3.w};
#pragma unroll
                  for (int j = 0; j < 8; ++j) { const float me = f[4 + part][j], other = shx(me, 32, lane); f[4 + part][j] = second ? (me * cs[j] + other * sn[j]) : (me * cs[j] - other * sn[j]); } } }
#pragma unroll
          for (int ks = 0; ks < 6; ++ks) {
#pragma unroll
              for (int j = 0; j < 8; ++j) f[ks][j] *= ATTN_SCALE_LOG2E;
              qf[qt][ks] = __builtin_bit_cast(bf16x8, pack8(f[ks])); }
      } }
    f32x4 O[2][8];
#pragma unroll
    for (int qt = 0; qt < 2; ++qt)
#pragma unroll
        for (int dt = 0; dt < 8; ++dt) O[qt][dt] = (f32x4){0.f, 0.f, 0.f, 0.f};
    float mrun[2] = {-1e30f, -1e30f}, lsum[2] = {0.f, 0.f};
    const bf16* kbase = K + (size_t)b * TOK * 768 + h * 192;
    v4u kr[3], vr[2];
    unsigned koff[3], voff[2];
#pragma unroll
    for (int i = 0; i < 3; ++i) { const int idx = tid + 512 * i, r = idx / 24, cc = idx % 24; koff[i] = (unsigned)(r * 768 + 8 * cc); }
#pragma unroll
    for (int i = 0; i < 2; ++i) { const int idx = tid + 512 * i, r = idx >> 4, cc = idx & 15; voff[i] = (unsigned)(r * 1024 + 8 * cc); }
    auto load_tile = [&](int kt) {
        const bf16* kb = kbase + (size_t)kt * (64 * 768); const bf16* vb = KVRAW + (size_t)row_key(b, 64 * kt) * 1024 + h * 256 + 128;
#pragma unroll
        for (int i = 0; i < 3; ++i) kr[i] = *(const v4u*)(kb + koff[i]);
#pragma unroll
        for (int i = 0; i < 2; ++i) vr[i] = *(const v4u*)(vb + voff[i]);
    };
    const LAS bf16* vtr0 = Vl + (4 * q4 + (i16 >> 2)) * AT_VP + 4 * (i16 & 3);
    int kwo[3], vwo[2];
#pragma unroll
    for (int i = 0; i < 3; ++i) { const int idx = tid + 512 * i, r = idx / 24, cc = idx % 24; kwo[i] = r * 200 + 8 * cc; }
#pragma unroll
    for (int i = 0; i < 2; ++i) { const int idx = tid + 512 * i, r = idx >> 4, cc = idx & 15; vwo[i] = r * AT_VP + 8 * cc; }
    load_tile(0);
    __syncthreads();
#pragma unroll
    for (int i = 0; i < 3; ++i) *(LAS v4u*)(Kl + kwo[i]) = kr[i];
#pragma unroll
    for (int i = 0; i < 2; ++i) *(LAS v4u*)(Vl + vwo[i]) = vr[i];
    __syncthreads();
    for (int kt = 0; kt < nkt; ++kt) {
        const int bo = (kt & 1) * (AT_BUF / 2);
        const LAS bf16* Kc = Kl + bo; const LAS bf16* vtrc = vtr0 + bo;
        if (kt + 1 < nkt) load_tile(kt + 1);
        f32x4 s[2][4];
#pragma unroll
        for (int k4 = 0; k4 < 4; ++k4) {
            f32x4 s0 = (f32x4){0.f, 0.f, 0.f, 0.f}, s1 = (f32x4){0.f, 0.f, 0.f, 0.f};
#pragma unroll
            for (int ks = 0; ks < 6; ++ks) { const bf16x8 kf = ldsfrag(Kc + (16 * k4 + i16) * 200 + 32 * ks + 8 * q4); s0 = MFMA16(kf, qf[0][ks], s0); s1 = MFMA16(kf, qf[1][ks], s1); }
            s[0][k4] = s0; s[1][k4] = s1;
        }
        bf16x8 pf[2][2];
#pragma unroll
        for (int qt = 0; qt < 2; ++qt) {
            float tm = -1e30f;
#pragma unroll
            for (int k4 = 0; k4 < 4; ++k4)
#pragma unroll
                for (int r = 0; r < 4; ++r) tm = fmaxf(tm, s[qt][k4][r]);
            tm = fmaxf(tm, shx(tm, 16, lane)); tm = fmaxf(tm, shx(tm, 32, lane));
            const float mn = fmaxf(mrun[qt], tm), alpha = __builtin_amdgcn_exp2f(mrun[qt] - mn);
            mrun[qt] = mn;
            float ps = 0.f; float p[4][4];
#pragma unroll
            for (int k4 = 0; k4 < 4; ++k4)
#pragma unroll
                for (int r = 0; r < 4; ++r) { p[k4][r] = __builtin_amdgcn_exp2f(s[qt][k4][r] - mn); ps += p[k4][r]; }
            lsum[qt] = lsum[qt] * alpha + ps;
#pragma unroll
            for (int dt = 0; dt < 8; ++dt) O[qt][dt] = O[qt][dt] * alpha;
#pragma unroll
            for (int kk = 0; kk < 2; ++kk) { v4u pw; pw.x = pk2(p[2 * kk][0], p[2 * kk][1]); pw.y = pk2(p[2 * kk][2], p[2 * kk][3]); pw.z = pk2(p[2 * kk + 1][0], p[2 * kk + 1][1]); pw.w = pk2(p[2 * kk + 1][2], p[2 * kk + 1][3]);
                pf[qt][kk] = __builtin_bit_cast(bf16x8, pw); }
        }
#pragma unroll
        for (int dt = 0; dt < 8; ++dt)
#pragma unroll
            for (int kk = 0; kk < 2; ++kk) {
                const v2u lo = tr16(vtrc + (32 * kk) * AT_VP + 16 * dt), hi = tr16(vtrc + (32 * kk + 16) * AT_VP + 16 * dt);
                const v4u vw = (v4u){lo.x, lo.y, hi.x, hi.y}; const bf16x8 vf = __builtin_bit_cast(bf16x8, vw);
                O[0][dt] = MFMA16(vf, pf[0][kk], O[0][dt]); O[1][dt] = MFMA16(vf, pf[1][kk], O[1][dt]);
            }
        if (kt + 1 < nkt) { const int bn = ((kt + 1) & 1) * (AT_BUF / 2);
#pragma unroll
            for (int i = 0; i < 3; ++i) *(LAS v4u*)(Kl + bn + kwo[i]) = kr[i];
#pragma unroll
            for (int i = 0; i < 2; ++i) *(LAS v4u*)(Vl + bn + vwo[i]) = vr[i]; }
        __syncthreads();
    }
#pragma unroll
    for (int qt = 0; qt < 2; ++qt) {
        float lt = lsum[qt]; lt += shx(lt, 16, lane); lt += shx(lt, 32, lane);
        const float inv = 1.f / lt;
        bf16* Yb = Y + (size_t)qrow0 * DM + 1024 + h * 128; const unsigned yoff = (unsigned)((32 * w + 16 * qt + i16) * DM + 4 * q4);
#pragma unroll
        for (int dt = 0; dt < 8; ++dt) { const f32x4 o = O[qt][dt] * inv; v2u ow; ow.x = pk2(o[0], o[1]); ow.y = pk2(o[2], o[3]); *(v2u*)(Yb + (yoff + (unsigned)(16 * dt))) = ow; }
    }
    __syncthreads();
}
template <class E_> __device__ __forceinline__ void probe_redirect(E_&, float*) {}
__device__ __forceinline__ void probe_redirect(pg8::EpiRes& e, float* dummy) { e.xout = dummy; }

__global__ void __launch_bounds__(NTHR, 2) trunk_fwd(Args A) {
    extern __shared__ __attribute__((aligned(16))) unsigned char lds[];
    Frame F;
    F.lds = (LAS unsigned char*)lds;
    F.MISC = (volatile LAS unsigned*)(F.lds + MISC_OFF);
    F.tid = threadIdx.x; F.lane = F.tid & 63; F.wave = __builtin_amdgcn_readfirstlane(F.tid >> 6);
    F.G = gridDim.x; F.bid = blockIdx.x;
    F.ws = A.ws; F.out = A.out; F.kp = (const __attribute__((address_space(4))) char*)__builtin_amdgcn_kernarg_segment_ptr();
    unsigned char* const ws0 = A.ws; const __attribute__((address_space(4))) char* const kp0 = F.kp;
    F.ctl = (gu32*)(A.ws + WS_CTL);
    for (int u = F.tid; u < (LDS_BYTES - LDSCTL_OFF) / 4; u += NTHR) ((LAS unsigned*)(F.lds + LDSCTL_OFF))[u] = 0u;
    __syncthreads();
    XcdBarrier bar = xcd_barrier_post((unsigned*)(F.ctl + CW_BAR), F.MISC + 8);
    const int lo = A.lo, hi = A.hi, wave0 = F.wave;
    int st = 0;
#define RELAUNDER() do { int w_s = wave0; asm volatile("" : "+s"(w_s)); F.wave = w_s; { unsigned m_ = ~0u; asm volatile("" : "+v"(m_)); F.lane = (int)__builtin_amdgcn_mbcnt_hi(m_, __builtin_amdgcn_mbcnt_lo(m_, 0u)); } F.tid = w_s * 64 + F.lane; int b_ = blockIdx.x, g_ = gridDim.x; asm volatile("" : "+s"(b_), "+s"(g_)); F.bid = b_; F.G = g_; GAS unsigned char* w_ = (GAS unsigned char*)ws0; asm volatile("" : "+s"(w_)); F.ws = (unsigned char*)w_; const __attribute__((address_space(4))) char* k_ = kp0; asm volatile("" : "+s"(k_)); F.kp = k_; } while (0)
#define STEP_BEGIN if (st >= lo && st < hi) { asm volatile("; STEP_MARK_BEGIN %0" :: "n"(__LINE__)); RELAUNDER();
#define STEP_END   asm volatile("; STEP_MARK_END %0" :: "n"(__LINE__)); if (st + 1 < hi) { xcd_barrier(bar); if (PROBE_DUP == 11) xcd_barrier(bar); } } ++st;
#define PROBE_REDIRECT(e) probe_redirect(e, WSP(float, WS_Z))
#define GEMM_STAGGER() do { if (STAG_GROUPS > 1) { const int sg_ = (F.bid >> 3) % STAG_GROUPS; for (int i_ = 0; i_ < sg_; ++i_) __builtin_amdgcn_s_sleep(STAG_SLEEP); } } while (0)
#define GEMM_RUN(EPI) { if (PROBE_DUP == 8) { auto E2_ = E; PROBE_REDIRECT(E2_); pg8::gemm_phase<decltype(E2_), pg8::StaticOrder, GEMM_ALIGN, GEMM_SP2>(ring, g, S, E2_, F.tid); RELAUNDER(); } \
    if (PROBE_DUP == 1) { pg8::EpiNull EN_; pg8::gemm_phase<pg8::EpiNull, pg8::StaticOrder, GEMM_ALIGN, GEMM_SP2>(ring, g, S, EN_, F.tid); RELAUNDER(); } \
    pg8::gemm_phase<pg8::EPI, pg8::StaticOrder, GEMM_ALIGN, GEMM_SP2>(ring, g, S, E, F.tid); }
#define GEMM_RUN_NSP(EPI, NSPV) { pg8::gemm_phase<pg8::EPI, pg8::StaticOrder, GEMM_ALIGN, GEMM_SP2, NSPV>(ring, g, S, E, F.tid); }
#define MODS_L (WSP(float, WS_MODS) + (size_t)l * 17 * NMOD)
    LAS unsigned char* ring = F.lds + RING_OFF;

    STEP_BEGIN
        for (int rep = 0; rep < (PROBE_DUP == 7 ? 2 : 1); ++rep)
        p0a_prologue(F, KIN(I_C), KIN(I_CCTX), KIN(I_ADAW), KIN(I_ADAB), KIN(I_S5LRE), KIN(I_S5LIM), KIN(I_S5LDT), KIN(I_S5BRE), KIN(I_S5BIM), KIN(I_S5CRE), KIN(I_S5CIM));
    STEP_END
    STEP_BEGIN
        for (int rep = 0; rep < (PROBE_DUP == 24 ? 2 : 1); ++rep) { p0c_shw(F, KIN(I_WIN), KIN(I_W1)); RELAUNDER(); }
    STEP_END

    for (int l = 0; l < DEPTH; ++l) {
        const bool need_ctx = l < DEPTH - 1;
        const int nrows = need_ctx ? RT : RL;
        STEP_BEGIN
            for (int rep = 0; rep < ((PROBE_DUP == 4 || PROBE_DUP == 20) ? 2 : 1); ++rep) {
            convert_weights(F, A, l, l);
            RELAUNDER();
            if (l == 0) norm0_phase(F, KIN(I_X), KIN(I_CTX), KIN(I_N1W), WSP(float, WS_MODS));
            else { rstd_phase(F, RL); RELAUNDER(); if (rep == 0) ctxfix_phase(F, MODS_L - 17 * NMOD + 16 * NMOD + 5 * DM, KIN(I_N1W) + (size_t)l * DM, MODS_L + 16 * NMOD + 1 * DM); }
            RELAUNDER(); }
        STEP_END
        STEP_BEGIN
            pg8::Gemm g{WSP(bf16, WS_H), WSP(bf16, WS_WIN), RT, LDZ, DM}; g.ablk = 1; pg8::StaticOrder S; S.init(RT, LDZ, F.G, F.bid);
            for (int rep = 0; rep < (PROBE_DUP == 14 ? 2 : 1); ++rep) {
            pg8::EpiStoreN E{WSP(bf16, WS_Z), LDZ, WSP(float, WS_RSTD), WSP(float, WS_SHW) + (size_t)l * 17 * (LDZ + DFF), LDZ + DFF};
            GEMM_STAGGER(); GEMM_RUN(EpiStoreN)
            RELAUNDER(); }
        STEP_END
        STEP_BEGIN
            for (int rep = 0; rep < ((PROBE_DUP == 4 || PROBE_DUP == 21) ? 2 : 1); ++rep) { prep_phase(F, A, l); RELAUNDER(); }
        STEP_END
        STEP_BEGIN
            for (int rep = 0; rep < (PROBE_DUP == 12 ? 2 : 1); ++rep) {
            { const pg8::GrpDesc gl{WSP(bf16, WS_XS), WSP(bf16, WS_WLRU), RT, 2048, 128, 512, 4}, gk{WSP(bf16, WS_AKV), WSP(bf16, WS_WKVUP), RT, 1024, 256, 256, 0},
                                 gq{WSP(bf16, WS_AQ), WSP(bf16, WS_WQUP), need_ctx ? RT : RL, 768, 384, 384, 0};
              const pg8::EpiLru el{WSP(bf16, WS_XS), WSP(bf16, WS_LOGA), WSP(bf16, WS_GB), WSP(float, WS_LRUC)};
              const pg8::EpiStoreBf16 ek{WSP(bf16, WS_KVRAW), 1024}, eq{WSP(bf16, WS_QRAW), 768};
              pg8::gemm_group3(ring, gl, gk, gq, el, ek, eq, F.G, F.bid, F.tid); }
            RELAUNDER(); }
        STEP_END
        STEP_BEGIN
            for (int rep = 0; rep < (PROBE_DUP == 3 ? 2 : 1); ++rep) {
            const int s5wg = (S5_IN_L4 && F.G >= 256) ? 64 : 0;
            if (F.bid < s5wg) s5_scan(F, l, F.bid * 4 + (F.wave >> 1), F.wave & 1);
            else {
            for (int wu = (F.bid - s5wg) * NWAVES + F.wave; wu < NB * 2 * 36; wu += (F.G - s5wg) * NWAVES) lru_chunk<false>(F, wu);
            RELAUNDER();
            mla_finish(F, A, l, need_ctx, s5wg, F.G - s5wg); }
            RELAUNDER(); }
        STEP_END
        STEP_BEGIN
            const int nattn = 704 + (need_ctx ? 64 : 0), nunits = nattn + 144;
            volatile LAS unsigned* slot = F.MISC + 16;
            for (int rep = 0; rep < ((PROBE_DUP == 2 || PROBE_DUP == 5 || PROBE_DUP == 6 || PROBE_DUP == 9) ? 2 : 1); ++rep) {
            gu32* qh = F.ctl + CW_QUEUE + 64 * (l + 4 * rep);
            const int ubase = (rep == 1 && PROBE_DUP == 6) ? 192 : (rep == 1 && PROBE_DUP == 9) ? 128 : 0;
            const int ulim = (rep == 1 && PROBE_DUP == 5) ? 128 : (rep == 1 && PROBE_DUP == 9) ? 192 : nunits;
            for (;;) {
                __syncthreads();
                if (F.tid == 0) slot[0] = __hip_atomic_fetch_add(qh, 1u, __ATOMIC_RELAXED, __HIP_MEMORY_SCOPE_AGENT);
                __syncthreads();
                const int u = ubase + __builtin_amdgcn_readfirstlane((int)slot[0]);
                if (u >= ulim) break;
                if (u < 128) mlstm_chain(F, A, l, u);
                else if (u < 192) s5_scan(F, l, (u - 128) * 4 + (F.wave >> 1), F.wave & 1);
                else if (u >= nattn) lru_chunk<true>(F, (u - nattn) * 8 + F.wave);
                else { int ab, ah, aq, an; const int ua = u - 192;
                    if (ua < 512) { ab = ua >> 5; ah = (ua >> 3) & 3; aq = (ua >> 5) * SEQ + 256 * (ua & 7); an = TOK / 64; }
                    else { const int uc = ua - 512; ab = uc >> 2; ah = uc & 3; aq = RL + (uc >> 2) * CTXL; an = CTXL / 64; }
                    attn_unit(F, ab, ah, aq, an, KIN(I_QN) + (size_t)l * 192); }
                RELAUNDER();
            }
            }
        STEP_END
        STEP_BEGIN
            pg8::Gemm g{WSP(bf16, WS_A5), WSP(bf16, WS_WGLU), nrows, 512, 512}; pg8::StaticOrder S; S.init(nrows, 512, F.G, F.bid);
            for (int rep = 0; rep < (PROBE_DUP == 13 ? 2 : 1); ++rep) {
            pg8::EpiGlu E{WSP(bf16, WS_A5), WSP(bf16, WS_Y), DM, KIN(I_S5GLUB) + (size_t)l * 512};
            GEMM_RUN(EpiGlu)
            RELAUNDER();
            finish_phase<false, true>(F, A, l, nrows);
            RELAUNDER(); }
        STEP_END
        STEP_BEGIN
            pg8::Gemm g{WSP(bf16, WS_Y), WSP(bf16, WS_WOUT), nrows, DM, DM}; pg8::StaticOrder S; S.init(nrows, DM, F.G, F.bid);
            if (l == 0) {
                pg8::EpiResNF E{KIN(I_X), KIN(I_CTX) - (size_t)RL * DM, WSP(bf16, WS_X), MODS_L + 2 * DM, 0, WSP(bf16, WS_H), KIN(I_N2W) + (size_t)l * DM, MODS_L + 4 * DM, WSP(float, WS_SSP)};
                GEMM_RUN(EpiResNF)
            } else {
                pg8::EpiResN E{WSP(bf16, WS_X), WSP(bf16, WS_X), WSP(bf16, WS_X), MODS_L + 2 * DM, 0, WSP(bf16, WS_H), KIN(I_N2W) + (size_t)l * DM, MODS_L + 4 * DM, WSP(float, WS_SSP)};
                GEMM_RUN(EpiResN)
            }
        STEP_END
        STEP_BEGIN
            for (int rep = 0; rep < (PROBE_DUP == 23 ? 2 : 1); ++rep) { rstd_phase(F, nrows); RELAUNDER(); }
        STEP_END
        { const int nch = (nrows + MLP_CHUNK - 1) / MLP_CHUNK;
          for (int c = 0; c <= nch; ++c) {
            STEP_BEGIN
                const int g1first = (MLP_ALT && c >= 1 && c < nch) ? ((F.bid >> 3) & 1) : 0;
                for (int ord = 0; ord < 2; ++ord) { const int which = ord ^ g1first;
                if (which == 0) {
                if (c >= 1) { const int r0 = (c - 1) * MLP_CHUNK, m = min(MLP_CHUNK, nrows - r0); const bf16* hid = WSP(bf16, WS_Z) + (size_t)((c - 1) & 1) * MLP_CHUNK * DFF;
                    if (m >= 8192) {
                        if (need_ctx) {
                            pg8::Gemm g{hid, WSP(bf16, WS_W2), m, DM, DFF}; g.ablk = 1; pg8::StaticOrder S; S.init(m, DM, F.G, F.bid);
                            pg8::EpiResN E{WSP(bf16, WS_X), WSP(bf16, WS_X), WSP(bf16, WS_X), MODS_L + 5 * DM, r0,
                                           WSP(bf16, WS_H), KIN(I_N1W) + (size_t)(l + 1) * DM, MODS_L + 17 * NMOD + 1 * DM, WSP(float, WS_SSP)};
                            GEMM_RUN(EpiResN)
                        } else {
                            pg8::Gemm g{hid, WSP(bf16, WS_W2), m, DM, DFF}; g.ablk = 1; pg8::StaticOrder S; S.init(m, DM, F.G, F.bid);
                            pg8::EpiResOut E{WSP(bf16, WS_X), F.out, MODS_L + 5 * DM, r0};
                            GEMM_RUN(EpiResOut)
                        }
                    } else {
                        pg8::Gemm g{hid, WSP(bf16, WS_W2), m, 2 * DM, DFF / 2, DFF, DM / 256}; g.ablk = 1; pg8::StaticOrder S; S.init(m, 2 * DM, F.G, F.bid);
                        pg8::EpiPart E{WSP(float, WS_LOGA), DM / 256, RC};
                        GEMM_RUN_NSP(EpiPart, 8)
                    }
                    RELAUNDER(); }
                } else {
                if (c < nch) { const int r0 = c * MLP_CHUNK, m = min(MLP_CHUNK, nrows - r0);
                    pg8::Gemm g{WSP(bf16, WS_H) + (size_t)r0 * DM, WSP(bf16, WS_W1), m, DFF, DM}; g.ablk = 1; pg8::StaticOrder S; S.init(m, DFF, F.G, F.bid);
                    pg8::EpiRelu2N E{WSP(bf16, WS_Z) + (size_t)(c & 1) * MLP_CHUNK * DFF, DFF, WSP(float, WS_RSTD), WSP(float, WS_SHW) + (size_t)l * 17 * (LDZ + DFF) + LDZ, LDZ + DFF, r0};
                    if (PROBE_DUP == 25) { GEMM_RUN(EpiRelu2N) RELAUNDER(); }
                    GEMM_RUN(EpiRelu2N) }
                }
                RELAUNDER(); }
            STEP_END
          } }
    }
#undef STEP_BEGIN
#undef STEP_END
}

extern "C" void kernel_launch(void* const* d_in, const int* in_sizes, int n_in, void* d_out, int out_size, void* d_ws, size_t ws_size, hipStream_t stream) {
    static int grid = 0;
    if (grid == 0) {
        if (n_in != N_IN || in_sizes[0] != RL * DM || out_size != RL * DM || ws_size < WS_END) {
            fprintf(stderr, "kernel_launch: shape/workspace mismatch: n_in %d in0 %d out %d ws %zu (need %zu); nothing launched\n", n_in, n_in > 0 ? in_sizes[0] : -1, out_size, ws_size, (size_t)WS_END); grid = -1; return; }
        int dev = 0, cus = 0, per_cu = 0;
        if (hipGetDevice(&dev) != hipSuccess || hipDeviceGetAttribute(&cus, hipDeviceAttributeMultiprocessorCount, dev) != hipSuccess) { grid = -1; return; }
        if (hipFuncSetAttribute((const void*)trunk_fwd, hipFuncAttributeMaxDynamicSharedMemorySize, LDS_BYTES) != hipSuccess) { fprintf(stderr, "kernel_launch: hipFuncSetAttribute failed\n"); grid = -1; return; }
        if (hipOccupancyMaxActiveBlocksPerMultiprocessor(&per_cu, (const void*)trunk_fwd, NTHR, LDS_BYTES) != hipSuccess || per_cu < 1)
            fprintf(stderr, "kernel_launch: note: occupancy query reports %d workgroups per CU\n", per_cu);
        (void)hipGetLastError();
        grid = cus;
    }
    if (grid < 0) return;
    if (hipMemsetAsync((char*)d_ws + WS_CTL, 0, CTL_ZERO_BYTES, stream) != hipSuccess) return;
    Args a{};
    for (int i = 0; i < N_IN; ++i) a.in[i] = (const float*)d_in[i];
    a.out = (float*)d_out; a.ws = (unsigned char*)d_ws;
#ifndef MK_SPLIT
    a.lo = 0; a.hi = 1 << 20;
    hipLaunchKernelGGL(trunk_fwd, dim3(grid), dim3(NTHR), LDS_BYTES, stream, a);
#else
    for (int s = 0; s < MK_SPLIT; ++s) { a.lo = s; a.hi = s + 1; hipLaunchKernelGGL(trunk_fwd, dim3(grid), dim3(NTHR), LDS_BYTES, stream, a); }
#endif
}
```

```cpp
#include <hip/hip_runtime.h>
#include <cstdio>
#include <cstdint>
#ifndef GEMM_ALIGN
#define GEMM_ALIGN true
#endif
#ifndef GEMM_SP2
#define GEMM_SP2 true
#endif
#ifndef MLP_CHUNK
#define MLP_CHUNK 8192
#endif
#ifndef STAG_GROUPS
#define STAG_GROUPS 1
#define STAG_SLEEP 64
#endif
#ifndef EPI_NT
#define EPI_NT 0
#endif
#ifndef S5_IN_L4
#define S5_IN_L4 0
#endif
#ifndef MLP_ALT
#define MLP_ALT 0
#endif
#ifndef WOUT_STAG_GROUPS
#define WOUT_STAG_GROUPS 1
#define WOUT_STAG_STEPS 4
#endif
#ifndef PROBE_DUP
#define PROBE_DUP 0
#endif

constexpr int DM = 2048, NB = 16, SEQ = 2048, CTXL = 256, DEPTH = 4, DFF = 8192;
constexpr int RL = NB * SEQ;
constexpr int RC = NB * CTXL;
constexpr int RT = RL + RC;
constexpr int TOK = SEQ + CTXL;
constexpr int NZ = 4176, LDZ = 4352;
constexpr int ZU = 0, ZMQ = 512, ZMK = 1024, ZMV = 1536, ZMO = 2048, ZMG = 2560, ZCQ = 2576, ZCKV = 2960, ZKR = 3088, ZLX = 3152, ZLG = 3664;
constexpr int NMOD = 6 * DM;
constexpr float EPS = 1e-6f;
constexpr int NWAVES = 8, NTHR = 512;

enum { I_X = 0, I_C, I_CTX, I_CCTX, I_ADAW, I_ADAB, I_N1W, I_N2W, I_WIN, I_WOUT, I_S5LRE, I_S5LIM, I_S5LDT, I_S5BRE, I_S5BIM, I_S5CRE, I_S5CIM, I_S5D, I_S5GLUW, I_S5GLUB,
       I_MLIG, I_MLFG, I_MLON, I_QAN, I_WQUP, I_KVAN, I_WKVUP, I_QN, I_KN, I_LCW, I_LCB, I_LWA, I_LBA, I_LWX, I_LBX, I_LLAM, I_W1, I_W2, N_IN };

constexpr size_t MiB = 1u << 20;
#ifndef WS_SKEW
#define WS_SKEW 1
#endif
#ifndef BLK_LAYOUT
#define BLK_LAYOUT 1
#endif
__host__ __device__ __forceinline__ size_t blk_off(int row, int col, int nct) { return BLK_LAYOUT ? (((size_t)((row >> 8) * nct + (col >> 8))) << 16) + (size_t)((row & 255) * 256 + (col & 255)) : (size_t)row * (size_t)(256 * nct) + col; }
constexpr size_t WS_CTL = 0, CTL_ZERO_BYTES = 1 * MiB;
constexpr size_t WS_MODS = 1 * MiB;
constexpr size_t WS_S5A = 5 * MiB;
constexpr size_t WS_S5BB = 5 * MiB + 512 * 1024;
constexpr size_t WS_S5CM = 6 * MiB + 512 * 1024;
constexpr size_t WS_LRUC = 7 * MiB + 512 * 1024;
constexpr size_t WS_ROPE = 7 * MiB + 640 * 1024;
constexpr size_t WS_W = 8 * MiB;
constexpr size_t WS_WIN = WS_W;
constexpr size_t WS_WOUT = WS_WIN + 17 * MiB;
constexpr size_t WS_W1 = WS_WOUT + 8 * MiB;
constexpr size_t WS_W2 = WS_W1 + 32 * MiB;
constexpr size_t WS_WGLU = WS_W2 + 32 * MiB;
constexpr size_t WS_WQUP = WS_WGLU + 1 * MiB;
constexpr size_t WS_WKVUP = WS_WQUP + 1 * MiB;
constexpr size_t WS_WLRU = WS_WKVUP + 1 * MiB;
constexpr size_t WS_X = WS_WLRU + 2 * MiB;
constexpr size_t WS_H = WS_X + 288 * MiB + WS_SKEW * 129 * 256;
constexpr size_t WS_Z = WS_H + 144 * MiB + WS_SKEW * 67 * 256;
constexpr size_t WS_Y = WS_Z + 306 * MiB + WS_SKEW * 201 * 256;
constexpr size_t WS_HID = WS_Y + 144 * MiB + WS_SKEW * 37 * 256;
constexpr size_t WS_T = WS_HID + 128 * MiB + WS_SKEW * 93 * 256;
constexpr size_t WS_XS = WS_H;
constexpr size_t WS_AQ = WS_H + 36 * MiB;
constexpr size_t WS_AKV = WS_H + 63 * MiB;
constexpr size_t WS_Q = WS_H;
constexpr size_t WS_K = WS_H + 54 * MiB;
constexpr size_t WS_VT = WS_H + 108 * MiB;
constexpr size_t WS_QRAW = WS_HID;
constexpr size_t WS_KVRAW = WS_HID + 54 * MiB;
constexpr size_t WS_LOGA = WS_T;
constexpr size_t WS_GB = WS_T + 72 * MiB;
constexpr size_t WS_YS = WS_T + 144 * MiB;
constexpr size_t WS_A5 = WS_X + 144 * MiB;
constexpr size_t WS_MH = WS_T + 216 * MiB;
constexpr size_t WS_LH = WS_T + 288 * MiB;
constexpr size_t WS_MODP = WS_Z;
constexpr size_t WS_LSUM = WS_T + 360 * MiB;
constexpr size_t WS_SHW = WS_T + 368 * MiB;
constexpr size_t WS_SSP = WS_T + 372 * MiB;
constexpr size_t WS_RSTD = WS_T + 377 * MiB;
constexpr size_t WS_END = WS_T + 378 * MiB;
static_assert(WS_END <= (size_t)1536 * MiB, "d_ws map exceeds 4 x largest input tensor");

constexpr int CW_TMO = 0, CW_CODE = 1;
constexpr int CW_BAR = 4096;
constexpr int CW_QUEUE = 8192;

constexpr int RING_OFF = 0, RING_BYTES = 131072;
constexpr int LDSCTL_OFF = RING_BYTES, MISC_OFF = LDSCTL_OFF + 320;
constexpr int LDS_BYTES = 147456;

#define GAS __attribute__((address_space(1)))
#define LAS __attribute__((address_space(3)))
typedef unsigned short bf16;
typedef unsigned v4u __attribute__((ext_vector_type(4)));
typedef unsigned v2u __attribute__((ext_vector_type(2)));
typedef float f32x4 __attribute__((ext_vector_type(4)));
typedef float f32x16 __attribute__((ext_vector_type(16)));
typedef short bf16x8 __attribute__((ext_vector_type(8)));
typedef short bf16x4 __attribute__((ext_vector_type(4)));
typedef GAS unsigned gu32;
#define RLX_AGENT __ATOMIC_RELAXED, __HIP_MEMORY_SCOPE_AGENT
#define LDS_WAIT() asm volatile("s_waitcnt lgkmcnt(0)" ::: "memory")
#define VM_WAIT() asm volatile("s_waitcnt vmcnt(0)" ::: "memory")
__device__ __forceinline__ unsigned f2bf(float f) { unsigned u = __builtin_bit_cast(unsigned, f); return (u + 0x7fffu + ((u >> 16) & 1u)) >> 16; }
typedef __bf16 bf16x2_t __attribute__((ext_vector_type(2)));
typedef float f32x2_t __attribute__((ext_vector_type(2)));
__device__ __forceinline__ unsigned pk2(float lo, float hi) { const f32x2_t v = {lo, hi}; const bf16x2_t b = __builtin_convertvector(v, bf16x2_t); return __builtin_bit_cast(unsigned, b); }
__device__ __forceinline__ float bf2f(unsigned b) { return __builtin_bit_cast(float, b << 16); }
__device__ __forceinline__ float bflo(unsigned w) { return __builtin_bit_cast(float, w << 16); }
__device__ __forceinline__ float bfhi(unsigned w) { return __builtin_bit_cast(float, w & 0xffff0000u); }
__device__ __forceinline__ void unpack8(const v4u w, float (&f)[8]) { f[0] = bflo(w.x); f[1] = bfhi(w.x); f[2] = bflo(w.y); f[3] = bfhi(w.y); f[4] = bflo(w.z); f[5] = bfhi(w.z); f[6] = bflo(w.w); f[7] = bfhi(w.w); }
__device__ __forceinline__ v4u pack8(const float (&f)[8]) { v4u w; w.x = pk2(f[0], f[1]); w.y = pk2(f[2], f[3]); w.z = pk2(f[4], f[5]); w.w = pk2(f[6], f[7]); return w; }
__device__ __forceinline__ float sigmoidf_(float x) { return __builtin_amdgcn_rcpf(1.f + __expf(-x)); }
__device__ __forceinline__ float gelu_tanh(float x) { const float u = 0.7978845608028654f * (x + 0.044715f * x * x * x); const float t = 1.f - 2.f * __builtin_amdgcn_rcpf(1.f + __expf(2.f * u)); return 0.5f * x * (1.f + t); }
__device__ __forceinline__ float softplusf_(float x) { return fmaxf(x, 0.f) + log1pf(__expf(-fabsf(x))); }
__device__ __forceinline__ float logsigmoidf_(float x) { return fminf(x, 0.f) - log1pf(__expf(-fabsf(x))); }
__device__ __forceinline__ float shx(float v, int mask, int lane) { return __builtin_bit_cast(float, __builtin_amdgcn_ds_bpermute((lane ^ mask) << 2, __builtin_bit_cast(int, v))); }
__device__ __forceinline__ float shup(float v, int delta, int lane) { return __builtin_bit_cast(float, __builtin_amdgcn_ds_bpermute(((lane - delta) & 63) << 2, __builtin_bit_cast(int, v))); }
__device__ __forceinline__ float wave_sum(float v, int lane) {
#pragma unroll
    for (int o = 1; o < 64; o <<= 1) v += shx(v, o, lane);
    return v;
}
__device__ __forceinline__ v4u zero_v4u() { unsigned z = 0u; asm volatile("" : "+v"(z)); return (v4u){z, z, z, z}; }
__device__ __forceinline__ int row_scan(int b, int dir, int p) {
    if (p < CTXL) { const int t = dir ? (CTXL - 1 - p) : p; return RL + b * CTXL + t; }
    const int q = p - CTXL; const int t = dir ? (SEQ - 1 - q) : q; return b * SEQ + t;
}
__device__ __forceinline__ int row_key(int b, int key) { return key < CTXL ? RL + b * CTXL + key : b * SEQ + (key - CTXL); }
__device__ __forceinline__ int mod_row(int r) { return r < RL ? (r >> 11) : NB; }
namespace pg8 {
#define PG8_LAS __attribute__((address_space(3)))
typedef unsigned short bf16_t;
typedef short bf16x8 __attribute__((ext_vector_type(8)));
typedef float f32x4 __attribute__((ext_vector_type(4)));
typedef unsigned u32x4 __attribute__((ext_vector_type(4)));
constexpr int BM = 256, BK = 64, HALF = 128, HTB = HALF * BK * 2  , STAGE_BYTES = 8 * HTB, NXCD = 8, WGM = 8;

__host__ __device__ __forceinline__ int lds_byte(int r, int c) { const int st = (r >> 4) * 2 + (c >> 5), rr = r & 15, cc = c & 31, ob = rr * 64 + cc * 2; return st * 1024 + (ob ^ (((ob >> 9) & 1) << 5)); }
__host__ __device__ __forceinline__ void stage_rc(int b, int& R, int& C) { const int st = b / 1024, sb = b % 1024, swz = sb ^ (((sb >> 9) & 1) << 5); R = (st >> 1) * 16 + swz / 64; C = (st & 1) * 32 + (swz % 64) / 2; }
__host__ __device__ __forceinline__ int perm32(int rho) { const int n = rho >> 4, i = rho & 15; return 8 * (i >> 2) + 4 * n + (i & 3); }

struct Unit { int pm, pn; };
struct Gemm { const bf16_t* A; const bf16_t* Bt; int M, N, K; int ld = 0, nsplit = 0, ablk = 0; };

struct StaticOrder {
    int nM, nN, nwg, G, c;
    __host__ __device__ void init(int M, int N, int G_, int c_) { nM = M / BM; nN = N / BM; nwg = nM * nN; G = G_; c = c_; }
    __host__ __device__ bool next(int i, Unit& u) const {
        const long L = (long)i * G + c; if (L >= nwg) return false;
        int wgid = (int)L; { const int q = nwg / NXCD, r = nwg % NXCD, xcd = wgid % NXCD, off = wgid / NXCD; wgid = (xcd < r ? xcd * (q + 1) : r * (q + 1) + (xcd - r) * q) + off; }
        const int nig = WGM * nN, gid = wgid / nig, fm = gid * WGM, gsz = (nM - fm) < WGM ? (nM - fm) : WGM;
        u.pm = fm + ((wgid % nig) % gsz); u.pn = (wgid % nig) / gsz; return true;
    }
    __device__ __forceinline__ void a_ready(const Unit&) const {}
    __device__ __forceinline__ void done(const Unit&) const {}
};

__device__ __forceinline__ unsigned cvt_pk_bf16(float lo, float hi) { unsigned r; asm volatile("v_cvt_pk_bf16_f32 %0, %1, %2" : "=v"(r) : "v"(lo), "v"(hi)); return r; }
typedef float f32x2 __attribute__((ext_vector_type(2)));
__device__ __forceinline__ float bf_lo(unsigned w) { return __builtin_bit_cast(float, w << 16); }
__device__ __forceinline__ float bf_hi(unsigned w) { return __builtin_bit_cast(float, w & 0xffff0000u); }
template <class T> __device__ __forceinline__ void st_stream(T* p, const T v) { if (EPI_NT) __builtin_nontemporal_store(v, p); else *p = v; }
struct EpiStoreBf16 {
    static constexpr bool PERM = true, AFTER_DRAIN = false;
    bf16_t* O; int ldc;
    __device__ __forceinline__ void operator()(const f32x4 (&acc)[2][2][4][2], const Unit& u, int wr, int wc, int fr, int fq) const {
        const int row0 = u.pm * BM + wr * 64 + fr, col0 = u.pn * BM + wc * 32 + 8 * fq;
#pragma unroll
        for (int ai = 0; ai < 2; ++ai)
#pragma unroll
            for (int m = 0; m < 4; ++m) { bf16_t* rowp = O + (size_t)(row0 + ai * HALF + m * 16) * ldc + col0;
#pragma unroll
                for (int bj = 0; bj < 2; ++bj) { const f32x4 v0 = acc[ai][bj][m][0], v1 = acc[ai][bj][m][1];
                    u32x4 w; w.x = cvt_pk_bf16(v0[0], v0[1]); w.y = cvt_pk_bf16(v0[2], v0[3]); w.z = cvt_pk_bf16(v1[0], v1[1]); w.w = cvt_pk_bf16(v1[2], v1[3]);
                    *(u32x4*)(rowp + bj * HALF) = w; } }
    }
};
struct EpiRelu2 {
    static constexpr bool PERM = true, AFTER_DRAIN = false;
    bf16_t* O; int ldc;
    __device__ __forceinline__ void operator()(const f32x4 (&acc)[2][2][4][2], const Unit& u, int wr, int wc, int fr, int fq) const {
        const int row0 = u.pm * BM + wr * 64 + fr, col0 = u.pn * BM + wc * 32 + 8 * fq;
#pragma unroll
        for (int ai = 0; ai < 2; ++ai)
#pragma unroll
            for (int m = 0; m < 4; ++m) { bf16_t* rowp = O + (size_t)(row0 + ai * HALF + m * 16) * ldc + col0;
#pragma unroll
                for (int bj = 0; bj < 2; ++bj) { f32x4 v0 = acc[ai][bj][m][0], v1 = acc[ai][bj][m][1];
#pragma unroll
                    for (int j = 0; j < 4; ++j) { const float a = fmaxf(v0[j], 0.f), b = fmaxf(v1[j], 0.f); v0[j] = a * a; v1[j] = b * b; }
                    u32x4 w; w.x = cvt_pk_bf16(v0[0], v0[1]); w.y = cvt_pk_bf16(v0[2], v0[3]); w.z = cvt_pk_bf16(v1[0], v1[1]); w.w = cvt_pk_bf16(v1[2], v1[3]);
                    *(u32x4*)(rowp + bj * HALF) = w; } }
    }
};
__device__ __forceinline__ void atomic_add_f32_dev(float* p, float v) { asm volatile("global_atomic_add_f32 %0, %1, off sc1" :: "v"(p), "v"(v) : "memory"); }
template <bool ATOMIC = false> struct EpiResT {
    static constexpr bool PERM = true, AFTER_DRAIN = false;
    const float* xin; float* xout; const float* gate; int row_base;
    __device__ __forceinline__ void operator()(const f32x4 (&acc)[2][2][4][2], const Unit& u, int wr, int wc, int fr, int fq) const {
        const int row0 = row_base + u.pm * BM + wr * 64 + fr, col0 = u.pn * BM + wc * 32 + 8 * fq;
        const int mrow = row0 < 32768 ? (row0 >> 11) : 16;
        const float* gp = gate + (size_t)mrow * 12288 + col0;
        f32x4 gv[2][2];
#pragma unroll
        for (int bj = 0; bj < 2; ++bj)
#pragma unroll
            for (int n = 0; n < 2; ++n) gv[bj][n] = *(const f32x4*)(gp + bj * HALF + n * 4);
#pragma unroll
        for (int ai = 0; ai < 2; ++ai) {
            f32x4 xv[4][2][2];
#pragma unroll
            for (int m = 0; m < 4; ++m) { const size_t off = (size_t)(row0 + ai * HALF + m * 16) * 2048 + col0;
#pragma unroll
                for (int bj = 0; bj < 2; ++bj)
#pragma unroll
                    for (int n = 0; n < 2; ++n) xv[m][bj][n] = *(const f32x4*)(xin + off + bj * HALF + n * 4); }
#pragma unroll
            for (int m = 0; m < 4; ++m) { const size_t off = (size_t)(row0 + ai * HALF + m * 16) * 2048 + col0;
#pragma unroll
                for (int bj = 0; bj < 2; ++bj)
#pragma unroll
                    for (int n = 0; n < 2; ++n) *(f32x4*)(xout + off + bj * HALF + n * 4) = xv[m][bj][n] + gv[bj][n] * acc[ai][bj][m][n]; }
            asm volatile("" ::: "memory");
        }
    }
};
typedef EpiResT<false> EpiRes;
__device__ __forceinline__ float sigm(float x) { return __builtin_amdgcn_rcpf(1.f + __expf(-x)); }
struct EpiGlu {
    static constexpr bool PERM = true, AFTER_DRAIN = false;
    const bf16_t* A5; bf16_t* Y; int ldy; const float* bias;
    __device__ __forceinline__ void operator()(const f32x4 (&acc)[2][2][4][2], const Unit& u, int wr, int wc, int fr, int fq) const {
        const int row0 = u.pm * BM + wr * 64 + fr, col0 = u.pn * BM + wc * 32 + 8 * fq;
        f32x4 bv[2][2];
#pragma unroll
        for (int bj = 0; bj < 2; ++bj)
#pragma unroll
            for (int n = 0; n < 2; ++n) bv[bj][n] = *(const f32x4*)(bias + col0 + bj * HALF + 4 * n);
#pragma unroll
        for (int ai = 0; ai < 2; ++ai)
#pragma unroll
            for (int m = 0; m < 4; ++m) { const int row = row0 + ai * HALF + m * 16;
#pragma unroll
                for (int bj = 0; bj < 2; ++bj) { const u32x4 aw = *(const u32x4*)(A5 + (size_t)row * 512 + col0 + bj * HALF);
                    const f32x4 v0 = acc[ai][bj][m][0] + bv[bj][0], v1 = acc[ai][bj][m][1] + bv[bj][1];
                    const float a0 = bf_lo(aw.x), a1 = bf_hi(aw.x), a2 = bf_lo(aw.y), a3 = bf_hi(aw.y), a4 = bf_lo(aw.z), a5 = bf_hi(aw.z), a6 = bf_lo(aw.w), a7 = bf_hi(aw.w);
                    u32x4 w; w.x = cvt_pk_bf16(a0 * sigm(v0[0]), a1 * sigm(v0[1])); w.y = cvt_pk_bf16(a2 * sigm(v0[2]), a3 * sigm(v0[3]));
                    w.z = cvt_pk_bf16(a4 * sigm(v1[0]), a5 * sigm(v1[1])); w.w = cvt_pk_bf16(a6 * sigm(v1[2]), a7 * sigm(v1[3]));
                    *(u32x4*)(Y + (size_t)row * ldy + col0 + bj * HALF) = w; } }
    }
};
struct EpiLru {
    static constexpr bool PERM = true, AFTER_DRAIN = false;
    const bf16_t* XS; bf16_t* LOGA; bf16_t* GB; const float* cst;
    __device__ __forceinline__ void operator()(const f32x4 (&acc)[2][2][4][2], const Unit& u, int wr, int wc, int fr, int fq) const {
        const int row0 = u.pm * BM + wr * 64 + fr, d = u.pn >> 2, nb = u.pn & 3, ch0 = nb * 128 + wc * 32 + 8 * fq;
        const float* cp = cst + d * 512 + ch0;
#pragma unroll
        for (int ai = 0; ai < 2; ++ai)
#pragma unroll
            for (int m = 0; m < 4; ++m) { const int row = row0 + ai * HALF + m * 16;
                const u32x4 xw = *(const u32x4*)(XS + (size_t)row * 512 + ch0);
                const float xs[8] = {bf_lo(xw.x), bf_hi(xw.x), bf_lo(xw.y), bf_hi(xw.y), bf_lo(xw.z), bf_hi(xw.z), bf_lo(xw.w), bf_hi(xw.w)};
#pragma unroll
                for (int n = 0; n < 2; ++n) { const f32x4 bav = *(const f32x4*)(cp + 4 * n), bxv = *(const f32x4*)(cp + 1024 + 4 * n), spv = *(const f32x4*)(cp + 2048 + 4 * n);
                    float la[4], gb[4];
#pragma unroll
                    for (int i = 0; i < 4; ++i) { const float r = sigm(acc[ai][0][m][n][i] + bav[i]), ig = sigm(acc[ai][1][m][n][i] + bxv[i]); const float l = -8.f * r * spv[i];
                        la[i] = l; const float x2 = 2.f * l;
                        const float em = -x2 * (1.f + 0.5f * x2 * (1.f + (1.f / 3.f) * x2 * (1.f + 0.25f * x2 * (1.f + 0.2f * x2 * (1.f + (1.f / 6.f) * x2)))));
                        gb[i] = __builtin_amdgcn_sqrtf(fmaxf(x2 > -0.25f ? em : 1.f - __expf(x2), 0.f)) * (ig * xs[4 * n + i]); }
                    typedef unsigned u32x2 __attribute__((ext_vector_type(2)));
                    u32x2 w1, w2; w1.x = cvt_pk_bf16(la[0], la[1]); w1.y = cvt_pk_bf16(la[2], la[3]); w2.x = cvt_pk_bf16(gb[0], gb[1]); w2.y = cvt_pk_bf16(gb[2], gb[3]);
                    *(u32x2*)(LOGA + (size_t)row * 1024 + d * 512 + ch0 + 4 * n) = w1; *(u32x2*)(GB + (size_t)row * 1024 + d * 512 + ch0 + 4 * n) = w2; }
                asm volatile("" ::: "memory"); }
    }
};
struct EpiNull {
    static constexpr bool PERM = false, AFTER_DRAIN = false;
    __device__ __forceinline__ void operator()(const f32x4 (&acc)[2][2][4][2], const Unit& u, int wr, int wc, int fr, int fq) const {
#pragma unroll
        for (int ai = 0; ai < 2; ++ai)
#pragma unroll
            for (int bj = 0; bj < 2; ++bj)
#pragma unroll
                for (int m = 0; m < 4; ++m)
#pragma unroll
                    for (int n = 0; n < 2; ++n) asm volatile("" :: "v"(acc[ai][bj][m][n]));
    }
};

template <bool XIN_F32> struct EpiResNT {
    static constexpr bool PERM = true, AFTER_DRAIN = false;
    const void* xin; const void* xin_ctx; bf16_t* xout; const float* gate; int row_base;
    bf16_t* H; const float* nw; const float* nscale; float* SSP;
    __device__ __forceinline__ void operator()(const f32x4 (&acc)[2][2][4][2], const Unit& u, int wr, int wc, int fr, int fq) const {
        const int row0 = row_base + u.pm * BM + wr * 64 + fr, col0 = u.pn * BM + wc * 32 + 8 * fq, lane = fq * 16 + fr;
        const int mrow = row0 < 32768 ? (row0 >> 11) : 16;
        const float* gp = gate + (size_t)mrow * 12288 + col0; const float* sp = nscale + (size_t)mrow * 12288 + col0; const void* xb = row0 < 32768 ? xin : xin_ctx;
        f32x4 gv[2][2], hs[2][2];
#pragma unroll
        for (int bj = 0; bj < 2; ++bj)
#pragma unroll
            for (int n = 0; n < 2; ++n) { gv[bj][n] = *(const f32x4*)(gp + bj * HALF + n * 4); hs[bj][n] = *(const f32x4*)(nw + col0 + bj * HALF + n * 4) * (*(const f32x4*)(sp + bj * HALF + n * 4) + 1.f); }
        constexpr int NB_ = XIN_F32 ? 4 : 2, MB_ = XIN_F32 ? 2 : 4;
#pragma unroll
        for (int am = 0; am < NB_; ++am) {
            const int ai = XIN_F32 ? (am >> 1) : am, mb = XIN_F32 ? 2 * (am & 1) : 0;
            f32x4 xv[XIN_F32 ? 2 : 1][2][2]; u32x4 xw[XIN_F32 ? 1 : 4][2];
#pragma unroll
            for (int mm = 0; mm < MB_; ++mm) { const int rowl = row0 + ai * HALF + (mb + mm) * 16; const size_t off = (size_t)rowl * 2048 + col0;
#pragma unroll
                for (int bj = 0; bj < 2; ++bj) {
                    if constexpr (XIN_F32) {
#pragma unroll
                        for (int n = 0; n < 2; ++n) xv[mm][bj][n] = *(const f32x4*)((const float*)xb + off + bj * HALF + n * 4); }
                    else xw[mm][bj] = *(const u32x4*)((const bf16_t*)xb + blk_off(rowl, col0, 8) + bj * HALF); } }
#pragma unroll
            for (int mm = 0; mm < MB_; ++mm) { const int m = mb + mm; const int row = row0 + ai * HALF + m * 16; const size_t off = blk_off(row, col0, 8); float ss = 0.f;
#pragma unroll
                for (int bj = 0; bj < 2; ++bj) { u32x4 w, xo;
#pragma unroll
                    for (int n = 0; n < 2; ++n) { f32x4 xi;
                        if constexpr (XIN_F32) xi = xv[mm][bj][n]; else xi = (f32x4){bf_lo(xw[mm][bj][2 * n]), bf_hi(xw[mm][bj][2 * n]), bf_lo(xw[mm][bj][2 * n + 1]), bf_hi(xw[mm][bj][2 * n + 1])};
                        const f32x4 xn = xi + gv[bj][n] * acc[ai][bj][m][n];
                        xo[2 * n] = cvt_pk_bf16(xn[0], xn[1]); xo[2 * n + 1] = cvt_pk_bf16(xn[2], xn[3]);
                        ss += (xn[0] * xn[0] + xn[1] * xn[1]) + (xn[2] * xn[2] + xn[3] * xn[3]);
                        const f32x4 hv = xn * hs[bj][n]; w[2 * n] = cvt_pk_bf16(hv[0], hv[1]); w[2 * n + 1] = cvt_pk_bf16(hv[2], hv[3]); }
                    st_stream((u32x4*)(xout + off + bj * HALF), xo);
                    st_stream((u32x4*)(H + off + bj * HALF), w); }
                ss += __builtin_bit_cast(float, __builtin_amdgcn_ds_bpermute((lane ^ 16) << 2, __builtin_bit_cast(int, ss)));
                ss += __builtin_bit_cast(float, __builtin_amdgcn_ds_bpermute((lane ^ 32) << 2, __builtin_bit_cast(int, ss)));
                if (fq == 0) SSP[(size_t)row * 32 + u.pn * 4 + wc] = ss; }
            asm volatile("" ::: "memory");
        }
    }
};
typedef EpiResNT<true> EpiResNF; typedef EpiResNT<false> EpiResN;
struct EpiResOut {
    static constexpr bool PERM = true, AFTER_DRAIN = false;
    const bf16_t* xin; float* xout; const float* gate; int row_base;
    __device__ __forceinline__ void operator()(const f32x4 (&acc)[2][2][4][2], const Unit& u, int wr, int wc, int fr, int fq) const {
        const int row0 = row_base + u.pm * BM + wr * 64 + fr, col0 = u.pn * BM + wc * 32 + 8 * fq;
        const int mrow = row0 < 32768 ? (row0 >> 11) : 16;
        const float* gp = gate + (size_t)mrow * 12288 + col0;
        f32x4 gv[2][2];
#pragma unroll
        for (int bj = 0; bj < 2; ++bj)
#pragma unroll
            for (int n = 0; n < 2; ++n) gv[bj][n] = *(const f32x4*)(gp + bj * HALF + n * 4);
#pragma unroll
        for (int ai = 0; ai < 2; ++ai) {
            u32x4 xw[4][2];
#pragma unroll
            for (int m = 0; m < 4; ++m) { const size_t off = blk_off(row0 + ai * HALF + m * 16, col0, 8);
#pragma unroll
                for (int bj = 0; bj < 2; ++bj) xw[m][bj] = *(const u32x4*)(xin + off + bj * HALF); }
#pragma unroll
            for (int m = 0; m < 4; ++m) { const size_t off = (size_t)(row0 + ai * HALF + m * 16) * 2048 + col0;
#pragma unroll
                for (int bj = 0; bj < 2; ++bj)
#pragma unroll
                    for (int n = 0; n < 2; ++n) { const f32x4 xi = (f32x4){bf_lo(xw[m][bj][2 * n]), bf_hi(xw[m][bj][2 * n]), bf_lo(xw[m][bj][2 * n + 1]), bf_hi(xw[m][bj][2 * n + 1])};
                        *(f32x4*)(xout + off + bj * HALF + n * 4) = xi + gv[bj][n] * acc[ai][bj][m][n]; } }
            asm volatile("" ::: "memory");
        }
    }
};
struct EpiStoreN {
    static constexpr bool PERM = true, AFTER_DRAIN = false;
    bf16_t* O; int ldc; const float* rstd; const float* shw; int ldshw;
    __device__ __forceinline__ void operator()(const f32x4 (&acc)[2][2][4][2], const Unit& u, int wr, int wc, int fr, int fq) const {
        const int row0 = u.pm * BM + wr * 64 + fr, col0 = u.pn * BM + wc * 32 + 8 * fq;
        const int mrow = row0 < 32768 ? (row0 >> 11) : 16;
        f32x4 sv[2][2];
#pragma unroll
        for (int bj = 0; bj < 2; ++bj)
#pragma unroll
            for (int n = 0; n < 2; ++n) sv[bj][n] = *(const f32x4*)(shw + (size_t)mrow * ldshw + col0 + bj * HALF + 4 * n);
#pragma unroll
        for (int ai = 0; ai < 2; ++ai)
#pragma unroll
            for (int m = 0; m < 4; ++m) { const int row = row0 + ai * HALF + m * 16; const float rs = rstd[row]; bf16_t* rowp = O + (size_t)row * ldc + col0;
#pragma unroll
                for (int bj = 0; bj < 2; ++bj) { const f32x4 v0 = acc[ai][bj][m][0] * rs + sv[bj][0], v1 = acc[ai][bj][m][1] * rs + sv[bj][1];
                    u32x4 w; w.x = cvt_pk_bf16(v0[0], v0[1]); w.y = cvt_pk_bf16(v0[2], v0[3]); w.z = cvt_pk_bf16(v1[0], v1[1]); w.w = cvt_pk_bf16(v1[2], v1[3]);
                    st_stream((u32x4*)(rowp + bj * HALF), w); } }
    }
};
struct EpiRelu2N {
    static constexpr bool PERM = true, AFTER_DRAIN = false;
    bf16_t* O; int ldc; const float* rstd; const float* shw; int ldshw; int row_base;
    __device__ __forceinline__ void operator()(const f32x4 (&acc)[2][2][4][2], const Unit& u, int wr, int wc, int fr, int fq) const {
        const int row0 = u.pm * BM + wr * 64 + fr, col0 = u.pn * BM + wc * 32 + 8 * fq, grow0 = row_base + row0;
        const int mrow = grow0 < 32768 ? (grow0 >> 11) : 16;
        f32x4 sv[2][2];
#pragma unroll
        for (int bj = 0; bj < 2; ++bj)
#pragma unroll
            for (int n = 0; n < 2; ++n) sv[bj][n] = *(const f32x4*)(shw + (size_t)mrow * ldshw + col0 + bj * HALF + 4 * n);
#pragma unroll
        for (int ai = 0; ai < 2; ++ai)
#pragma unroll
            for (int m = 0; m < 4; ++m) { const int row = row0 + ai * HALF + m * 16; const float rs = rstd[row_base + row]; bf16_t* rowp = O + blk_off(row, col0, ldc >> 8);
#pragma unroll
                for (int bj = 0; bj < 2; ++bj) { f32x4 v0 = acc[ai][bj][m][0] * rs + sv[bj][0], v1 = acc[ai][bj][m][1] * rs + sv[bj][1];
#pragma unroll
                    for (int j = 0; j < 4; ++j) { const float a = fmaxf(v0[j], 0.f), b = fmaxf(v1[j], 0.f); v0[j] = a * a; v1[j] = b * b; }
                    u32x4 w; w.x = cvt_pk_bf16(v0[0], v0[1]); w.y = cvt_pk_bf16(v0[2], v0[3]); w.z = cvt_pk_bf16(v1[0], v1[1]); w.w = cvt_pk_bf16(v1[2], v1[3]);
                    *(u32x4*)(rowp + bj * HALF) = w; } }
    }
};

struct EpiPart {
    static constexpr bool PERM = false, AFTER_DRAIN = false, VIRT = true;
    float* P; int ntile; int rows;
    __device__ __forceinline__ void operator()(const f32x4 (&acc)[2][2][4][2], const Unit& u, int wr, int wc, int fr, int fq) const {
        const int slice = u.pn / ntile, pn = u.pn % ntile, ld = 256 * ntile;
        const int row0 = u.pm * BM + wr * 64 + fr, col0 = pn * BM + wc * 32 + 4 * fq; float* base = P + (size_t)slice * rows * ld;
#pragma unroll
        for (int ai = 0; ai < 2; ++ai)
#pragma unroll
            for (int m = 0; m < 4; ++m) { float* rowp = base + (size_t)(row0 + ai * HALF + m * 16) * ld + col0;
#pragma unroll
                for (int bj = 0; bj < 2; ++bj)
#pragma unroll
                    for (int n = 0; n < 2; ++n) *(f32x4*)(rowp + bj * HALF + n * 16) = acc[ai][bj][m][n]; }
    }
};
template <class T, class = void> struct epi_virt { static constexpr bool value = false; };
template <class T> struct epi_virt<T, decltype((void)T::VIRT)> { static constexpr bool value = true; };
template <class Epi, class Sched, bool ALIGN_EPI = false, bool SP2 = false, int NSP = 0>
__device__ __forceinline__ void gemm_phase(PG8_LAS unsigned char* lds, const Gemm g, const Sched& S, const Epi& E, const int tid_in) {
    const int tid = tid_in,
    wid = __builtin_amdgcn_readfirstlane(tid >> 6), lane = tid & 63, wr = wid >> 2, wc = wid & 3, fr = lane & 15, fq = lane >> 4;
    const int K = g.K, nt = K / BK, LD = g.ld ? g.ld : g.K;
    const bool ablk = BLK_LAYOUT && g.ablk; const int LDA = ablk ? 256 : LD;
    unsigned voffA[2], voffB[2];
#pragma unroll
    for (int i = 0; i < 2; ++i) { int R, C; stage_rc(tid * 16 + i * 8192, R, C); const int Rb = Epi::PERM ? ((R & ~31) + perm32(R & 31)) : R;
        voffA[i] = (unsigned)(R * LDA + C) * 2u; voffB[i] = (unsigned)(Rb * LD + C) * 2u; }
    const size_t kstep = (size_t)(BK * 2);
    const size_t hstep = (size_t)HALF * LD * 2;
    const size_t hstepA = (size_t)HALF * LDA * 2;
#define PG8_KOFF(t) (ablk ? (((size_t)((t) >> 2) << 17) + (size_t)(((t) & 3) << 7)) : (size_t)(t) * kstep)
    const size_t tstep = 2 * hstep;
    const unsigned ldsw = (unsigned)wid * 1024u;
    const int aoff = lds_byte(wr * 64 + fr, fq * 8), boff = lds_byte(wc * 32 + fr, fq * 8);
#define PG8_SA(b, h) (((b) * 2 + (h)) * HTB)
#define PG8_SB(b, h) ((4 + (b) * 2 + (h)) * HTB)
#define PG8_STAGE(bufoff, gbase, voff) do { _Pragma("unroll") for (int _i = 0; _i < 2; ++_i) \
        __builtin_amdgcn_global_load_lds((const unsigned*)((const char*)(gbase) + (voff)[_i]), (PG8_LAS unsigned*)(lds + (bufoff) + ldsw + _i * 8192), 16, 0, 0); } while (0)
#define PG8_LDA(dst, b, h) do { _Pragma("unroll") for (int m = 0; m < 4; ++m) _Pragma("unroll") for (int k = 0; k < 2; ++k) dst[m][k] = *(const PG8_LAS bf16x8*)(lds + PG8_SA(b, h) + aoff + m * 2048 + k * 1024); } while (0)
#define PG8_LDB(dst, b, h) do { _Pragma("unroll") for (int n = 0; n < 2; ++n) _Pragma("unroll") for (int k = 0; k < 2; ++k) dst[n][k] = *(const PG8_LAS bf16x8*)(lds + PG8_SB(b, h) + boff + n * 2048 + k * 1024); } while (0)
#define PG8_MMA(ai, bj, At, Bt) do { __builtin_amdgcn_s_setprio(1); _Pragma("unroll") for (int m = 0; m < 4; ++m) _Pragma("unroll") for (int n = 0; n < 2; ++n) _Pragma("unroll") for (int k = 0; k < 2; ++k) \
        acc[ai][bj][m][n] = __builtin_amdgcn_mfma_f32_16x16x32_bf16(Bt[n][k], At[m][k], acc[ai][bj][m][n], 0, 0, 0); __builtin_amdgcn_s_setprio(0); } while (0)
#define PG8_WAIT_V(n) asm volatile("s_waitcnt vmcnt(" #n ")" ::: "memory")
#define PG8_WAIT_L(n) asm volatile("s_waitcnt lgkmcnt(" #n ")" ::: "memory")
#define PG8_BAR __builtin_amdgcn_s_barrier()
#define PG8_SCHED __builtin_amdgcn_sched_barrier(0)
    Unit cur, nxt; int ui = 0;
    if (!S.next(0, cur)) return;
    f32x4 acc[2][2][4][2];
    float zf = 0.f; asm volatile("" : "+v"(zf));
    const f32x4 zero4 = (f32x4){zf, zf, zf, zf};
#pragma unroll
    for (int a = 0; a < 2; ++a)
#pragma unroll
        for (int b = 0; b < 2; ++b)
#pragma unroll
            for (int m = 0; m < 4; ++m)
#pragma unroll
                for (int n = 0; n < 2; ++n) acc[a][b][m][n] = zero4;
    bf16x8 At[4][2], B0[2][2], B1[2][2];
#define PG8_SLICE(u) (NSP > 0 ? (u).pn / NSP : (NSP < 0 ? ((u).pn & (-NSP - 1)) : 0))
#define PG8_PNR(u) (NSP > 0 ? (u).pn % NSP : (u).pn)
#define PG8_ABASE(u) ((const char*)g.A + (size_t)(u).pm * tstep + (size_t)PG8_SLICE(u) * K * (ablk ? 512 : 2))
#define PG8_BBASE(u) ((const char*)g.Bt + (size_t)PG8_PNR(u) * tstep + (size_t)PG8_SLICE(u) * K * 2)
    const char* cA = PG8_ABASE(cur); const char* cB = PG8_BBASE(cur);
    S.a_ready(cur);
    if constexpr (SP2) {
        PG8_STAGE(PG8_SB(0, 0), cB, voffB); PG8_STAGE(PG8_SB(0, 1), cB + hstep, voffB); PG8_STAGE(PG8_SA(0, 0), cA, voffA); PG8_STAGE(PG8_SA(0, 1), cA + hstepA, voffA);
        if (wr == 1) PG8_BAR;
        PG8_WAIT_V(2); PG8_BAR;
        PG8_STAGE(PG8_SB(1, 0), cB + kstep, voffB); PG8_STAGE(PG8_SA(1, 0), cA + kstep, voffA); PG8_STAGE(PG8_SB(1, 1), cB + hstep + kstep, voffB);
        PG8_WAIT_V(6); PG8_BAR;
    } else {
        PG8_STAGE(PG8_SB(0, 0), cB, voffB); PG8_STAGE(PG8_SA(0, 0), cA, voffA); PG8_STAGE(PG8_SB(0, 1), cB + hstep, voffB); PG8_STAGE(PG8_SA(0, 1), cA + hstepA, voffA);
        if (wr == 1) PG8_BAR;
        PG8_WAIT_V(4); PG8_BAR;
        PG8_STAGE(PG8_SB(1, 0), cB + kstep, voffB); PG8_STAGE(PG8_SA(1, 0), cA + kstep, voffA); PG8_STAGE(PG8_SB(1, 1), cB + hstep + kstep, voffB);
        PG8_WAIT_V(6); PG8_BAR;
    }
    for (;;) {
        const bool has_next = S.next(ui + 1, nxt);
        const char* nA = has_next ? PG8_ABASE(nxt) : cA; const char* nB = has_next ? PG8_BBASE(nxt) : cB;
        for (int t = 0; t < nt; t += 2) {
            const bool last = (t == nt - 2);
            const char* a1 = cA + PG8_KOFF(t) + kstep;
            const char* a2 = last ? nA : cA + PG8_KOFF(t + 2); const char* b2 = last ? nB : cB + (size_t)(t + 2) * kstep;
            const char* a3 = a2 + kstep; const char* b3 = b2 + kstep;
            if (last && has_next) S.a_ready(nxt);
            if constexpr (SP2) {
            PG8_LDB(B0, 0, 0); PG8_LDB(B1, 0, 1); PG8_SCHED; PG8_LDA(At, 0, 0); PG8_STAGE(PG8_SA(1, 1), a1 + hstepA, voffA);
            PG8_WAIT_V(8); PG8_WAIT_L(0); PG8_BAR; PG8_MMA(0, 0, At, B0); PG8_MMA(0, 1, At, B1); PG8_BAR; PG8_SCHED;
            PG8_LDA(At, 0, 1); PG8_STAGE(PG8_SB(0, 0), b2, voffB); PG8_STAGE(PG8_SB(0, 1), b2 + hstep, voffB); PG8_STAGE(PG8_SA(0, 0), a2, voffA);
            PG8_WAIT_V(8); PG8_WAIT_L(0); PG8_BAR; PG8_MMA(1, 0, At, B0); PG8_MMA(1, 1, At, B1); PG8_BAR; PG8_SCHED;
            PG8_LDB(B0, 1, 0); PG8_LDB(B1, 1, 1); PG8_SCHED; PG8_LDA(At, 1, 0); PG8_STAGE(PG8_SA(0, 1), a2 + hstepA, voffA);
            PG8_WAIT_V(8); PG8_WAIT_L(0); PG8_BAR; PG8_MMA(0, 0, At, B0); PG8_MMA(0, 1, At, B1); PG8_BAR; PG8_SCHED;
            PG8_LDA(At, 1, 1); PG8_STAGE(PG8_SB(1, 0), b3, voffB); PG8_STAGE(PG8_SB(1, 1), b3 + hstep, voffB); PG8_STAGE(PG8_SA(1, 0), a3, voffA);
            PG8_WAIT_V(8); PG8_WAIT_L(0); PG8_BAR; PG8_MMA(1, 0, At, B0); PG8_MMA(1, 1, At, B1); PG8_BAR; PG8_SCHED;
            } else {
            PG8_LDB(B0, 0, 0); PG8_SCHED; PG8_LDA(At, 0, 0); PG8_STAGE(PG8_SA(1, 1), a1 + hstepA, voffA);
            PG8_WAIT_L(8); PG8_BAR; PG8_WAIT_L(0); PG8_MMA(0, 0, At, B0); PG8_BAR; PG8_SCHED;
            PG8_LDB(B1, 0, 1); PG8_STAGE(PG8_SB(0, 0), b2, voffB);
            PG8_BAR; PG8_WAIT_L(0); PG8_MMA(0, 1, At, B1); PG8_BAR;
            PG8_LDA(At, 0, 1); PG8_STAGE(PG8_SA(0, 0), a2, voffA);
            PG8_BAR; PG8_WAIT_L(0); PG8_MMA(1, 0, At, B0); PG8_BAR; PG8_SCHED;
            PG8_STAGE(PG8_SB(0, 1), b2 + hstep, voffB);
            PG8_WAIT_V(6); PG8_BAR; PG8_MMA(1, 1, At, B1); PG8_BAR;
            PG8_LDB(B0, 1, 0); PG8_SCHED; PG8_LDA(At, 1, 0); PG8_STAGE(PG8_SA(0, 1), a2 + hstepA, voffA);
            PG8_WAIT_L(8); PG8_BAR; PG8_WAIT_L(0); PG8_MMA(0, 0, At, B0); PG8_BAR; PG8_SCHED;
            PG8_LDB(B1, 1, 1); PG8_STAGE(PG8_SB(1, 0), b3, voffB);
            PG8_BAR; PG8_WAIT_L(0); PG8_MMA(0, 1, At, B1); PG8_BAR;
            PG8_LDA(At, 1, 1); PG8_STAGE(PG8_SA(1, 0), a3, voffA);
            PG8_BAR; PG8_WAIT_L(0); PG8_MMA(1, 0, At, B0); PG8_BAR; PG8_SCHED;
            PG8_STAGE(PG8_SB(1, 1), b3 + hstep, voffB);
            PG8_WAIT_V(6); PG8_BAR; PG8_MMA(1, 1, At, B1); PG8_BAR;
            }
        }
        if constexpr (ALIGN_EPI) { if (wr == 0) PG8_BAR; }
        if constexpr (!Epi::AFTER_DRAIN) { if constexpr (epi_virt<Epi>::value) E(acc, cur, wr, wc, fr, fq); else { const Unit eu{cur.pm, PG8_PNR(cur)}; E(acc, eu, wr, wc, fr, fq); } S.done(cur); }
        if (!has_next) break;
#pragma unroll
        for (int a = 0; a < 2; ++a)
#pragma unroll
            for (int b = 0; b < 2; ++b)
#pragma unroll
                for (int m = 0; m < 4; ++m)
#pragma unroll
                    for (int n = 0; n < 2; ++n) acc[a][b][m][n] = zero4;
        cur = nxt; cA = nA; cB = nB; ++ui;
        if constexpr (ALIGN_EPI) { if (wr == 1) PG8_BAR; }
    }
    PG8_WAIT_V(0);
    if constexpr (!ALIGN_EPI) { if (wr == 0) PG8_BAR; }
    PG8_BAR;
    if constexpr (Epi::AFTER_DRAIN) { E.fused(acc, cur, wr, wc, fr, fq, lds, wid, lane); S.done(cur); }
#undef PG8_SLICE
#undef PG8_PNR
#undef PG8_KOFF
#undef PG8_ABASE
#undef PG8_BBASE
#undef PG8_SA
#undef PG8_SB
#undef PG8_STAGE
#undef PG8_LDA
#undef PG8_LDB
#undef PG8_MMA
#undef PG8_WAIT_V
#undef PG8_WAIT_L
#undef PG8_BAR
#undef PG8_SCHED
}
}
namespace pg8 {
struct GrpDesc { const bf16_t* A; const bf16_t* Bt; int M, N, K, ld, bdiag; };
struct GUnit { int pm, pn, grp; };
__device__ __forceinline__ bool static_map(long L, int nM, int nN, Unit& u) {
    const int nwg = nM * nN; if (L >= nwg) return false;
    int wgid = (int)L; { const int q = nwg / NXCD, r = nwg % NXCD, xcd = wgid % NXCD, off = wgid / NXCD; wgid = (xcd < r ? xcd * (q + 1) : r * (q + 1) + (xcd - r) * q) + off; }
    const int nig = WGM * nN, gid = wgid / nig, fm = gid * WGM, gsz = (nM - fm) < WGM ? (nM - fm) : WGM;
    u.pm = fm + ((wgid % nig) % gsz); u.pn = (wgid % nig) / gsz; return true;
}
template <class E0, class E1, class E2>
__device__ __forceinline__ void gemm_group3(PG8_LAS unsigned char* lds, const GrpDesc g0, const GrpDesc g1, const GrpDesc g2, const E0& e0, const E1& e1, const E2& e2, const int Gn, const int c, const int tid_in) {
    static_assert(E0::PERM && E1::PERM && E2::PERM, "gemm_group3: the three epilogues must share the permuted weight staging");
    const int tid = tid_in, wid = __builtin_amdgcn_readfirstlane(tid >> 6), lane = tid & 63, wr = wid >> 2, wc = wid & 3, fr = lane & 15, fq = lane >> 4;
    const int n0 = (g0.M / BM) * (g0.N / BM), n1 = (g1.M / BM) * (g1.N / BM), n2 = (g2.M / BM) * (g2.N / BM);
    int sR[2], sRb[2], sC[2];
#pragma unroll
    for (int i = 0; i < 2; ++i) { int R, C; stage_rc(tid * 16 + i * 8192, R, C); sR[i] = R; sRb[i] = (R & ~31) + perm32(R & 31); sC[i] = C; }
    const size_t kstep = (size_t)(BK * 2);
    const unsigned ldsw = (unsigned)wid * 1024u;
    const int aoff = lds_byte(wr * 64 + fr, fq * 8), boff = lds_byte(wc * 32 + fr, fq * 8);
#define PG8_SA(b, h) (((b) * 2 + (h)) * HTB)
#define PG8_SB(b, h) ((4 + (b) * 2 + (h)) * HTB)
#define PG8_STAGE(bufoff, gbase, voff) do { _Pragma("unroll") for (int _i = 0; _i < 2; ++_i) \
        __builtin_amdgcn_global_load_lds((const unsigned*)((const char*)(gbase) + (voff)[_i]), (PG8_LAS unsigned*)(lds + (bufoff) + ldsw + _i * 8192), 16, 0, 0); } while (0)
#define PG8_LDA(dst, b, h) do { _Pragma("unroll") for (int m = 0; m < 4; ++m) _Pragma("unroll") for (int k = 0; k < 2; ++k) dst[m][k] = *(const PG8_LAS bf16x8*)(lds + PG8_SA(b, h) + aoff + m * 2048 + k * 1024); } while (0)
#define PG8_LDB(dst, b, h) do { _Pragma("unroll") for (int n = 0; n < 2; ++n) _Pragma("unroll") for (int k = 0; k < 2; ++k) dst[n][k] = *(const PG8_LAS bf16x8*)(lds + PG8_SB(b, h) + boff + n * 2048 + k * 1024); } while (0)
#define PG8_MMA(ai, bj, At, Bt) do { __builtin_amdgcn_s_setprio(1); _Pragma("unroll") for (int m = 0; m < 4; ++m) _Pragma("unroll") for (int n = 0; n < 2; ++n) _Pragma("unroll") for (int k = 0; k < 2; ++k) \
        acc[ai][bj][m][n] = __builtin_amdgcn_mfma_f32_16x16x32_bf16(Bt[n][k], At[m][k], acc[ai][bj][m][n], 0, 0, 0); __builtin_amdgcn_s_setprio(0); } while (0)
#define PG8_WAIT_V(n) asm volatile("s_waitcnt vmcnt(" #n ")" ::: "memory")
#define PG8_WAIT_L(n) asm volatile("s_waitcnt lgkmcnt(" #n ")" ::: "memory")
#define PG8_BAR __builtin_amdgcn_s_barrier()
#define PG8_SCHED __builtin_amdgcn_sched_barrier(0)
#define PG8_GETUNIT(L, u, ok) do { Unit t_; const long L_ = (L); ok = true; \
        if (L_ < n0) { static_map(L_, g0.M / BM, g0.N / BM, t_); u.grp = 0; } else if (L_ < n0 + n1) { static_map(L_ - n0, g1.M / BM, g1.N / BM, t_); u.grp = 1; } \
        else if (L_ < n0 + n1 + n2) { static_map(L_ - n0 - n1, g2.M / BM, g2.N / BM, t_); u.grp = 2; } else { ok = false; t_.pm = 0; t_.pn = 0; u.grp = 0; } u.pm = t_.pm; u.pn = t_.pn; } while (0)
#define PG8_GSEL(u, f) ((u).grp == 0 ? g0.f : ((u).grp == 1 ? g1.f : g2.f))
#define PG8_SETUNIT(u, pA, pB, ntv, ldv) do { const int ld_ = PG8_GSEL(u, ld), K_ = PG8_GSEL(u, K), bd_ = PG8_GSEL(u, bdiag); const int sl_ = bd_ ? ((u).pn & (bd_ - 1)) : 0; \
        pA = (const char*)PG8_GSEL(u, A) + (size_t)(u).pm * (size_t)(2 * HALF) * ld_ * 2 + (size_t)sl_ * K_ * 2; pB = (const char*)PG8_GSEL(u, Bt) + (size_t)(u).pn * (size_t)(2 * HALF) * ld_ * 2 + (size_t)sl_ * K_ * 2; ntv = K_ / BK; ldv = ld_; } while (0)
#define PG8_SETVOFF(vA, vB, ldv) do { _Pragma("unroll") for (int i = 0; i < 2; ++i) { vA[i] = (unsigned)(sR[i] * (ldv) + sC[i]) * 2u; vB[i] = (unsigned)(sRb[i] * (ldv) + sC[i]) * 2u; } } while (0)
    GUnit cur, nxt; int ui = 0; bool ok;
    PG8_GETUNIT((long)c, cur, ok);
    if (!ok) return;
    f32x4 acc[2][2][4][2];
    float zf = 0.f; asm volatile("" : "+v"(zf));
    const f32x4 zero4 = (f32x4){zf, zf, zf, zf};
#pragma unroll
    for (int a = 0; a < 2; ++a)
#pragma unroll
        for (int b = 0; b < 2; ++b)
#pragma unroll
            for (int m = 0; m < 4; ++m)
#pragma unroll
                for (int n = 0; n < 2; ++n) acc[a][b][m][n] = zero4;
    bf16x8 At[4][2], B0[2][2], B1[2][2];
    const char* cA; const char* cB; int nt, ldc_; PG8_SETUNIT(cur, cA, cB, nt, ldc_);
    unsigned voffA[2], voffB[2]; PG8_SETVOFF(voffA, voffB, ldc_);
    size_t hstep = (size_t)HALF * ldc_ * 2;
    PG8_STAGE(PG8_SB(0, 0), cB, voffB); PG8_STAGE(PG8_SB(0, 1), cB + hstep, voffB); PG8_STAGE(PG8_SA(0, 0), cA, voffA); PG8_STAGE(PG8_SA(0, 1), cA + hstep, voffA);
    if (wr == 1) PG8_BAR;
    PG8_WAIT_V(2); PG8_BAR;
    PG8_STAGE(PG8_SB(1, 0), cB + kstep, voffB); PG8_STAGE(PG8_SA(1, 0), cA + kstep, voffA); PG8_STAGE(PG8_SB(1, 1), cB + hstep + kstep, voffB);
    PG8_WAIT_V(6); PG8_BAR;
    for (;;) {
        bool has_next; PG8_GETUNIT((long)(ui + 1) * Gn + c, nxt, has_next);
        const char* nA = cA; const char* nB = cB; int ntn = nt, ldn = ldc_;
        if (has_next) PG8_SETUNIT(nxt, nA, nB, ntn, ldn);
        unsigned voffAn[2], voffBn[2]; PG8_SETVOFF(voffAn, voffBn, ldn);
        const size_t hstepn = (size_t)HALF * ldn * 2;
        for (int t = 0; t < nt; t += 2) {
            const bool last = (t == nt - 2);
            const char* a1 = cA + (size_t)(t + 1) * kstep;
            const char* a2 = last ? nA : cA + (size_t)(t + 2) * kstep; const char* b2 = last ? nB : cB + (size_t)(t + 2) * kstep;
            const char* a3 = a2 + kstep; const char* b3 = b2 + kstep;
            unsigned vA2[2], vB2[2];
#pragma unroll
            for (int i = 0; i < 2; ++i) { vA2[i] = last ? voffAn[i] : voffA[i]; vB2[i] = last ? voffBn[i] : voffB[i]; }
            const size_t h2 = last ? hstepn : hstep;
            PG8_LDB(B0, 0, 0); PG8_LDB(B1, 0, 1); PG8_SCHED; PG8_LDA(At, 0, 0); PG8_STAGE(PG8_SA(1, 1), a1 + hstep, voffA);
            PG8_WAIT_V(8); PG8_WAIT_L(0); PG8_BAR; PG8_MMA(0, 0, At, B0); PG8_MMA(0, 1, At, B1); PG8_BAR; PG8_SCHED;
            PG8_LDA(At, 0, 1); PG8_STAGE(PG8_SB(0, 0), b2, vB2); PG8_STAGE(PG8_SB(0, 1), b2 + h2, vB2); PG8_STAGE(PG8_SA(0, 0), a2, vA2);
            PG8_WAIT_V(8); PG8_WAIT_L(0); PG8_BAR; PG8_MMA(1, 0, At, B0); PG8_MMA(1, 1, At, B1); PG8_BAR; PG8_SCHED;
            PG8_LDB(B0, 1, 0); PG8_LDB(B1, 1, 1); PG8_SCHED; PG8_LDA(At, 1, 0); PG8_STAGE(PG8_SA(0, 1), a2 + h2, vA2);
            PG8_WAIT_V(8); PG8_WAIT_L(0); PG8_BAR; PG8_MMA(0, 0, At, B0); PG8_MMA(0, 1, At, B1); PG8_BAR; PG8_SCHED;
            PG8_LDA(At, 1, 1); PG8_STAGE(PG8_SB(1, 0), b3, vB2); PG8_STAGE(PG8_SB(1, 1), b3 + h2, vB2); PG8_STAGE(PG8_SA(1, 0), a3, vA2);
            PG8_WAIT_V(8); PG8_WAIT_L(0); PG8_BAR; PG8_MMA(1, 0, At, B0); PG8_MMA(1, 1, At, B1); PG8_BAR; PG8_SCHED;
        }
        if (wr == 0) PG8_BAR;
        { const Unit eu{cur.pm, cur.pn};
          if (cur.grp == 0) e0(acc, eu, wr, wc, fr, fq); else if (cur.grp == 1) e1(acc, eu, wr, wc, fr, fq); else e2(acc, eu, wr, wc, fr, fq); }
        if (!has_next) break;
#pragma unroll
        for (int a = 0; a < 2; ++a)
#pragma unroll
            for (int b = 0; b < 2; ++b)
#pragma unroll
                for (int m = 0; m < 4; ++m)
#pragma unroll
                    for (int n = 0; n < 2; ++n) acc[a][b][m][n] = zero4;
        cur = nxt; cA = nA; cB = nB; nt = ntn; ldc_ = ldn; hstep = hstepn;
#pragma unroll
        for (int i = 0; i < 2; ++i) { voffA[i] = voffAn[i]; voffB[i] = voffBn[i]; }
        ++ui;
        if (wr == 1) PG8_BAR;
    }
    PG8_WAIT_V(0);
    PG8_BAR;
#undef PG8_GETUNIT
#undef PG8_GSEL
#undef PG8_SETUNIT
#undef PG8_SETVOFF
#undef PG8_SA
#undef PG8_SB
#undef PG8_STAGE
#undef PG8_LDA
#undef PG8_LDB
#undef PG8_MMA
#undef PG8_WAIT_V
#undef PG8_WAIT_L
#undef PG8_BAR
#undef PG8_SCHED
}
}
#define XB_TMO      128
#define XB_XCNT(j)  (256  + 64 * (j))
#define XB_XSUB(j)  (1280 + 64 * (j))
#define XB_XGEN(j)  (2304 + 64 * (j))
#define XB_TOP      3328
#define XB_TOPGEN   3392
#define XCD_BAR_WORDS 3456
#define XB_SPIN_CAP (1u << 18)

__device__ __forceinline__ unsigned xb_ld(unsigned* p)              { return __hip_atomic_load(p, __ATOMIC_RELAXED, __HIP_MEMORY_SCOPE_AGENT); }
__device__ __forceinline__ unsigned xb_add(unsigned* p, unsigned v) { return __hip_atomic_fetch_add(p, v, __ATOMIC_RELAXED, __HIP_MEMORY_SCOPE_AGENT); }
__device__ __forceinline__ unsigned xb_xcc_id() { return (unsigned)__builtin_amdgcn_s_getreg((3 << 11) | 20) & 0xFu; }
#define XB_SPIN(cond, bar) do { unsigned _sp = 0; while (cond) { __builtin_amdgcn_s_sleep(1); \
    if ((++_sp & 255u) == 0u) { if (xb_ld(&(bar)[XB_TMO])) break; if (_sp > XB_SPIN_CAP) { atomicAdd(&(bar)[XB_TMO], 1u); break; } } } } while (0)

struct XcdBarrier {
    unsigned* bar; unsigned x;
    volatile LAS unsigned* st;
};

__device__ __forceinline__ XcdBarrier xcd_barrier_post(unsigned* bar, volatile LAS unsigned* st) {
    XcdBarrier b; b.bar = bar; b.x = xb_xcc_id(); b.st = st;
    if (threadIdx.x == 0) (void)xb_add(&bar[XB_XCNT(b.x)], 1u);
    return b;
}
__device__ __forceinline__ void xcd_barrier_complete(unsigned* bar, unsigned x, unsigned& nloc, unsigned& nx) {
    const unsigned G = gridDim.x * gridDim.y * gridDim.z;
    unsigned sum, cnt, mine, sp = 0u;
    for (;;) {
        sum = 0u; cnt = 0u; mine = 0u;
#pragma unroll
        for (unsigned j = 0; j < 16; ++j) { const unsigned c = xb_ld(&bar[XB_XCNT(j)]); sum += c; cnt += (c > 0u) ? 1u : 0u; mine = (j == x) ? c : mine; }
        if (sum == G) break;
        __builtin_amdgcn_s_sleep(1);
        if ((++sp & 255u) == 0u) { if (xb_ld(&bar[XB_TMO])) break; if (sp > XB_SPIN_CAP) { atomicAdd(&bar[XB_TMO], 1u); break; } }
    }
    nloc = mine > 0u ? mine : 1u; nx = cnt > 0u ? cnt : 1u;
}

__device__ __forceinline__ void xcd_barrier(const XcdBarrier& b) {
    asm volatile("s_waitcnt vmcnt(0)" ::: "memory");
    __syncthreads();
    if (threadIdx.x == 0) {
        unsigned* bar = b.bar;
        __builtin_amdgcn_s_waitcnt(0);
        unsigned nloc = b.st[0], nx = b.st[1];
        if (nloc == 0u) { xcd_barrier_complete(bar, b.x, nloc, nx); b.st[0] = nloc; b.st[1] = nx; }
        const unsigned old = xb_add(&bar[XB_XSUB(b.x)], 1u);
        const unsigned gen = old / nloc;
        if (old + 1u == (gen + 1u) * nloc) {
            __builtin_amdgcn_fence(__ATOMIC_RELEASE, "agent");
            asm volatile("s_waitcnt vmcnt(0)" ::: "memory");
            const unsigned og = xb_add(&bar[XB_TOP], 1u);
            const unsigned tg = og / nx;
            if (og + 1u == (tg + 1u) * nx) xb_add(&bar[XB_TOPGEN], 1u);
            else XB_SPIN(xb_ld(&bar[XB_TOPGEN]) == tg, bar);
            __builtin_amdgcn_fence(__ATOMIC_ACQUIRE, "agent");
            xb_add(&bar[XB_XGEN(b.x)], 1u);
            asm volatile("s_waitcnt vmcnt(0)" ::: "memory");
        } else {
            XB_SPIN(xb_ld(&bar[XB_XGEN(b.x)]) == gen, bar);
            __builtin_amdgcn_fence(__ATOMIC_ACQUIRE, "agent");
            asm volatile("s_waitcnt vmcnt(0)" ::: "memory");
        }
    }
    __syncthreads();
}
struct Args { const float* in[N_IN]; float* out; unsigned char* ws; int lo, hi; };
static_assert(sizeof(Args) == (N_IN + 2) * 8 + 8, "Args has no holes");
struct Frame {
    LAS unsigned char* lds;
    volatile LAS unsigned* MISC;
    gu32* ctl;
    int tid, lane, wave, G, bid;
    unsigned char* ws;
    const __attribute__((address_space(4))) char* kp;
    float* out;
};
#define WSP(T, off) ((T*)(F.ws + (off)))
typedef const GAS float* gcfptr_t;
#define KIN(i) ((const float*)(*(const __attribute__((address_space(4))) gcfptr_t*)(F.kp + 8 * (i))))

template <class LhsFn> __device__ __forceinline__ void skinny17_task(Frame& F, LhsFn lhs, const float* W, int N, int n0, float* out, int ldo, const float* bias) {
    LAS float* sh = (LAS float*)(F.lds + RING_OFF);
    const int lane = F.lane, bi = lane & 31, hk = lane >> 5, col = n0 + 32 * F.wave + bi, cc = min(col, N - 1);
    f32x16 acc;
#pragma unroll
    for (int e = 0; e < 16; ++e) acc[e] = 0.f;
    for (int kh = 0; kh < 2; ++kh) {
        __syncthreads();
        for (int idx = F.tid; idx < 17 * 1024; idx += NTHR) { const int b = idx >> 10, kk = idx & 1023; sh[b * 1025 + kk] = lhs(b, kh * 1024 + kk); }
        __syncthreads();
        const float* wp = W + (size_t)(kh * 1024 + hk) * N + cc; const LAS float* ap = sh + (bi < 17 ? bi : 0) * 1025 + hk;
#pragma unroll 8
        for (int ks = 0; ks < 512; ++ks) { const float bv = wp[(size_t)(2 * ks) * N]; float av = ap[2 * ks]; av = bi < 17 ? av : 0.f;
            acc = __builtin_amdgcn_mfma_f32_32x32x2f32(av, bv, acc, 0, 0, 0); }
    }
    if (col < N) { const float bz = bias ? bias[col] : 0.f;
#pragma unroll
        for (int r = 0; r < 16; ++r) { const int b = (r & 3) + 8 * (r >> 2) + 4 * hk; if (b < 17) out[(size_t)b * ldo + col] = acc[r] + bz; } }
}
__device__ __forceinline__ void p0a_prologue(Frame& F, const float* c, const float* cctx, const float* adaw, const float* adab,
                                             const float* lre, const float* lim, const float* ldt, const float* bre, const float* bim, const float* cre, const float* cim) {
    for (int t = F.bid; t < DEPTH * 48; t += F.G) { const int l = t / 48, n0 = (t % 48) * 256;
        skinny17_task(F, [&](int b, int k) { const float v = b < NB ? c[b * DM + k] : cctx[k]; return v / (1.f + __expf(-v)); },
                      adaw + (size_t)l * DM * NMOD, NMOD, n0, WSP(float, WS_MODS) + (size_t)l * 17 * NMOD, NMOD, adab + (size_t)l * NMOD); }
    __syncthreads();
    { float* RT_ = WSP(float, WS_ROPE);
      for (int i = F.bid * NTHR + F.tid; i < 1024; i += F.G * NTHR) { const int pos = i >> 4, fi = i & 15; const float inv = exp2f(-(float)fi * (13.287712379549449f / 16.f));
          float sn, cs; sincosf((float)pos * inv, &sn, &cs); RT_[2 * i] = cs; RT_[2 * i + 1] = sn; } }
    {
        float* S5A = WSP(float, WS_S5A); bf16* BB = WSP(bf16, WS_S5BB); bf16* CM = WSP(bf16, WS_S5CM);
        for (int i = F.bid * NTHR + F.tid; i < DEPTH * 2 * 32 * 64; i += F.G * NTHR) {
            const int p = i & 63, ldg = i >> 6;
            const float lr = fminf(lre[i], -1e-4f), li = lim[i], dt = __expf(ldt[ldg]);
            const float mag = expf(lr * dt), ar = mag * cosf(li * dt), ai = mag * sinf(li * dt);
            const float den = lr * lr + li * li, fr = ((ar - 1.f) * lr + ai * li) / den, fi = (ai * lr - (ar - 1.f) * li) / den;
            S5A[(size_t)i * 2] = ar; S5A[(size_t)i * 2 + 1] = ai;
            const int kre = (p & 31) + 64 * (p >> 5), kim = kre + 32;
            const int hre = 2 * (p & 31) + 64 * (p >> 5), him = hre + 1;
#pragma unroll
            for (int cc = 0; cc < 16; ++cc) { const float br = bre[(size_t)i * 16 + cc], bi = bim[(size_t)i * 16 + cc];
                BB[((size_t)ldg * 128 + kre) * 16 + cc] = (bf16)f2bf(fr * br - fi * bi); BB[((size_t)ldg * 128 + kim) * 16 + cc] = (bf16)f2bf(fr * bi + fi * br);
                CM[((size_t)ldg * 16 + cc) * 128 + hre] = (bf16)f2bf(cre[((size_t)ldg * 16 + cc) * 64 + p]); CM[((size_t)ldg * 16 + cc) * 128 + him] = (bf16)f2bf(-cim[((size_t)ldg * 16 + cc) * 64 + p]); }
        }
    }
}
__device__ __forceinline__ void p0c_shw(Frame& F, const float* win_all, const float* w1_all) {
    const float* MODS = WSP(float, WS_MODS); float* SHW = WSP(float, WS_SHW);
    for (int t = F.bid; t < DEPTH * 49; t += F.G) { const int l = t / 49, g = t % 49; const bool is1 = g >= 17; const int ish = is1 ? 3 : 0;
        const float* mp = MODS + (size_t)l * 17 * NMOD + ish * DM;
        skinny17_task(F, [&](int b, int k) { return mp[(size_t)b * NMOD + k]; },
                      is1 ? w1_all + (size_t)l * DM * DFF : win_all + (size_t)l * DM * NZ, is1 ? DFF : NZ, (is1 ? g - 17 : g) * 256,
                      SHW + (size_t)l * 17 * (LDZ + DFF) + (is1 ? LDZ : 0), LDZ + DFF, nullptr); }
    __syncthreads();
}
__device__ __forceinline__ void norm0_phase(Frame& F, const float* x, const float* ctx, const float* w, const float* mods  ) {
    bf16* H = WSP(bf16, WS_H); float* RSTD = WSP(float, WS_RSTD);
    const int gw = F.bid * NWAVES + F.wave, NGW = F.G * NWAVES, lane = F.lane;
    for (int r = gw; r < RT; r += NGW) {
        const float* xrow = r < RL ? x + (size_t)r * DM : ctx + (size_t)(r - RL) * DM; const float* sc = mods + (size_t)mod_row(r) * NMOD + 1 * DM;
        const f32x4* xr = (const f32x4*)xrow + lane; f32x4 v[8]; float s = 0.f;
#pragma unroll
        for (int j = 0; j < 8; ++j) { v[j] = xr[64 * j]; s += (v[j].x * v[j].x + v[j].y * v[j].y) + (v[j].z * v[j].z + v[j].w * v[j].w); }
        s = wave_sum(s, lane);
        if (lane == 0) RSTD[r] = rsqrtf(s * (1.f / DM) + EPS);
        v2u* o8 = (v2u*)(H + blk_off(r, 0, 8)) + lane; constexpr int JS = BLK_LAYOUT ? 16384 : 64;
#pragma unroll
        for (int j = 0; j < 8; ++j) { const int cix = 64 * j + lane; const f32x4 y = v[j] * ((const f32x4*)w)[cix] * (((const f32x4*)sc)[cix] + 1.f); v2u o; o.x = pk2(y.x, y.y); o.y = pk2(y.z, y.w); o8[JS * j] = o; }
    }
}
__device__ __forceinline__ void ctxfix_phase(Frame& F, const float* gate  , const float* w, const float* sc  ) {
    bf16* X = WSP(bf16, WS_X); const float* P = WSP(float, WS_LOGA); bf16* H = WSP(bf16, WS_H); float* RSTD = WSP(float, WS_RSTD);
    const int gw = F.bid * NWAVES + F.wave, NGW = F.G * NWAVES, lane = F.lane;
    for (int rc = gw; rc < RC; rc += NGW) { const int r = RL + rc;
        v2u* xr = (v2u*)(X + blk_off(r, 0, 8)) + lane; constexpr int JS = BLK_LAYOUT ? 16384 : 64; const f32x4* p0 = (const f32x4*)(P + (size_t)rc * DM) + lane; const f32x4* p1 = (const f32x4*)(P + (size_t)(RC + rc) * DM) + lane;
        f32x4 v[8]; float s = 0.f;
#pragma unroll
        for (int j = 0; j < 8; ++j) { const int cix = 64 * j + lane; const v2u xw = xr[JS * j]; const f32x4 xi = (f32x4){bflo(xw.x), bfhi(xw.x), bflo(xw.y), bfhi(xw.y)};
            v[j] = xi + ((const f32x4*)gate)[cix] * (p0[64 * j] + p1[64 * j]); s += (v[j].x * v[j].x + v[j].y * v[j].y) + (v[j].z * v[j].z + v[j].w * v[j].w); }
        s = wave_sum(s, lane);
        if (lane == 0) RSTD[r] = rsqrtf(s * (1.f / DM) + EPS);
        v2u* o8 = (v2u*)(H + blk_off(r, 0, 8)) + lane;
#pragma unroll
        for (int j = 0; j < 8; ++j) { const int cix = 64 * j + lane; v2u xo; xo.x = pk2(v[j].x, v[j].y); xo.y = pk2(v[j].z, v[j].w); xr[JS * j] = xo;
            const f32x4 y = v[j] * ((const f32x4*)w)[cix] * (((const f32x4*)sc)[cix] + 1.f); v2u o; o.x = pk2(y.x, y.y); o.y = pk2(y.z, y.w); o8[JS * j] = o; }
    }
}
__device__ __forceinline__ void rstd_phase(Frame& F, int nrows) {
    const float* SSP = WSP(float, WS_SSP); float* RSTD = WSP(float, WS_RSTD);
    for (int r = F.bid * NTHR + F.tid; r < nrows; r += F.G * NTHR) { const f32x4* sp = (const f32x4*)(SSP + (size_t)r * 32); float s = 0.f;
#pragma unroll
        for (int j = 0; j < 8; ++j) { const f32x4 v = sp[j]; s += (v.x + v.y) + (v.z + v.w); }
        RSTD[r] = rsqrtf(s * (1.f / DM) + EPS); }
}
__device__ __forceinline__ void transpose_item(const float* W, int K, int N, bf16* WT, int ldt, LAS float* scr, int item, int lane) {
    const int nblk = (N + 31) / 32, kb = item / nblk, nb = item % nblk, k0 = 64 * kb, n0 = 32 * nb;
    const int nr = min(n0 + (lane & 31), N - 1);
#pragma unroll 8
    for (int i = 0; i < 32; ++i) { const int kk = 2 * i + (lane >> 5); scr[kk * 33 + (lane & 31)] = W[(size_t)(k0 + kk) * N + nr]; }
    LDS_WAIT(); asm volatile("" ::: "memory");
    const int cch = lane & 7;
#pragma unroll
    for (int j = 0; j < 4; ++j) { const int n = (lane >> 3) + 8 * j; const LAS float* s = scr + (8 * cch) * 33 + n;
        v4u o; o.x = pk2(s[0 * 33], s[1 * 33]); o.y = pk2(s[2 * 33], s[3 * 33]); o.z = pk2(s[4 * 33], s[5 * 33]); o.w = pk2(s[6 * 33], s[7 * 33]);
        if (n0 + n < N) *(v4u*)(WT + (size_t)(n0 + n) * ldt + k0 + 8 * cch) = o; }
    LDS_WAIT(); asm volatile("" ::: "memory");
}
__device__ __forceinline__ void norm_row(const float* xrow, bf16* orow, const float* w, const float* shift, const float* scale, int lane) {
    const f32x4* xr = (const f32x4*)xrow + lane;
    f32x4 v[8]; float s = 0.f;
#pragma unroll
    for (int j = 0; j < 8; ++j) { v[j] = xr[64 * j]; s += (v[j].x * v[j].x + v[j].y * v[j].y) + (v[j].z * v[j].z + v[j].w * v[j].w); }
    const float rstd = rsqrtf(wave_sum(s, lane) * (1.f / DM) + EPS);
    v2u* o8 = (v2u*)orow + lane;
#pragma unroll
    for (int j = 0; j < 8; ++j) { const int cix = 64 * j + lane; const f32x4 wv = ((const f32x4*)w)[cix], sh = ((const f32x4*)shift)[cix], sc = ((const f32x4*)scale)[cix];
        const f32x4 y = v[j] * rstd * wv * (sc + 1.f) + sh; v2u o; o.x = pk2(y.x, y.y); o.y = pk2(y.z, y.w); o8[64 * j] = o; }
}
__device__ __forceinline__ void norm_phase(Frame& F, const float* X, bf16* H, const float* w, const float* mods  , int ishift, int iscale, int nrows) {
    const int gw = F.bid * NWAVES + F.wave, NGW = F.G * NWAVES;
    for (int r = gw; r < nrows; r += NGW) { const float* mp = mods + (size_t)mod_row(r) * NMOD;
        norm_row(X + (size_t)r * DM, H + (size_t)r * DM, w, mp + ishift * DM, mp + iscale * DM, F.lane); }
}
constexpr int CV_1 = 32 * 256, CV_2 = 128 * 64, CV_OUT = 32 * 64, CV_G = 8 * 16, CV_OWN = CV_1 + CV_2 + CV_OUT + CV_G, CV_IN = 32 * 131, CV_Q = 6 * 24, CV_KV = 2 * 32, CV_NEXT = CV_IN + CV_Q + CV_KV;
__device__ __forceinline__ void convert_item(Frame& F, const Args& A, int lo, int ln, int it, LAS float* scr) {
    int r = it;
    if (r < CV_OWN) { if (lo < 0) return;
        if (r < CV_1) { transpose_item(KIN(I_W1) + (size_t)lo * DM * DFF, DM, DFF, WSP(bf16, WS_W1), DM, scr, r, F.lane); return; } r -= CV_1;
        if (r < CV_2) { transpose_item(KIN(I_W2) + (size_t)lo * DFF * DM, DFF, DM, WSP(bf16, WS_W2), DFF, scr, r, F.lane); return; } r -= CV_2;
        if (r < CV_OUT) { transpose_item(KIN(I_WOUT) + (size_t)lo * DM * DM, DM, DM, WSP(bf16, WS_WOUT), DM, scr, r, F.lane); return; } r -= CV_OUT;
        transpose_item(KIN(I_S5GLUW) + (size_t)lo * 512 * 512, 512, 512, WSP(bf16, WS_WGLU), 512, scr, r, F.lane); return; }
    r -= CV_OWN; if (ln >= DEPTH) return;
    if (r < CV_IN) { transpose_item(KIN(I_WIN) + (size_t)ln * DM * NZ, DM, NZ, WSP(bf16, WS_WIN), DM, scr, r, F.lane); return; } r -= CV_IN;
    if (r < CV_Q) { transpose_item(KIN(I_WQUP) + (size_t)ln * 384 * 768, 384, 768, WSP(bf16, WS_WQUP), 384, scr, r, F.lane); return; } r -= CV_Q;
    transpose_item(KIN(I_WKVUP) + (size_t)ln * 128 * 1024, 128, 1024, WSP(bf16, WS_WKVUP), 256, scr, r, F.lane);
}
__device__ __forceinline__ void convert_misc(Frame& F, const Args& A, int ln, int t0, int nt) {
    if (ln >= DEPTH) return;
    { v4u* p = WSP(v4u, WS_WKVUP); const v4u z4 = zero_v4u(); for (int i = t0; i < 1024 * 16; i += nt) { const int n = i >> 4, c8 = i & 15; p[(size_t)n * 32 + 16 + c8] = z4; } }
    { float* cst = WSP(float, WS_LRUC); const float* ba = KIN(I_LBA) + (size_t)ln * 1024; const float* bx = KIN(I_LBX) + (size_t)ln * 1024; const float* lam = KIN(I_LLAM) + (size_t)ln * 1024;
      for (int i = t0; i < 1024; i += nt) { cst[i] = ba[i]; cst[1024 + i] = bx[i]; cst[2048 + i] = softplusf_(-lam[i]); } }
    { const float* wa = KIN(I_LWA) + (size_t)ln * 2 * 4 * 128 * 128; const float* wx = KIN(I_LWX) + (size_t)ln * 2 * 4 * 128 * 128; v4u* p = WSP(v4u, WS_WLRU);
      for (int i = t0; i < 2048 * 64; i += nt) { const int cidx = i >> 6, k8 = (i & 63) * 8; const int pn = cidx >> 8, type = (cidx >> 7) & 1, j = cidx & 127, d = pn >> 2, nb = pn & 3;
          v4u o = zero_v4u();
          if ((k8 >> 7) == nb) { const float* src = (type ? wx : wa) + ((size_t)(d * 4 + nb) * 128 + (k8 & 127)) * 128 + j;
              o.x = pk2(src[0 * 128], src[1 * 128]); o.y = pk2(src[2 * 128], src[3 * 128]); o.z = pk2(src[4 * 128], src[5 * 128]); o.w = pk2(src[6 * 128], src[7 * 128]); }
          p[i] = o; } }
}
__device__ __forceinline__ void convert_weights(Frame& F, const Args& A, int lo, int ln) {
    LAS float* scr = (LAS float*)(F.lds + RING_OFF + F.wave * 16384);
    for (int it = F.bid * NWAVES + F.wave; it < CV_OWN + CV_NEXT; it += F.G * NWAVES) convert_item(F, A, lo, ln, it, scr);
    convert_misc(F, A, ln, F.bid * NTHR + F.tid, F.G * NTHR);
}
constexpr int CV_UNITS = (CV_OWN + CV_NEXT + 63) / 64 + 1;
__device__ __forceinline__ void convert_unit(Frame& F, const Args& A, int lo, int ln, int cu) {
    if (cu == CV_UNITS - 1) { convert_misc(F, A, ln, F.tid, NTHR); return; }
    LAS float* scr = (LAS float*)(F.lds + RING_OFF + F.wave * 16384);
    for (int j = 0; j < 8; ++j) { const int it = cu * 64 + j * 8 + F.wave; if (it < CV_OWN + CV_NEXT) convert_item(F, A, lo, ln, it, scr); }
}
__device__ __forceinline__ void prep_phase(Frame& F, const Args& A, int l) {
    const bf16* Z = WSP(bf16, WS_Z); bf16* XS = WSP(bf16, WS_XS); bf16* AQ = WSP(bf16, WS_AQ); bf16* AKV = WSP(bf16, WS_AKV);
    const float* cw = KIN(I_LCW) + (size_t)l * 4 * 512; const float* cb = KIN(I_LCB) + (size_t)l * 512;
    const float* qan = KIN(I_QAN) + (size_t)l * 384; const float* kvan = KIN(I_KVAN) + (size_t)l * 128;
    for (size_t i = (size_t)F.bid * NTHR + F.tid; i < (size_t)RT * 64; i += (size_t)F.G * NTHR) {
        const int r = (int)(i >> 6), c8 = (int)(i & 63) * 8;
        int t, len; if (r < RL) { t = r & (SEQ - 1); len = SEQ; } else { t = (r - RL) & (CTXL - 1); len = CTXL; }
        float acc[8];
#pragma unroll
        for (int j = 0; j < 8; ++j) acc[j] = cb[c8 + j];
#pragma unroll
        for (int tap = 0; tap < 4; ++tap) { const int tt = t + tap - 2;
            if (tt >= 0 && tt < len) { const v4u w = *(const v4u*)(Z + (size_t)(r + tap - 2) * LDZ + ZLX + c8); float f[8]; unpack8(w, f);
#pragma unroll
                for (int j = 0; j < 8; ++j) acc[j] += f[j] * cw[tap * 512 + c8 + j]; } }
        *(v4u*)(XS + (size_t)r * 512 + c8) = pack8(acc);
    }
    const int gw = F.bid * NWAVES + F.wave, NGW = F.G * NWAVES;
    for (int r = gw; r < RT; r += NGW) {
        const bool isq = F.lane < 48; const int e0 = isq ? F.lane * 8 : (F.lane - 48) * 8;
        const v4u w = *(const v4u*)(Z + (size_t)r * LDZ + (isq ? ZCQ : ZCKV) + e0); float f[8]; unpack8(w, f);
        float ss = 0.f;
#pragma unroll
        for (int j = 0; j < 8; ++j) ss += f[j] * f[j];
        const float sq = wave_sum(isq ? ss : 0.f, F.lane), skv = wave_sum(isq ? 0.f : ss, F.lane);
        const float rstd = isq ? rsqrtf(sq * (1.f / 384.f) + EPS) : rsqrtf(skv * (1.f / 128.f) + EPS);
        const float* nw = isq ? qan + e0 : kvan + e0;
#pragma unroll
        for (int j = 0; j < 8; ++j) f[j] = f[j] * rstd * nw[j];
        if (isq) *(v4u*)(AQ + (size_t)r * 384 + e0) = pack8(f);
        else { *(v4u*)(AKV + (size_t)r * 256 + e0) = pack8(f); *(v4u*)(AKV + (size_t)r * 256 + 128 + e0) = zero_v4u(); }
    }
}
constexpr float ATTN_SCALE_LOG2E = 0.07216878364870322f * 1.4426950408889634f;
__device__ __forceinline__ void rope8(float (&f)[8], int li, int t, int lane, const float* rope) {
    const bool second = (li & 2) != 0;
    const int pos = (li < 20) ? (t >> 6) : (t & 63);
    const f32x4* tp = (const f32x4*)(rope + (size_t)(pos * 16 + 8 * (li & 1)) * 2);
    const f32x4 t0 = tp[0], t1 = tp[1], t2 = tp[2], t3 = tp[3];
    const float cs[8] = {t0.x, t0.z, t1.x, t1.z, t2.x, t2.z, t3.x, t3.z}, sn[8] = {t0.y, t0.w, t1.y, t1.w, t2.y, t2.w, t3.y, t3.w};
    float o[8];
#pragma unroll
    for (int j = 0; j < 8; ++j) { const float other = shx(f[j], 2, lane); o[j] = second ? (f[j] * cs[j] + other * sn[j]) : (f[j] * cs[j] - other * sn[j]); }
#pragma unroll
    for (int j = 0; j < 8; ++j) f[j] = o[j];
}
__device__ __forceinline__ void mla_finish(Frame& F, const Args& A, int l, bool need_ctx, int wg0, int nwg) {
    const bf16* Z = WSP(bf16, WS_Z); const bf16* KVRAW = WSP(bf16, WS_KVRAW); bf16* K = WSP(bf16, WS_K);
    const float* kn = KIN(I_KN) + (size_t)l * 192; const float* rope = WSP(float, WS_ROPE);
    const int gw = (F.bid - wg0) * NWAVES + F.wave, NGW = nwg * NWAVES;
    const int li = F.lane & 31, hh = F.lane >> 5; const bool act = li < 24;
    float knw[8];
#pragma unroll
    for (int j = 0; j < 8; ++j) knw[j] = act ? kn[8 * li + j] : 0.f;
    for (int r = gw; r < RT; r += NGW) {
        const bool lat = r < RL; const int t = r & (SEQ - 1);
        v4u wk[2];
#pragma unroll
        for (int it = 0; it < 2; ++it) { const int h = it * 2 + hh;
            wk[it] = li < 16 ? *(const v4u*)(KVRAW + (size_t)r * 1024 + h * 256 + 8 * li) : (li < 24 ? *(const v4u*)(Z + (size_t)r * LDZ + ZKR + 8 * (li - 16)) : zero_v4u()); }
        int b, key; if (lat) { b = r >> 11; key = CTXL + t; } else { b = (r - RL) >> 8; key = (r - RL) & (CTXL - 1); }
#pragma unroll
        for (int it = 0; it < 2; ++it) { const int h = it * 2 + hh;
            float g[8]; unpack8(wk[it], g);
            float sk = 0.f;
#pragma unroll
            for (int j = 0; j < 8; ++j) sk += g[j] * g[j];
#pragma unroll
            for (int o = 1; o < 32; o <<= 1) sk += shx(sk, o, F.lane);
            const float rk = rsqrtf(sk * (1.f / 192.f) + EPS);
#pragma unroll
            for (int j = 0; j < 8; ++j) g[j] = g[j] * rk * knw[j];
            if (lat) { if (li >= 16 && li < 24) rope8(g, li, t, F.lane, rope); }
            if (act) *(v4u*)(K + ((size_t)b * TOK + key) * 768 + h * 192 + 8 * li) = pack8(g);
        }
    }
}
template <bool FINAL> __device__ __forceinline__ void lru_chunk(Frame& F, int wunit) {
    const bf16* LOGA = WSP(bf16, WS_LOGA); const bf16* GB = WSP(bf16, WS_GB); bf16* LH = WSP(bf16, WS_LH); float* SUM = WSP(float, WS_LSUM);
    const int b = wunit / 72, d = (wunit / 36) & 1, c = wunit % 36, c8 = 8 * F.lane, step = d ? -1 : 1;
    const int r0 = row_scan(b, d, 64 * c);
    float* sp = SUM + ((size_t)((b * 2 + d) * 36) * 2) * 512 + c8;
    float h[8], P[8];
#pragma unroll
    for (int j = 0; j < 8; ++j) { h[j] = 0.f; P[j] = 0.f; }
    if (FINAL) {
        for (int cc = 0; cc < c; ++cc) { const f32x4 p0 = *(const f32x4*)(sp + (size_t)cc * 1024), p1 = *(const f32x4*)(sp + (size_t)cc * 1024 + 4), e0 = *(const f32x4*)(sp + (size_t)cc * 1024 + 512), e1 = *(const f32x4*)(sp + (size_t)cc * 1024 + 516);
#pragma unroll
            for (int j = 0; j < 4; ++j) { h[j] = __expf(p0[j]) * h[j] + e0[j]; h[4 + j] = __expf(p1[j]) * h[4 + j] + e1[j]; } }
    }
    const bf16* lap = LOGA + d * 512 + c8; const bf16* gbp = GB + d * 512 + c8; bf16* lhp = LH + (size_t)d * RT * 512 + c8;
    for (int t0 = 0; t0 < 64; t0 += 8) {
        v4u la[8], gb[8];
#pragma unroll
        for (int j = 0; j < 8; ++j) { const size_t row = (size_t)(r0 + step * (t0 + j)); la[j] = *(const v4u*)(lap + row * 1024); gb[j] = *(const v4u*)(gbp + row * 1024); }
#pragma unroll
        for (int j = 0; j < 8; ++j) { float a[8], g[8]; unpack8(la[j], a); unpack8(gb[j], g);
#pragma unroll
            for (int e = 0; e < 8; ++e) { h[e] = __expf(a[e]) * h[e] + g[e]; if (!FINAL) P[e] += a[e]; }
            if (FINAL) *(v4u*)(lhp + (size_t)(r0 + step * (t0 + j)) * 512) = pack8(h); }
    }
    if (!FINAL) { float* o = sp + (size_t)c * 1024;
        *(f32x4*)(o) = (f32x4){P[0], P[1], P[2], P[3]}; *(f32x4*)(o + 4) = (f32x4){P[4], P[5], P[6], P[7]};
        *(f32x4*)(o + 512) = (f32x4){h[0], h[1], h[2], h[3]}; *(f32x4*)(o + 516) = (f32x4){h[4], h[5], h[6], h[7]}; }
}
template <bool DO_S5, bool DO_REST> __device__ __forceinline__ void finish_phase(Frame& F, const Args& A, int l, int nrows) {
    const bf16* Z = WSP(bf16, WS_Z); bf16* Y = WSP(bf16, WS_Y); bf16* A5 = WSP(bf16, WS_A5);
    const bf16* YS = WSP(bf16, WS_YS); const bf16* MH = WSP(bf16, WS_MH); const bf16* LH = WSP(bf16, WS_LH);
    const float* s5d = KIN(I_S5D) + (size_t)l * 512; const float* on = KIN(I_MLON) + (size_t)l * 512;
    const int gw = F.bid * NWAVES + F.wave, NGW = F.G * NWAVES; const int c8 = F.lane * 8;
    for (int r = gw; r < nrows; r += NGW) {
        float a[8], b[8], o[8];
        if (DO_S5) { unpack8(*(const v4u*)(YS + (size_t)r * 512 + c8), a); unpack8(*(const v4u*)(YS + ((size_t)RT + r) * 512 + c8), b); unpack8(*(const v4u*)(Z + (size_t)r * LDZ + ZU + c8), o);
#pragma unroll
          for (int j = 0; j < 8; ++j) a[j] = gelu_tanh(a[j] + b[j] + s5d[c8 + j] * o[j]);
          *(v4u*)(A5 + (size_t)r * 512 + c8) = pack8(a); }
        if (DO_REST) { unpack8(*(const v4u*)(LH + (size_t)r * 512 + c8), a); unpack8(*(const v4u*)(LH + ((size_t)RT + r) * 512 + c8), b); unpack8(*(const v4u*)(Z + (size_t)r * LDZ + ZLG + c8), o);
#pragma unroll
          for (int j = 0; j < 8; ++j) a[j] = (a[j] + b[j]) * gelu_tanh(o[j]);
          *(v4u*)(Y + (size_t)r * DM + 1536 + c8) = pack8(a); }
        if (DO_REST) { unpack8(*(const v4u*)(MH + (size_t)r * 512 + c8), a); unpack8(*(const v4u*)(MH + ((size_t)RT + r) * 512 + c8), b); unpack8(*(const v4u*)(Z + (size_t)r * LDZ + ZMO + c8), o);
          float ss = 0.f;
#pragma unroll
          for (int j = 0; j < 8; ++j) { a[j] += b[j]; ss += a[j] * a[j]; }
#pragma unroll
          for (int s = 1; s < 16; s <<= 1) ss += shx(ss, s, F.lane);
          const float rstd = rsqrtf(ss * (1.f / 128.f) + EPS);
#pragma unroll
          for (int j = 0; j < 8; ++j) a[j] = a[j] * rstd * on[c8 + j] * sigmoidf_(o[j]);
          *(v4u*)(Y + (size_t)r * DM + 512 + c8) = pack8(a); }
    }
}
#define MFMA16(a, b, c) __builtin_amdgcn_mfma_f32_16x16x32_bf16((a), (b), (c), 0, 0, 0)
#define MFMA32(a, b, c) __builtin_amdgcn_mfma_f32_32x32x16_bf16((a), (b), (c), 0, 0, 0)
__device__ __forceinline__ bf16x8 ldsfrag(const LAS bf16* p) { return *(const LAS bf16x8*)p; }

__device__ __forceinline__ void s5_scan(Frame& F, int l, int unit, int d) {
    const bf16* Z = WSP(bf16, WS_Z); bf16* YS = WSP(bf16, WS_YS);
    const float* S5A = WSP(float, WS_S5A); const bf16* BB = WSP(bf16, WS_S5BB); const bf16* CM = WSP(bf16, WS_S5CM);
    LAS bf16* Hs = (LAS bf16*)(F.lds + RING_OFF + F.wave * 8704);
    const int lane = F.lane, j = lane & 31, hl = lane >> 5, i16 = lane & 15, q4 = lane >> 4;
    const int hb = (j >> 2) & 1, tt = (j & 3) + 4 * (j >> 3);
    bf16* A5 = WSP(bf16, WS_A5); const float* s5d = KIN(I_S5D) + (size_t)l * 512;
    {
        const int bp = unit & 7, g = unit >> 3, b0 = 2 * bp, ldg = (l * 2 + d) * 32 + g;
        bf16x8 Bf[4], Cf[4];
#pragma unroll
        for (int t = 0; t < 4; ++t) { Bf[t] = *(const bf16x8*)(BB + ((size_t)ldg * 128 + t * 32 + j) * 16 + 8 * hl); Cf[t] = *(const bf16x8*)(CM + ((size_t)ldg * 16 + i16) * 128 + 32 * t + 8 * q4); }
        const float ar0 = S5A[((size_t)ldg * 64 + j) * 2], ai0 = S5A[((size_t)ldg * 64 + j) * 2 + 1], ar1 = S5A[((size_t)ldg * 64 + j + 32) * 2], ai1 = S5A[((size_t)ldg * 64 + j + 32) * 2 + 1];
        float hr0 = 0.f, hi0 = 0.f, hr1 = 0.f, hi1 = 0.f;
        const bf16* zu = Z + ZU + g * 16 + 8 * hl;
        bf16x8 a0 = *(const bf16x8*)(zu + (size_t)row_scan(b0 + hb, d, tt) * LDZ);
        bf16x8 a1 = *(const bf16x8*)(zu + (size_t)row_scan(b0 + hb, d, 16 + tt) * LDZ);
        for (int blk = 0; blk < TOK / 16; ++blk) {
            const int p0 = blk * 16, pn = min(blk + 2, TOK / 16 - 1) * 16;
            if (blk == CTXL / 32 || blk == CTXL / 16 + SEQ / 32) { asm volatile("s_waitcnt vmcnt(0)" ::: "memory"); __syncthreads(); }
            const bool fin = (blk >= CTXL / 32 && blk < CTXL / 16) || blk >= CTXL / 16 + SEQ / 32;
            const bf16x8 a2 = *(const bf16x8*)(zu + (size_t)row_scan(b0 + hb, d, pn + tt) * LDZ);
            f32x16 acc[4];
#pragma unroll
            for (int t = 0; t < 4; ++t) { f32x16 z;
#pragma unroll
                for (int e = 0; e < 16; ++e) z[e] = 0.f;
                acc[t] = MFMA32(a0, Bf[t], z); }
            LAS unsigned* hrow = (LAS unsigned*)(Hs + hl * (16 * 136)) + j;
#pragma unroll
            for (int r = 0; r < 16; ++r) {
                const float nr0 = ar0 * hr0 - ai0 * hi0 + acc[0][r], ni0 = ar0 * hi0 + ai0 * hr0 + acc[1][r];
                const float nr1 = ar1 * hr1 - ai1 * hi1 + acc[2][r], ni1 = ar1 * hi1 + ai1 * hr1 + acc[3][r];
                hr0 = nr0; hi0 = ni0; hr1 = nr1; hi1 = ni1;
                hrow[r * 68] = pk2(nr0, ni0); hrow[r * 68 + 32] = pk2(nr1, ni1);
            }
            asm volatile("s_waitcnt lgkmcnt(0)" ::: "memory");
#pragma unroll
            for (int h2 = 0; h2 < 2; ++h2) {
                f32x4 y = (f32x4){0.f, 0.f, 0.f, 0.f};
#pragma unroll
                for (int ks = 0; ks < 4; ++ks) y = MFMA16(Cf[ks], ldsfrag(Hs + h2 * (16 * 136) + i16 * 136 + 32 * ks + 8 * q4), y);
                { const int rr = row_scan(b0 + h2, d, p0 + i16);
                  if (!fin) { v2u o; o.x = pk2(y[0], y[1]); o.y = pk2(y[2], y[3]); *(v2u*)(YS + ((size_t)d * RT + rr) * 512 + g * 16 + 4 * q4) = o; }
                  else { const v2u yf = *(const v2u*)(YS + ((size_t)(1 - d) * RT + rr) * 512 + g * 16 + 4 * q4), uw = *(const v2u*)(Z + (size_t)rr * LDZ + ZU + g * 16 + 4 * q4); const f32x4 dv = *(const f32x4*)(s5d + g * 16 + 4 * q4);
                      const float a0 = gelu_tanh(y[0] + bflo(yf.x) + dv[0] * bflo(uw.x)), a1 = gelu_tanh(y[1] + bfhi(yf.x) + dv[1] * bfhi(uw.x));
                      const float a2 = gelu_tanh(y[2] + bflo(yf.y) + dv[2] * bflo(uw.y)), a3 = gelu_tanh(y[3] + bfhi(yf.y) + dv[3] * bfhi(uw.y));
                      v2u o; o.x = pk2(a0, a1); o.y = pk2(a2, a3); *(v2u*)(A5 + (size_t)rr * 512 + g * 16 + 4 * q4) = o; } }
            }
            asm volatile("s_waitcnt lgkmcnt(0)" ::: "memory");
            a0 = a1; a1 = a2;
        }
    }
}

constexpr int ML_QS = 0, ML_KS = 17408, ML_VS = 34816, ML_KW = 53248, ML_CT = 71680, ML_SP = 108544, ML_FL = 118784;
constexpr int ML_P = 144, ML_SPP = 80;
typedef short v4i16_t __attribute__((ext_vector_type(4)));
__device__ __forceinline__ v2u tr16(const LAS bf16* p) { return __builtin_bit_cast(v2u, __builtin_amdgcn_ds_read_tr16_b64_v4i16((LAS v4i16_t*)p)); }
__device__ __forceinline__ bf16x8 trfrag(const LAS bf16* base, int pitch, int k0, int n0) {
    const v2u lo = tr16(base + k0 * pitch + n0), hi = tr16(base + (k0 + 4) * pitch + n0);
    const v4u w = (v4u){lo.x, lo.y, hi.x, hi.y}; return __builtin_bit_cast(bf16x8, w);
}
__device__ __forceinline__ void mlstm_chain(Frame& F, const Args& A, int l, int unit) {
    const bf16* Z = WSP(bf16, WS_Z); bf16* MH = WSP(bf16, WS_MH);
    const int b = unit >> 3, head = (unit >> 1) & 3, dir = unit & 1;
    LAS bf16* Qs = (LAS bf16*)(F.lds + ML_QS); LAS bf16* Ks = (LAS bf16*)(F.lds + ML_KS); LAS bf16* Vs = (LAS bf16*)(F.lds + ML_VS);
    LAS bf16* Kw = (LAS bf16*)(F.lds + ML_KW); LAS bf16* Ct = (LAS bf16*)(F.lds + ML_CT); LAS bf16* Sp = (LAS bf16*)(F.lds + ML_SP);
    LAS float* bcum = (LAS float*)(F.lds + ML_FL); LAS float* lis = bcum + 64; LAS float* den = bcum + 128; LAS float* nq = bcum + 192; LAS float* nvec = bcum + 256; LAS float* nadd = bcum + 384;
    int lane_l = F.lane; asm volatile("" : "+v"(lane_l));
    const int lane = lane_l, w = F.wave, tid = w * 64 + lane, i16 = lane & 15, q4 = lane >> 4;
    const float igb = KIN(I_MLIG)[(l * 2 + dir) * 4 + head], fgb = KIN(I_MLFG)[(l * 2 + dir) * 4 + head];
    const float kscale = 0.08838834764831845f;
    f32x4 C[8];
#pragma unroll
    for (int e = 0; e < 8; ++e) C[e] = (f32x4){0.f, 0.f, 0.f, 0.f};
    __syncthreads();
    if (tid < 128) nvec[tid] = 0.f;
    nadd[tid] = 0.f;
    float gb[5], gl[5];
#pragma unroll
    for (int j = 0; j < 5; ++j) { const int cc = 8 * j + w; gb[j] = 0.f; gl[j] = 0.f;
        if (cc < TOK / 64) { const bf16* zr = Z + (size_t)row_scan(b, dir, 64 * cc + lane) * LDZ + ZMG + dir * 8 + head; gl[j] = bf2f(zr[0]) + igb; gb[j] = logsigmoidf_(bf2f(zr[4]) + fgb); } }
#pragma unroll
    for (int o = 1; o < 64; o <<= 1) {
#pragma unroll
        for (int j = 0; j < 5; ++j) { const float t = shup(gb[j], o, lane); if (lane >= o) gb[j] += t; } }
    const int trq = (8 * q4 + (i16 >> 2)), trc = 4 * (i16 & 3);
    const LAS bf16* vs_tr = Vs + trq * ML_P + trc; const LAS bf16* kw_tr = Kw + trq * ML_P + trc; const LAS bf16* ct_tr = Ct + trq * ML_P + trc; const LAS bf16* sp_tr = Sp + trq * ML_SPP + trc;
    v4u qreg[2], kreg[2], vreg[2];
    auto load_chunk = [&](int c) {
#pragma unroll
        for (int i = 0; i < 2; ++i) { const int idx = tid + 512 * i, s = idx >> 4, c8 = (idx & 15) * 8; const bf16* zr = Z + (size_t)row_scan(b, dir, 64 * c + s) * LDZ + head * 128 + c8;
            qreg[i] = *(const v4u*)(zr + ZMQ); kreg[i] = *(const v4u*)(zr + ZMK); vreg[i] = *(const v4u*)(zr + ZMV); }
    };
    load_chunk(0);
    float eBprev = 1.f;
    for (int c = 0; c < TOK / 64; ++c) {
        __syncthreads();
        if (w == (c & 7)) { float bv = gb[0], lv = gl[0];
#pragma unroll
            for (int j = 1; j < 5; ++j) if ((c >> 3) == j) { bv = gb[j]; lv = gl[j]; }
            bcum[lane] = bv; lis[lane] = lv; }
        if (tid < 128) nvec[tid] = eBprev * nvec[tid] + ((nadd[tid] + nadd[128 + tid]) + (nadd[256 + tid] + nadd[384 + tid]));
#pragma unroll
        for (int i = 0; i < 2; ++i) { const int idx = tid + 512 * i, s = idx >> 4, c8 = (idx & 15) * 8;
            *(LAS v4u*)(Qs + s * 136 + c8) = qreg[i];
            *(LAS v4u*)(Vs + s * ML_P + c8) = vreg[i]; }
#pragma unroll
        for (int et = 0; et < 8; ++et) { v2u cw; cw.x = pk2(C[et][0], C[et][1]); cw.y = pk2(C[et][2], C[et][3]); *(LAS v2u*)(Ct + (16 * et + i16) * ML_P + 16 * w + 4 * q4) = cw; }
        float kf[2][8];
#pragma unroll
        for (int i = 0; i < 2; ++i) { const int idx = tid + 512 * i, s = idx >> 4, c8 = (idx & 15) * 8;
            unpack8(kreg[i], kf[i]);
#pragma unroll
            for (int jj = 0; jj < 8; ++jj) kf[i][jj] *= kscale;
            *(LAS v4u*)(Ks + s * 136 + c8) = pack8(kf[i]); }
        if (c + 1 < TOK / 64) load_chunk(c + 1);
        __syncthreads();
        const float Btot = bcum[63];
#pragma unroll
        for (int i = 0; i < 2; ++i) { const int idx = tid + 512 * i, s = idx >> 4, c8 = (idx & 15) * 8; const float ws = __expf(Btot - bcum[s] + lis[s]);
#pragma unroll
            for (int jj = 0; jj < 8; ++jj) kf[i][jj] *= ws;
            *(LAS v4u*)(Kw + s * ML_P + c8) = pack8(kf[i]); }
#pragma unroll
        for (int ti = 0; ti < 2; ++ti) { const int idx = 2 * w + ti, tt = idx >> 2, st = idx & 3; const int srow = 16 * st + i16;
            f32x4 acc = (f32x4){0.f, 0.f, 0.f, 0.f};
            if (st <= tt) {
#pragma unroll
                for (int ks = 0; ks < 4; ++ks) acc = MFMA16(ldsfrag(Qs + (16 * tt + i16) * 136 + 32 * ks + 8 * q4), ldsfrag(Ks + srow * 136 + 32 * ks + 8 * q4), acc); }
            const float bs = bcum[srow], ls = lis[srow]; const f32x4 bt = *(const LAS f32x4*)(bcum + 16 * tt + 4 * q4); float v[4];
#pragma unroll
            for (int r = 0; r < 4; ++r) { const int t = 16 * tt + 4 * q4 + r; v[r] = (srow <= t && st <= tt) ? acc[r] * __expf(bt[r] - bs + ls) : 0.f; }
            v2u sw; sw.x = pk2(v[0], v[1]); sw.y = pk2(v[2], v[3]); *(LAS v2u*)(Sp + srow * ML_SPP + 16 * tt + 4 * q4) = sw; }
        __syncthreads();
        bf16x8 vfr[2], cfr[4], nfr[4];
        const bf16x8 onesf = __builtin_bit_cast(bf16x8, (v4u){0x3f803f80u, 0x3f803f80u, 0x3f803f80u, 0x3f803f80u});
#pragma unroll
        for (int ks = 0; ks < 2; ++ks) vfr[ks] = trfrag(vs_tr, ML_P, 32 * ks, 16 * w);
#pragma unroll
        for (int ks = 0; ks < 4; ++ks) { cfr[ks] = trfrag(ct_tr, ML_P, 32 * ks, 16 * w);
            const f32x4 n0 = *(const LAS f32x4*)(nvec + 32 * ks + 8 * q4), n1 = *(const LAS f32x4*)(nvec + 32 * ks + 8 * q4 + 4);
            const float nf[8] = {n0.x, n0.y, n0.z, n0.w, n1.x, n1.y, n1.z, n1.w}; nfr[ks] = __builtin_bit_cast(bf16x8, pack8(nf)); }
#pragma unroll 2
        for (int tt = 0; tt < 4; ++tt) {
            f32x4 a1 = (f32x4){0.f, 0.f, 0.f, 0.f}, a2 = (f32x4){0.f, 0.f, 0.f, 0.f}, ad = (f32x4){0.f, 0.f, 0.f, 0.f}, an = (f32x4){0.f, 0.f, 0.f, 0.f};
#pragma unroll
            for (int ks = 0; ks < 2; ++ks) { const bf16x8 sf = trfrag(sp_tr, ML_SPP, 32 * ks, 16 * tt); a1 = MFMA16(vfr[ks], sf, a1); ad = MFMA16(onesf, sf, ad); }
#pragma unroll
            for (int ks = 0; ks < 4; ++ks) { const bf16x8 qf = ldsfrag(Qs + (16 * tt + i16) * 136 + 32 * ks + 8 * q4); a2 = MFMA16(cfr[ks], qf, a2); an = MFMA16(nfr[ks], qf, an); }
            const int rr = row_scan(b, dir, 64 * c + 16 * tt + i16);
            { const float eb = __expf(bcum[16 * tt + i16]), dn = ad[0] + eb * an[0], inv = __builtin_amdgcn_rcpf(fmaxf(fabsf(dn), 1.f));
              v2u o; o.x = pk2((a1[0] + eb * a2[0]) * inv, (a1[1] + eb * a2[1]) * inv); o.y = pk2((a1[2] + eb * a2[2]) * inv, (a1[3] + eb * a2[3]) * inv);
              *(v2u*)(MH + ((size_t)dir * RT + rr) * 512 + head * 128 + 16 * w + 4 * q4) = o; }
        }
        const float eB = __expf(Btot);
#pragma unroll
        for (int et = 0; et < 8; ++et) { f32x4 acc = C[et] * eB;
#pragma unroll
            for (int ks = 0; ks < 2; ++ks) acc = MFMA16(vfr[ks], trfrag(kw_tr, ML_P, 32 * ks, 16 * et), acc);
            C[et] = acc; if (et & 1) __builtin_amdgcn_sched_barrier(0); }
        { const int e = tid & 127, part = tid >> 7; float s = 0.f;
#pragma unroll
          for (int ss = 0; ss < 16; ++ss) s += bf2f(Kw[(16 * part + ss) * ML_P + e]);
          nadd[tid] = s; }
        eBprev = eB;
    }
    __syncthreads();
}

constexpr float ATT_THR = 8.f;
constexpr int AT_K = 0, AT_V = 25600, AT_VP = 144, AT_BUF = 44032;
__device__ __forceinline__ void attn_unit(Frame& F, int b, int h, int qrow0, int nkt, const float* qn  ) {
    const bf16* Q = WSP(bf16, WS_QRAW); const bf16* K = WSP(bf16, WS_K); const bf16* KVRAW = WSP(bf16, WS_KVRAW); bf16* Y = WSP(bf16, WS_Y);
    LAS bf16* Kl = (LAS bf16*)(F.lds + AT_K); LAS bf16* Vl = (LAS bf16*)(F.lds + AT_V);
    int lane_l = F.lane; asm volatile("" : "+v"(lane_l));
    const int lane = lane_l, w = F.wave, tid = w * 64 + lane, i16 = lane & 15, q4 = lane >> 4;
    bf16x8 qf[2][6];
    const bf16* Qb = Q + (size_t)qrow0 * 768 + h * 192;
    const unsigned qoff = (unsigned)((32 * w + i16) * 768 + 8 * q4);
#pragma unroll
    for (int qt = 0; qt < 2; ++qt)
#pragma unroll
        for (int ks = 0; ks < 6; ++ks) qf[qt][ks] = *(const bf16x8*)(Qb + (qoff + (unsigned)(16 * qt * 768 + 32 * ks)));
    { const float* rope = WSP(float, WS_ROPE); const bool lat = qrow0 < RL;
#pragma unroll
      for (int qt = 0; qt < 2; ++qt) {
          float f[6][8]; float ss = 0.f;
#pragma unroll
          for (int ks = 0; ks < 6; ++ks) { unpack8(__builtin_bit_cast(v4u, qf[qt][ks]), f[ks]);
#pragma unroll
              for (int j = 0; j < 8; ++j) ss += f[ks][j] * f[ks][j]; }
          ss += shx(ss, 16, lane); ss += shx(ss, 32, lane);
          const float rs = rsqrtf(ss * (1.f / 192.f) + EPS);
#pragma unroll
          for (int ks = 0; ks < 6; ++ks) { const f32x4 n0 = *(const f32x4*)(qn + 32 * ks + 8 * q4), n1 = *(const f32x4*)(qn + 32 * ks + 8 * q4 + 4);
#pragma unroll
              for (int j = 0; j < 4; ++j) { f[ks][j] *= rs * n0[j]; f[ks][4 + j] *= rs * n1[j]; } }
          if (lat) { const int t = (qrow0 + 32 * w + 16 * qt + i16) & (SEQ - 1); const bool second = (q4 & 2) != 0;
#pragma unroll
              for (int part = 0; part < 2; ++part) {
                  const int pos = part ? (t & 63) : (t >> 6); const f32x4* tp = (const f32x4*)(rope + (size_t)(pos * 16 + 8 * (q4 & 1)) * 2);
                  const f32x4 t0 = tp[0], t1 = tp[1], t2 = tp[2], t3 = tp[3];
                  const float cs[8] = {t0.x, t0.z, t1.x, t1.z, t2.x, t2.z, t3.x, t3.z}, sn[8] = {t0.y, t0.w, t1.y, t1.w, t2.y, t2.w, t3.y, t3.w};
#pragma unroll
                  for (int j = 0; j < 8; ++j) { const float me = f[4 + part][j], other = shx(me, 32, lane); f[4 + part][j] = second ? (me * cs[j] + other * sn[j]) : (me * cs[j] - other * sn[j]); } } }
#pragma unroll
          for (int ks = 0; ks < 6; ++ks) {
#pragma unroll
              for (int j = 0; j < 8; ++j) f[ks][j] *= ATTN_SCALE_LOG2E;
              qf[qt][ks] = __builtin_bit_cast(bf16x8, pack8(f[ks])); }
      } }
    f32x4 O[2][8];
#pragma unroll
    for (int qt = 0; qt < 2; ++qt)
#pragma unroll
        for (int dt = 0; dt < 8; ++dt) O[qt][dt] = (f32x4){0.f, 0.f, 0.f, 0.f};
    float mrun[2] = {-1e30f, -1e30f}, lsum[2] = {0.f, 0.f};
    const bf16* kbase = K + (size_t)b * TOK * 768 + h * 192;
    v4u kr[3], vr[2];
    unsigned koff[3], voff[2];
#pragma unroll
    for (int i = 0; i < 3; ++i) { const int idx = tid + 512 * i, r = idx / 24, cc = idx % 24; koff[i] = (unsigned)(r * 768 + 8 * cc); }
#pragma unroll
    for (int i = 0; i < 2; ++i) { const int idx = tid + 512 * i, r = idx >> 4, cc = idx & 15; voff[i] = (unsigned)(r * 1024 + 8 * cc); }
    auto load_tile = [&](int kt) {
        const bf16* kb = kbase + (size_t)kt * (64 * 768); const bf16* vb = KVRAW + (size_t)row_key(b, 64 * kt) * 1024 + h * 256 + 128;
#pragma unroll
        for (int i = 0; i < 3; ++i) kr[i] = *(const v4u*)(kb + koff[i]);
#pragma unroll
        for (int i = 0; i < 2; ++i) vr[i] = *(const v4u*)(vb + voff[i]);
    };
    const LAS bf16* vtr0 = Vl + (4 * q4 + (i16 >> 2)) * AT_VP + 4 * (i16 & 3);
    int kwo[3], vwo[2];
#pragma unroll
    for (int i = 0; i < 3; ++i) { const int idx = tid + 512 * i, r = idx / 24, cc = idx % 24; kwo[i] = r * 200 + 8 * cc; }
#pragma unroll
    for (int i = 0; i < 2; ++i) { const int idx = tid + 512 * i, r = idx >> 4, cc = idx & 15; vwo[i] = r * AT_VP + 8 * cc; }
    load_tile(0);
    __syncthreads();
#pragma unroll
    for (int i = 0; i < 3; ++i) *(LAS v4u*)(Kl + kwo[i]) = kr[i];
#pragma unroll
    for (int i = 0; i < 2; ++i) *(LAS v4u*)(Vl + vwo[i]) = vr[i];
    __syncthreads();
    for (int kt = 0; kt < nkt; ++kt) {
        const int bo = (kt & 1) * (AT_BUF / 2);
        const LAS bf16* Kc = Kl + bo; const LAS bf16* vtrc = vtr0 + bo;
        if (kt + 1 < nkt) load_tile(kt + 1);
        f32x4 s[2][4];
#pragma unroll
        for (int k4 = 0; k4 < 4; ++k4) {
            f32x4 s0 = (f32x4){0.f, 0.f, 0.f, 0.f}, s1 = (f32x4){0.f, 0.f, 0.f, 0.f};
#pragma unroll
            for (int ks = 0; ks < 6; ++ks) { const bf16x8 kf = ldsfrag(Kc + (16 * k4 + i16) * 200 + 32 * ks + 8 * q4); s0 = MFMA16(kf, qf[0][ks], s0); s1 = MFMA16(kf, qf[1][ks], s1); }
            s[0][k4] = s0; s[1][k4] = s1;
        }
        bf16x8 pf[2][2];
        float tmx[2];
#pragma unroll
        for (int qt = 0; qt < 2; ++qt) {
            float tm = -1e30f;
#pragma unroll
            for (int k4 = 0; k4 < 4; ++k4)
#pragma unroll
                for (int r = 0; r < 4; ++r) tm = fmaxf(tm, s[qt][k4][r]);
            tm = fmaxf(tm, shx(tm, 16, lane)); tm = fmaxf(tm, shx(tm, 32, lane)); tmx[qt] = tm; }
        if (__builtin_amdgcn_ballot_w64((tmx[0] > mrun[0] + ATT_THR) || (tmx[1] > mrun[1] + ATT_THR)) != 0ull) {
#pragma unroll
            for (int qt = 0; qt < 2; ++qt) { const float mn = fmaxf(mrun[qt], tmx[qt]), alpha = __builtin_amdgcn_exp2f(mrun[qt] - mn);
                mrun[qt] = mn; lsum[qt] *= alpha;
#pragma unroll
                for (int dt = 0; dt < 8; ++dt) O[qt][dt] = O[qt][dt] * alpha; }
        }
#pragma unroll
        for (int qt = 0; qt < 2; ++qt) {
            const float mn = mrun[qt];
            float ps = 0.f; float p[4][4];
#pragma unroll
            for (int k4 = 0; k4 < 4; ++k4)
#pragma unroll
                for (int r = 0; r < 4; ++r) { p[k4][r] = __builtin_amdgcn_exp2f(s[qt][k4][r] - mn); ps += p[k4][r]; }
            lsum[qt] += ps;
#pragma unroll
            for (int kk = 0; kk < 2; ++kk) { v4u pw; pw.x = pk2(p[2 * kk][0], p[2 * kk][1]); pw.y = pk2(p[2 * kk][2], p[2 * kk][3]); pw.z = pk2(p[2 * kk + 1][0], p[2 * kk + 1][1]); pw.w = pk2(p[2 * kk + 1][2], p[2 * kk + 1][3]);
                pf[qt][kk] = __builtin_bit_cast(bf16x8, pw); }
        }
#pragma unroll
        for (int dt = 0; dt < 8; ++dt)
#pragma unroll
            for (int kk = 0; kk < 2; ++kk) {
                const v2u lo = tr16(vtrc + (32 * kk) * AT_VP + 16 * dt), hi = tr16(vtrc + (32 * kk + 16) * AT_VP + 16 * dt);
                const v4u vw = (v4u){lo.x, lo.y, hi.x, hi.y}; const bf16x8 vf = __builtin_bit_cast(bf16x8, vw);
                O[0][dt] = MFMA16(vf, pf[0][kk], O[0][dt]); O[1][dt] = MFMA16(vf, pf[1][kk], O[1][dt]);
            }
        if (kt + 1 < nkt) { const int bn = ((kt + 1) & 1) * (AT_BUF / 2);
#pragma unroll
            for (int i = 0; i < 3; ++i) *(LAS v4u*)(Kl + bn + kwo[i]) = kr[i];
#pragma unroll
            for (int i = 0; i < 2; ++i) *(LAS v4u*)(Vl + bn + vwo[i]) = vr[i]; }
        __syncthreads();
    }
#pragma unroll
    for (int qt = 0; qt < 2; ++qt) {
        float lt = lsum[qt]; lt += shx(lt, 16, lane); lt += shx(lt, 32, lane);
        const float inv = 1.f / lt;
        bf16* Yb = Y + (size_t)qrow0 * DM + 1024 + h * 128; const unsigned yoff = (unsigned)((32 * w + 16 * qt + i16) * DM + 4 * q4);
#pragma unroll
        for (int dt = 0; dt < 8; ++dt) { const f32x4 o = O[qt][dt] * inv; v2u ow; ow.x = pk2(o[0], o[1]); ow.y = pk2(o[2], o[3]); *(v2u*)(Yb + (yoff + (unsigned)(16 * dt))) = ow; }
    }
    __syncthreads();
}
template <class E_> __device__ __forceinline__ void probe_redirect(E_&, float*) {}
__device__ __forceinline__ void probe_redirect(pg8::EpiRes& e, float* dummy) { e.xout = dummy; }

__global__ void __launch_bounds__(NTHR, 2) trunk_fwd(Args A) {
    extern __shared__ __attribute__((aligned(16))) unsigned char lds[];
    Frame F;
    F.lds = (LAS unsigned char*)lds;
    F.MISC = (volatile LAS unsigned*)(F.lds + MISC_OFF);
    F.tid = threadIdx.x; F.lane = F.tid & 63; F.wave = __builtin_amdgcn_readfirstlane(F.tid >> 6);
    F.G = gridDim.x; F.bid = blockIdx.x;
    F.ws = A.ws; F.out = A.out; F.kp = (const __attribute__((address_space(4))) char*)__builtin_amdgcn_kernarg_segment_ptr();
    unsigned char* const ws0 = A.ws; const __attribute__((address_space(4))) char* const kp0 = F.kp;
    F.ctl = (gu32*)(A.ws + WS_CTL);
    for (int u = F.tid; u < (LDS_BYTES - LDSCTL_OFF) / 4; u += NTHR) ((LAS unsigned*)(F.lds + LDSCTL_OFF))[u] = 0u;
    __syncthreads();
    XcdBarrier bar = xcd_barrier_post((unsigned*)(F.ctl + CW_BAR), F.MISC + 8);
    const int lo = A.lo, hi = A.hi, wave0 = F.wave;
    int st = 0;
#define RELAUNDER() do { int w_s = wave0; asm volatile("" : "+s"(w_s)); F.wave = w_s; { unsigned m_ = ~0u; asm volatile("" : "+v"(m_)); F.lane = (int)__builtin_amdgcn_mbcnt_hi(m_, __builtin_amdgcn_mbcnt_lo(m_, 0u)); } F.tid = w_s * 64 + F.lane; int b_ = blockIdx.x, g_ = gridDim.x; asm volatile("" : "+s"(b_), "+s"(g_)); F.bid = b_; F.G = g_; GAS unsigned char* w_ = (GAS unsigned char*)ws0; asm volatile("" : "+s"(w_)); F.ws = (unsigned char*)w_; const __attribute__((address_space(4))) char* k_ = kp0; asm volatile("" : "+s"(k_)); F.kp = k_; } while (0)
#define STEP_BEGIN if (st >= lo && st < hi) { asm volatile("; STEP_MARK_BEGIN %0" :: "n"(__LINE__)); RELAUNDER();
#define STEP_END   asm volatile("; STEP_MARK_END %0" :: "n"(__LINE__)); if (st + 1 < hi) { xcd_barrier(bar); if (PROBE_DUP == 11) xcd_barrier(bar); } } ++st;
#define PROBE_REDIRECT(e) probe_redirect(e, WSP(float, WS_Z))
#define GEMM_STAGGER() do { if (STAG_GROUPS > 1) { const int sg_ = (F.bid >> 3) % STAG_GROUPS; for (int i_ = 0; i_ < sg_; ++i_) __builtin_amdgcn_s_sleep(STAG_SLEEP); } } while (0)
#define GEMM_RUN(EPI) { if (PROBE_DUP == 8) { auto E2_ = E; PROBE_REDIRECT(E2_); pg8::gemm_phase<decltype(E2_), pg8::StaticOrder, GEMM_ALIGN, GEMM_SP2>(ring, g, S, E2_, F.tid); RELAUNDER(); } \
    if (PROBE_DUP == 1) { pg8::EpiNull EN_; pg8::gemm_phase<pg8::EpiNull, pg8::StaticOrder, GEMM_ALIGN, GEMM_SP2>(ring, g, S, EN_, F.tid); RELAUNDER(); } \
    pg8::gemm_phase<pg8::EPI, pg8::StaticOrder, GEMM_ALIGN, GEMM_SP2>(ring, g, S, E, F.tid); }
#define GEMM_RUN_NSP(EPI, NSPV) { pg8::gemm_phase<pg8::EPI, pg8::StaticOrder, GEMM_ALIGN, GEMM_SP2, NSPV>(ring, g, S, E, F.tid); }
#define MODS_L (WSP(float, WS_MODS) + (size_t)l * 17 * NMOD)
    LAS unsigned char* ring = F.lds + RING_OFF;

    STEP_BEGIN
        for (int rep = 0; rep < (PROBE_DUP == 7 ? 2 : 1); ++rep)
        p0a_prologue(F, KIN(I_C), KIN(I_CCTX), KIN(I_ADAW), KIN(I_ADAB), KIN(I_S5LRE), KIN(I_S5LIM), KIN(I_S5LDT), KIN(I_S5BRE), KIN(I_S5BIM), KIN(I_S5CRE), KIN(I_S5CIM));
    STEP_END
    STEP_BEGIN
        for (int rep = 0; rep < (PROBE_DUP == 24 ? 2 : 1); ++rep) { p0c_shw(F, KIN(I_WIN), KIN(I_W1)); RELAUNDER(); }
    STEP_END

    for (int l = 0; l < DEPTH; ++l) {
        const bool need_ctx = l < DEPTH - 1;
        const int nrows = need_ctx ? RT : RL;
        STEP_BEGIN
            for (int rep = 0; rep < ((PROBE_DUP == 4 || PROBE_DUP == 20) ? 2 : 1); ++rep) {
            convert_weights(F, A, l, l);
            RELAUNDER();
            if (l == 0) norm0_phase(F, KIN(I_X), KIN(I_CTX), KIN(I_N1W), WSP(float, WS_MODS));
            else { rstd_phase(F, RL); RELAUNDER(); if (rep == 0) ctxfix_phase(F, MODS_L - 17 * NMOD + 16 * NMOD + 5 * DM, KIN(I_N1W) + (size_t)l * DM, MODS_L + 16 * NMOD + 1 * DM); }
            RELAUNDER(); }
        STEP_END
        STEP_BEGIN
            pg8::Gemm g{WSP(bf16, WS_H), WSP(bf16, WS_WIN), RT, LDZ, DM}; g.ablk = 1; pg8::StaticOrder S; S.init(RT, LDZ, F.G, F.bid);
            for (int rep = 0; rep < (PROBE_DUP == 14 ? 2 : 1); ++rep) {
            pg8::EpiStoreN E{WSP(bf16, WS_Z), LDZ, WSP(float, WS_RSTD), WSP(float, WS_SHW) + (size_t)l * 17 * (LDZ + DFF), LDZ + DFF};
            GEMM_STAGGER(); GEMM_RUN(EpiStoreN)
            RELAUNDER(); }
        STEP_END
        STEP_BEGIN
            for (int rep = 0; rep < ((PROBE_DUP == 4 || PROBE_DUP == 21) ? 2 : 1); ++rep) { prep_phase(F, A, l); RELAUNDER(); }
        STEP_END
        STEP_BEGIN
            for (int rep = 0; rep < (PROBE_DUP == 12 ? 2 : 1); ++rep) {
            { const pg8::GrpDesc gl{WSP(bf16, WS_XS), WSP(bf16, WS_WLRU), RT, 2048, 128, 512, 4}, gk{WSP(bf16, WS_AKV), WSP(bf16, WS_WKVUP), RT, 1024, 256, 256, 0},
                                 gq{WSP(bf16, WS_AQ), WSP(bf16, WS_WQUP), need_ctx ? RT : RL, 768, 384, 384, 0};
              const pg8::EpiLru el{WSP(bf16, WS_XS), WSP(bf16, WS_LOGA), WSP(bf16, WS_GB), WSP(float, WS_LRUC)};
              const pg8::EpiStoreBf16 ek{WSP(bf16, WS_KVRAW), 1024}, eq{WSP(bf16, WS_QRAW), 768};
              pg8::gemm_group3(ring, gl, gk, gq, el, ek, eq, F.G, F.bid, F.tid); }
            RELAUNDER(); }
        STEP_END
        STEP_BEGIN
            for (int rep = 0; rep < (PROBE_DUP == 3 ? 2 : 1); ++rep) {
            const int s5wg = (S5_IN_L4 && F.G >= 256) ? 64 : 0;
            if (F.bid < s5wg) s5_scan(F, l, F.bid * 4 + (F.wave >> 1), F.wave & 1);
            else {
            for (int wu = (F.bid - s5wg) * NWAVES + F.wave; wu < NB * 2 * 36; wu += (F.G - s5wg) * NWAVES) lru_chunk<false>(F, wu);
            RELAUNDER();
            mla_finish(F, A, l, need_ctx, s5wg, F.G - s5wg); }
            RELAUNDER(); }
        STEP_END
        STEP_BEGIN
            const int nattn = 704 + (need_ctx ? 64 : 0), nunits = nattn + 144;
            volatile LAS unsigned* slot = F.MISC + 16;
            for (int rep = 0; rep < ((PROBE_DUP == 2 || PROBE_DUP == 5 || PROBE_DUP == 6 || PROBE_DUP == 9) ? 2 : 1); ++rep) {
            gu32* qh = F.ctl + CW_QUEUE + 64 * (l + 4 * rep);
            const int ubase = (rep == 1 && PROBE_DUP == 6) ? 192 : (rep == 1 && PROBE_DUP == 9) ? 128 : 0;
            const int ulim = (rep == 1 && PROBE_DUP == 5) ? 128 : (rep == 1 && PROBE_DUP == 9) ? 192 : nunits;
            for (;;) {
                __syncthreads();
                if (F.tid == 0) slot[0] = __hip_atomic_fetch_add(qh, 1u, __ATOMIC_RELAXED, __HIP_MEMORY_SCOPE_AGENT);
                __syncthreads();
                const int u = ubase + __builtin_amdgcn_readfirstlane((int)slot[0]);
                if (u >= ulim) break;
                if (u < 128) mlstm_chain(F, A, l, u);
                else if (u < 192) s5_scan(F, l, (u - 128) * 4 + (F.wave >> 1), F.wave & 1);
                else if (u >= nattn) lru_chunk<true>(F, (u - nattn) * 8 + F.wave);
                else { int ab, ah, aq, an; const int ua = u - 192;
                    if (ua < 512) { ab = ua >> 5; ah = (ua >> 3) & 3; aq = (ua >> 5) * SEQ + 256 * (ua & 7); an = TOK / 64; }
                    else { const int uc = ua - 512; ab = uc >> 2; ah = uc & 3; aq = RL + (uc >> 2) * CTXL; an = CTXL / 64; }
                    attn_unit(F, ab, ah, aq, an, KIN(I_QN) + (size_t)l * 192); }
                RELAUNDER();
            }
            }
        STEP_END
        STEP_BEGIN
            pg8::Gemm g{WSP(bf16, WS_A5), WSP(bf16, WS_WGLU), nrows, 512, 512}; pg8::StaticOrder S; S.init(nrows, 512, F.G, F.bid);
            for (int rep = 0; rep < (PROBE_DUP == 13 ? 2 : 1); ++rep) {
            pg8::EpiGlu E{WSP(bf16, WS_A5), WSP(bf16, WS_Y), DM, KIN(I_S5GLUB) + (size_t)l * 512};
            GEMM_RUN(EpiGlu)
            RELAUNDER();
            finish_phase<false, true>(F, A, l, nrows);
            RELAUNDER(); }
        STEP_END
        STEP_BEGIN
            pg8::Gemm g{WSP(bf16, WS_Y), WSP(bf16, WS_WOUT), nrows, DM, DM}; pg8::StaticOrder S; S.init(nrows, DM, F.G, F.bid);
            if (l == 0) {
                pg8::EpiResNF E{KIN(I_X), KIN(I_CTX) - (size_t)RL * DM, WSP(bf16, WS_X), MODS_L + 2 * DM, 0, WSP(bf16, WS_H), KIN(I_N2W) + (size_t)l * DM, MODS_L + 4 * DM, WSP(float, WS_SSP)};
                GEMM_RUN(EpiResNF)
            } else {
                pg8::EpiResN E{WSP(bf16, WS_X), WSP(bf16, WS_X), WSP(bf16, WS_X), MODS_L + 2 * DM, 0, WSP(bf16, WS_H), KIN(I_N2W) + (size_t)l * DM, MODS_L + 4 * DM, WSP(float, WS_SSP)};
                GEMM_RUN(EpiResN)
            }
        STEP_END
        STEP_BEGIN
            for (int rep = 0; rep < (PROBE_DUP == 23 ? 2 : 1); ++rep) { rstd_phase(F, nrows); RELAUNDER(); }
        STEP_END
        { const int nch = (nrows + MLP_CHUNK - 1) / MLP_CHUNK;
          for (int c = 0; c <= nch; ++c) {
            STEP_BEGIN
                const int g1first = (MLP_ALT && c >= 1 && c < nch) ? ((F.bid >> 3) & 1) : 0;
                for (int ord = 0; ord < 2; ++ord) { const int which = ord ^ g1first;
                if (which == 0) {
                if (c >= 1) { const int r0 = (c - 1) * MLP_CHUNK, m = min(MLP_CHUNK, nrows - r0); const bf16* hid = WSP(bf16, WS_Z) + (size_t)((c - 1) & 1) * MLP_CHUNK * DFF;
                    if (m >= 8192) {
                        if (need_ctx) {
                            pg8::Gemm g{hid, WSP(bf16, WS_W2), m, DM, DFF}; g.ablk = 1; pg8::StaticOrder S; S.init(m, DM, F.G, F.bid);
                            pg8::EpiResN E{WSP(bf16, WS_X), WSP(bf16, WS_X), WSP(bf16, WS_X), MODS_L + 5 * DM, r0,
                                           WSP(bf16, WS_H), KIN(I_N1W) + (size_t)(l + 1) * DM, MODS_L + 17 * NMOD + 1 * DM, WSP(float, WS_SSP)};
                            GEMM_RUN(EpiResN)
                        } else {
                            pg8::Gemm g{hid, WSP(bf16, WS_W2), m, DM, DFF}; g.ablk = 1; pg8::StaticOrder S; S.init(m, DM, F.G, F.bid);
                            pg8::EpiResOut E{WSP(bf16, WS_X), F.out, MODS_L + 5 * DM, r0};
                            GEMM_RUN(EpiResOut)
                        }
                    } else {
                        pg8::Gemm g{hid, WSP(bf16, WS_W2), m, 2 * DM, DFF / 2, DFF, DM / 256}; g.ablk = 1; pg8::StaticOrder S; S.init(m, 2 * DM, F.G, F.bid);
                        pg8::EpiPart E{WSP(float, WS_LOGA), DM / 256, RC};
                        GEMM_RUN_NSP(EpiPart, 8)
                    }
                    RELAUNDER(); }
                } else {
                if (c < nch) { const int r0 = c * MLP_CHUNK, m = min(MLP_CHUNK, nrows - r0);
                    pg8::Gemm g{WSP(bf16, WS_H) + (size_t)r0 * DM, WSP(bf16, WS_W1), m, DFF, DM}; g.ablk = 1; pg8::StaticOrder S; S.init(m, DFF, F.G, F.bid);
                    pg8::EpiRelu2N E{WSP(bf16, WS_Z) + (size_t)(c & 1) * MLP_CHUNK * DFF, DFF, WSP(float, WS_RSTD), WSP(float, WS_SHW) + (size_t)l * 17 * (LDZ + DFF) + LDZ, LDZ + DFF, r0};
                    if (PROBE_DUP == 25) { GEMM_RUN(EpiRelu2N) RELAUNDER(); }
                    GEMM_RUN(EpiRelu2N) }
                }
                RELAUNDER(); }
            STEP_END
          } }
    }
#undef STEP_BEGIN
#undef STEP_END
}

extern "C" void kernel_launch(void* const* d_in, const int* in_sizes, int n_in, void* d_out, int out_size, void* d_ws, size_t ws_size, hipStream_t stream) {
    static int grid = 0;
    if (grid == 0) {
        if (n_in != N_IN || in_sizes[0] != RL * DM || out_size != RL * DM || ws_size < WS_END) {
            fprintf(stderr, "kernel_launch: shape/workspace mismatch: n_in %d in0 %d out %d ws %zu (need %zu); nothing launched\n", n_in, n_in > 0 ? in_sizes[0] : -1, out_size, ws_size, (size_t)WS_END); grid = -1; return; }
        int dev = 0, cus = 0, per_cu = 0;
        if (hipGetDevice(&dev) != hipSuccess || hipDeviceGetAttribute(&cus, hipDeviceAttributeMultiprocessorCount, dev) != hipSuccess) { grid = -1; return; }
        if (hipFuncSetAttribute((const void*)trunk_fwd, hipFuncAttributeMaxDynamicSharedMemorySize, LDS_BYTES) != hipSuccess) { fprintf(stderr, "kernel_launch: hipFuncSetAttribute failed\n"); grid = -1; return; }
        if (hipOccupancyMaxActiveBlocksPerMultiprocessor(&per_cu, (const void*)trunk_fwd, NTHR, LDS_BYTES) != hipSuccess || per_cu < 1)
            fprintf(stderr, "kernel_launch: note: occupancy query reports %d workgroups per CU\n", per_cu);
        (void)hipGetLastError();
        grid = cus;
    }
    if (grid < 0) return;
    if (hipMemsetAsync((char*)d_ws + WS_CTL, 0, CTL_ZERO_BYTES, stream) != hipSuccess) return;
    Args a{};
    for (int i = 0; i < N_IN; ++i) a.in[i] = (const float*)d_in[i];
    a.out = (float*)d_out; a.ws = (unsigned char*)d_ws;
#ifndef MK_SPLIT
    a.lo = 0; a.hi = 1 << 20;
    hipLaunchKernelGGL(trunk_fwd, dim3(grid), dim3(NTHR), LDS_BYTES, stream, a);
#else
    for (int s = 0; s < MK_SPLIT; ++s) { a.lo = s; a.hi = s + 1; hipLaunchKernelGGL(trunk_fwd, dim3(grid), dim3(NTHR), LDS_BYTES, stream, a); }
#endif
}
```
